# Optimizing an MI355X kernel written in HIP

```python
import jax, jax.numpy as jnp
from jax import lax
import numpy as np

D_MODEL = 2048
BATCH = 8
SEQ = 4096
DEPTH = 2
DEC_BATCH = 1
DEC_SEQ = 16384
PAST_LEN = 128

HEAD_DIM = 64
ATT_HEADS = 12
ATT_WIDTH = ATT_HEADS * HEAD_DIM
LRU_WIDTH = D_MODEL - ATT_WIDTH
LRU_BLOCKS = 10
LRU_BLOCK = LRU_WIDTH // LRU_BLOCKS
IN_WIDTH = 3 * ATT_WIDTH + 2 * LRU_WIDTH
D_FF = 5632
CONV_WIDTH = 4
CONV_LEFT = 2
LRU_C = 8.0
ROPE_THETA = 500000.0
ROT_DIM = HEAD_DIM // 4
DILATED_PATTERNS = ((128, 1), (512, 4), (2048, 16))
ALPHA = (2 * DEPTH) ** 0.25
BETA = (8 * DEPTH) ** -0.25
NORM_EPS = 1e-5
NEG_INF = -1e30

kernel_name = 'hybrid_dilated_rglru_macaron_encoder'


def layer_norm(x, g, b):
    xf = x.astype(jnp.float32)
    mu = jnp.mean(xf, axis=-1, keepdims=True)
    var = jnp.mean(jnp.square(xf - mu), axis=-1, keepdims=True)
    return ((xf - mu) * lax.rsqrt(var + NORM_EPS) * g + b).astype(x.dtype)


def rms_norm(x, g):
    xf = x.astype(jnp.float32)
    ms = jnp.mean(jnp.square(xf), axis=-1, keepdims=True)
    return (xf * lax.rsqrt(ms + NORM_EPS) * g).astype(x.dtype)


def swiglu(x, w_gate, w_up, w_down):
    return (jax.nn.silu(x @ w_gate) * (x @ w_up)) @ w_down


def partial_rotary(x):
    S = x.shape[1]
    inv_freq = ROPE_THETA ** (-jnp.arange(0, ROT_DIM, 2, dtype=jnp.float32) / ROT_DIM)
    ang = jnp.arange(S, dtype=jnp.float32)[:, None] * inv_freq[None, :]
    cos = jnp.cos(ang)[None, :, None, :]
    sin = jnp.sin(ang)[None, :, None, :]
    xr = x[..., :ROT_DIM].astype(jnp.float32)
    x1, x2 = xr[..., :ROT_DIM // 2], xr[..., ROT_DIM // 2:]
    rot = jnp.concatenate([x1 * cos - x2 * sin, x2 * cos + x1 * sin], axis=-1).astype(x.dtype)
    return jnp.concatenate([rot, x[..., ROT_DIM:]], axis=-1)


def banded_window_attention(q, k, v, radius):
    n, L, h, dh = q.shape
    blk = radius
    nb = -(-L // blk)
    lp = nb * blk
    qb = jnp.pad(q, ((0, 0), (0, lp - L), (0, 0), (0, 0))).reshape(n, nb, blk, h, dh)
    pad_kv = ((0, 0), (blk, lp - L + blk), (0, 0), (0, 0))
    kb = jnp.pad(k, pad_kv).reshape(n, nb + 2, blk, h, dh)
    vb = jnp.pad(v, pad_kv).reshape(n, nb + 2, blk, h, dh)
    kw = jnp.concatenate([kb[:, :-2], kb[:, 1:-1], kb[:, 2:]], axis=2)
    vw = jnp.concatenate([vb[:, :-2], vb[:, 1:-1], vb[:, 2:]], axis=2)
    s = jnp.einsum('nbqhd,nbkhd->nbhqk', qb, kw,
                   preferred_element_type=jnp.float32) * (dh ** -0.5)
    qpos = jnp.arange(nb)[:, None, None] * blk + jnp.arange(blk)[None, :, None]
    kpos = jnp.arange(nb)[:, None, None] * blk + jnp.arange(3 * blk)[None, None, :] - blk
    mask = (jnp.abs(kpos - qpos) <= radius) & (kpos >= 0) & (kpos < L)
    s = jnp.where(mask[None, :, None], s, NEG_INF)
    lse = jax.nn.logsumexp(s, axis=-1)
    p = jnp.exp(s - lse[..., None])
    o = jnp.einsum('nbhqk,nbkhd->nbqhd', p.astype(v.dtype), vw).reshape(n, lp, h, dh)[:, :L]
    lse = lse.transpose(0, 1, 3, 2).reshape(n, lp, h)[:, :L]
    return o, lse


def dilated_window_mixture(q, k, v):
    B, S, H, Dh = q.shape
    outs, lses = [], []
    for window, dil in DILATED_PATTERNS:
        L = S // dil
        radius = window // (2 * dil)

        def split(t):
            return t.reshape(B, L, dil, H, Dh).transpose(0, 2, 1, 3, 4).reshape(B * dil, L, H, Dh)

        o, lse = banded_window_attention(split(q), split(k), split(v), radius)
        outs.append(o.reshape(B, dil, L, H, Dh).transpose(0, 2, 1, 3, 4).reshape(B, S, H, Dh))
        lses.append(lse.reshape(B, dil, L, H).transpose(0, 2, 1, 3).reshape(B, S, H))
    w = jax.nn.softmax(jnp.stack(lses, axis=-1), axis=-1).astype(q.dtype)
    return sum(outs[g] * w[..., g, None] for g in range(len(DILATED_PATTERNS)))


def centred_depthwise_conv(x, w, b):
    S = x.shape[1]
    xp = jnp.pad(x, ((0, 0), (CONV_LEFT, CONV_WIDTH - 1 - CONV_LEFT), (0, 0)))
    return sum(xp[:, j:j + S] * w[j] for j in range(CONV_WIDTH)) + b


def linear_recurrence(a, u, reverse):
    def combine(c1, c2):
        a1, b1 = c1
        a2, b2 = c2
        return a1 * a2, a2 * b1 + b2
    return lax.associative_scan(combine, (a, u), axis=1, reverse=reverse)[1]


def bidirectional_rg_lru(x, w_a, b_a, w_x, b_x, lam):
    B, S, _ = x.shape
    xb = x.reshape(B, S, LRU_BLOCKS, LRU_BLOCK)
    gate_a = jnp.einsum('bsnc,gncd->gbsnd', xb, w_a).reshape(2, B, S, LRU_WIDTH) + b_a[:, None, None]
    gate_x = jnp.einsum('bsnc,gncd->gbsnd', xb, w_x).reshape(2, B, S, LRU_WIDTH) + b_x[:, None, None]
    r = jax.nn.sigmoid(gate_a.astype(jnp.float32))
    i = jax.nn.sigmoid(gate_x.astype(jnp.float32))
    log_a = -LRU_C * jax.nn.softplus(-lam.astype(jnp.float32))[:, None, None] * r
    a = jnp.exp(log_a)
    u = jnp.sqrt(-jnp.expm1(2.0 * log_a)) * i * x.astype(jnp.float32)[None]
    h_fwd = linear_recurrence(a[0], u[0], False)
    h_bwd = linear_recurrence(a[1], u[1], True)
    return (h_fwd + h_bwd).astype(x.dtype)


def hybrid_mixer(x, w_in, conv_w, conv_b, lru_w_a, lru_b_a, lru_w_x, lru_b_x,
                 lru_lambda, att_norm_g, lru_norm_g, w_out):
    B, S, _ = x.shape
    z = x @ w_in
    q, k, v, xl, gl = jnp.split(
        z, [ATT_WIDTH, 2 * ATT_WIDTH, 3 * ATT_WIDTH, 3 * ATT_WIDTH + LRU_WIDTH], axis=-1)
    heads = lambda t: t.reshape(B, S, ATT_HEADS, HEAD_DIM)
    attn = dilated_window_mixture(partial_rotary(heads(q)), partial_rotary(heads(k)),
                                  heads(v)).reshape(B, S, ATT_WIDTH)
    xc = centred_depthwise_conv(xl, conv_w, conv_b)
    rec = bidirectional_rg_lru(xc, lru_w_a, lru_b_a, lru_w_x, lru_b_x, lru_lambda) * jax.nn.gelu(gl)
    merged = jnp.concatenate([rms_norm(attn, att_norm_g), rms_norm(rec, lru_norm_g)], axis=-1)
    return merged @ w_out


def encoder_trunk(x, ln1_g, ln1_b, ffn1_w_gate, ffn1_w_up, ffn1_w_down, ln2_g, ln2_b,
                  w_in, conv_w, conv_b, lru_w_a, lru_b_a, lru_w_x, lru_b_x, lru_lambda,
                  att_norm_g, lru_norm_g, w_out, ln3_g, ln3_b, ffn2_w_gate, ffn2_w_up,
                  ffn2_w_down):
    for l in range(DEPTH):
        x = layer_norm(ALPHA * x + 0.5 * swiglu(x, ffn1_w_gate[l], ffn1_w_up[l], ffn1_w_down[l]),
                       ln1_g[l], ln1_b[l])
        mix = hybrid_mixer(x, w_in[l], conv_w[l], conv_b[l], lru_w_a[l], lru_b_a[l],
                           lru_w_x[l], lru_b_x[l], lru_lambda[l], att_norm_g[l],
                           lru_norm_g[l], w_out[l])
        x = layer_norm(ALPHA * x + mix, ln2_g[l], ln2_b[l])
        x = layer_norm(ALPHA * x + 0.5 * swiglu(x, ffn2_w_gate[l], ffn2_w_up[l], ffn2_w_down[l]),
                       ln3_g[l], ln3_b[l])
    return x


def setup_inputs(seed: int = 0) -> dict:
    key = jax.random.key(seed)
    ks = jax.random.split(key, 28)
    f32 = jnp.float32
    nrm = lambda k, shape, scale: jax.random.normal(k, shape, f32) * scale
    gain = lambda k, n: 1.0 + nrm(k, (DEPTH, n), 0.05)
    col_scale = jnp.concatenate([jnp.ones((2 * ATT_WIDTH,), f32),
                                 jnp.full((ATT_WIDTH + LRU_WIDTH,), BETA, f32),
                                 jnp.ones((LRU_WIDTH,), f32)])
    a_pow_c = jax.random.uniform(ks[14], (DEPTH, 2, LRU_WIDTH), f32, 0.9, 0.999)
    a0 = a_pow_c ** (1.0 / LRU_C)
    return {
        'x_prompt': nrm(ks[0], (BATCH, SEQ, D_MODEL), 1.0),
        'x_sample': nrm(ks[1], (DEC_BATCH, DEC_SEQ, D_MODEL), 1.0),
        'ln1_g': gain(ks[2], D_MODEL),
        'ln1_b': nrm(ks[3], (DEPTH, D_MODEL), 0.02),
        'ffn1_w_gate': nrm(ks[4], (DEPTH, D_MODEL, D_FF), BETA * D_MODEL ** -0.5),
        'ffn1_w_up': nrm(ks[5], (DEPTH, D_MODEL, D_FF), BETA * D_MODEL ** -0.5),
        'ffn1_w_down': nrm(ks[6], (DEPTH, D_FF, D_MODEL), BETA * D_FF ** -0.5),
        'ln2_g': gain(ks[7], D_MODEL),
        'ln2_b': nrm(ks[8], (DEPTH, D_MODEL), 0.02),
        'w_in': nrm(ks[9], (DEPTH, D_MODEL, IN_WIDTH), D_MODEL ** -0.5) * col_scale,
        'conv_w': nrm(ks[10], (DEPTH, CONV_WIDTH, LRU_WIDTH), CONV_WIDTH ** -0.5),
        'conv_b': nrm(ks[11], (DEPTH, LRU_WIDTH), 0.02),
        'lru_w_a': nrm(ks[12], (DEPTH, 2, LRU_BLOCKS, LRU_BLOCK, LRU_BLOCK), LRU_BLOCK ** -0.5),
        'lru_b_a': nrm(ks[13], (DEPTH, 2, LRU_WIDTH), 0.05),
        'lru_w_x': nrm(ks[15], (DEPTH, 2, LRU_BLOCKS, LRU_BLOCK, LRU_BLOCK), LRU_BLOCK ** -0.5),
        'lru_b_x': nrm(ks[16], (DEPTH, 2, LRU_WIDTH), 0.05),
        'lru_lambda': jnp.log(a0) - jnp.log1p(-a0),
        'att_norm_g': gain(ks[17], ATT_WIDTH),
        'lru_norm_g': gain(ks[18], LRU_WIDTH),
        'w_out': nrm(ks[19], (DEPTH, D_MODEL, D_MODEL), BETA * D_MODEL ** -0.5),
        'ln3_g': gain(ks[20], D_MODEL),
        'ln3_b': nrm(ks[21], (DEPTH, D_MODEL), 0.02),
        'ffn2_w_gate': nrm(ks[22], (DEPTH, D_MODEL, D_FF), BETA * D_MODEL ** -0.5),
        'ffn2_w_up': nrm(ks[23], (DEPTH, D_MODEL, D_FF), BETA * D_MODEL ** -0.5),
        'ffn2_w_down': nrm(ks[24], (DEPTH, D_FF, D_MODEL), BETA * D_FF ** -0.5),
    }


def reference(x_prompt, x_sample, ln1_g, ln1_b, ffn1_w_gate, ffn1_w_up, ffn1_w_down,
              ln2_g, ln2_b, w_in, conv_w, conv_b, lru_w_a, lru_b_a, lru_w_x, lru_b_x,
              lru_lambda, att_norm_g, lru_norm_g, w_out, ln3_g, ln3_b, ffn2_w_gate,
              ffn2_w_up, ffn2_w_down):
    params = (ln1_g, ln1_b, ffn1_w_gate, ffn1_w_up, ffn1_w_down, ln2_g, ln2_b,
              w_in, conv_w, conv_b, lru_w_a, lru_b_a, lru_w_x, lru_b_x, lru_lambda,
              att_norm_g, lru_norm_g, w_out, ln3_g, ln3_b, ffn2_w_gate, ffn2_w_up,
              ffn2_w_down)
    y_prompt = encoder_trunk(x_prompt, *params)
    y_sample = encoder_trunk(x_sample, *params)
    return (y_prompt, y_sample)
```

```cpp
#include <hip/hip_runtime.h>
#include <cstdio>
#include <cstdint>
namespace pg8 {
#define PG8_LAS __attribute__((address_space(3)))
typedef unsigned short bf16_t;
typedef short bf16x8 __attribute__((ext_vector_type(8)));
typedef float f32x4 __attribute__((ext_vector_type(4)));
typedef unsigned u32x4 __attribute__((ext_vector_type(4)));
constexpr int BM = 256, BK = 64, HALF = 128, HTB = HALF * BK * 2  , STAGE_BYTES = 8 * HTB, NXCD = 8, WGM = 8;

__host__ __device__ __forceinline__ int lds_byte(int r, int c) { const int st = (r >> 4) * 2 + (c >> 5), rr = r & 15, cc = c & 31, ob = rr * 64 + cc * 2; return st * 1024 + (ob ^ (((ob >> 9) & 1) << 5)); }
__host__ __device__ __forceinline__ void stage_rc(int b, int& R, int& C) { const int st = b / 1024, sb = b % 1024, swz = sb ^ (((sb >> 9) & 1) << 5); R = (st >> 1) * 16 + swz / 64; C = (st & 1) * 32 + (swz % 64) / 2; }
__host__ __device__ __forceinline__ int perm32(int rho) { const int n = rho >> 4, i = rho & 15; return 8 * (i >> 2) + 4 * n + (i & 3); }

struct Unit { int pm, pn; };
struct Gemm { const bf16_t* A; const bf16_t* Bt; int M, N, K, lda; };

struct StaticOrder {
    int nM, nN, nwg, G, c;
    __host__ __device__ void init(int M, int N, int G_, int c_) { nM = M / BM; nN = N / BM; nwg = nM * nN; G = G_; c = c_; }
    __host__ __device__ bool next(int i, Unit& u) const {
        const long L = (long)i * G + c; if (L >= nwg) return false;
        int wgid = (int)L; { const int q = nwg / NXCD, r = nwg % NXCD, xcd = wgid % NXCD, off = wgid / NXCD; wgid = (xcd < r ? xcd * (q + 1) : r * (q + 1) + (xcd - r) * q) + off; }
        const int nig = WGM * nN, gid = wgid / nig, fm = gid * WGM, gsz = (nM - fm) < WGM ? (nM - fm) : WGM;
        u.pm = fm + ((wgid % nig) % gsz); u.pn = (wgid % nig) / gsz; return true;
    }
    __device__ __forceinline__ void a_ready(const Unit&) const {}
    __device__ __forceinline__ void done(const Unit&) const {}
};


__device__ __forceinline__ unsigned cvt_pk_bf16(float lo, float hi) { unsigned r; asm volatile("v_cvt_pk_bf16_f32 %0, %1, %2" : "=v"(r) : "v"(lo), "v"(hi)); return r; }
typedef float f32x2 __attribute__((ext_vector_type(2)));
typedef unsigned u32x2 __attribute__((ext_vector_type(2)));
constexpr float ALPHA_RES = 1.41421356237309515f;
__device__ __forceinline__ void row_stats(const float* st, int r, float& mu, float& rstd) {
    const f32x2 s = *(const f32x2*)(st + 2 * (size_t)r);
    mu = s.x * (1.0f / 2048.0f); const float var = s.y * (1.0f / 2048.0f) - mu * mu;
    rstd = rsqrtf(fmaxf(var, 0.0f) + 1e-5f);
}
__device__ __forceinline__ float silu_f(float v) { return v * __builtin_amdgcn_rcpf(1.0f + __expf(-v)); }

struct EpiGU {
    static constexpr bool PERM = true, AFTER_DRAIN = false;
    bf16_t* H; const float* st; const float* cs; const float* cb;
    __device__ __forceinline__ void operator()(const f32x4 (&acc)[2][2][4][2], const Unit& u, int wr, int wc, int fr, int fq) const {
        const int row0 = u.pm * BM + wr * 64 + fr, rb = u.pn * BM + wc * 32 + 8 * fq, hc = u.pn * 128 + wc * 32 + 8 * fq;
        f32x4 csv[2][2], cbv[2][2];
#pragma unroll
        for (int bj = 0; bj < 2; ++bj)
#pragma unroll
            for (int n = 0; n < 2; ++n) { csv[bj][n] = *(const f32x4*)(cs + rb + bj * HALF + 4 * n); cbv[bj][n] = *(const f32x4*)(cb + rb + bj * HALF + 4 * n); }
#pragma unroll
        for (int ai = 0; ai < 2; ++ai)
#pragma unroll
            for (int m = 0; m < 4; ++m) { const int r = row0 + ai * HALF + m * 16; float mu, rstd; row_stats(st, r, mu, rstd);
                f32x4 hv[2];
#pragma unroll
                for (int n = 0; n < 2; ++n) { const f32x4 gt = (acc[ai][0][m][n] - csv[0][n] * mu) * rstd + cbv[0][n], up = (acc[ai][1][m][n] - csv[1][n] * mu) * rstd + cbv[1][n];
#pragma unroll
                    for (int j = 0; j < 4; ++j) hv[n][j] = silu_f(gt[j]) * up[j]; }
                u32x4 w; w.x = cvt_pk_bf16(hv[0][0], hv[0][1]); w.y = cvt_pk_bf16(hv[0][2], hv[0][3]); w.z = cvt_pk_bf16(hv[1][0], hv[1][1]); w.w = cvt_pk_bf16(hv[1][2], hv[1][3]);
                *(u32x4*)(H + (size_t)r * 5632 + hc) = w; asm volatile("" ::: "memory"); }
    }
};
struct EpiIn {
    static constexpr bool PERM = true, AFTER_DRAIN = false;
    bf16_t* Z; const float* st; const float* cs; const float* cb; const float* rope;
    __device__ __forceinline__ void operator()(const f32x4 (&acc)[2][2][4][2], const Unit& u, int wr, int wc, int fr, int fq) const {
        const int row0 = u.pm * BM + wr * 64 + fr, rb = u.pn * BM + wc * 32 + 8 * fq;
        const bool rot = (u.pn < 3 || (u.pn >= 8 && u.pn < 11)) && ((wc & 1) == 0);
        f32x4 csv[2][2], cbv[2][2];
#pragma unroll
        for (int bj = 0; bj < 2; ++bj)
#pragma unroll
            for (int n = 0; n < 2; ++n) { csv[bj][n] = *(const f32x4*)(cs + rb + bj * HALF + 4 * n); cbv[bj][n] = *(const f32x4*)(cb + rb + bj * HALF + 4 * n); }
#pragma unroll
        for (int ai = 0; ai < 2; ++ai)
#pragma unroll
            for (int m = 0; m < 4; ++m) { const int r = row0 + ai * HALF + m * 16; float mu, rstd; row_stats(st, r, mu, rstd);
                f32x4 cs0 = {1.f, 0.f, 1.f, 0.f}, cs1 = cs0, cs2 = cs0, cs3 = cs0;
                if (rot && fq < 2) { const int pos = r < 32768 ? (r & 4095) : (r - 32768); const f32x4* rp = (const f32x4*)(rope + (size_t)pos * 16); cs0 = rp[0]; cs1 = rp[1]; cs2 = rp[2]; cs3 = rp[3]; }
                const float sg = (fq == 0) ? -1.f : 1.f;
#pragma unroll
                for (int bj = 0; bj < 2; ++bj) { f32x4 v0 = (acc[ai][bj][m][0] - csv[bj][0] * mu) * rstd + cbv[bj][0], v1 = (acc[ai][bj][m][1] - csv[bj][1] * mu) * rstd + cbv[bj][1];
                    if (rot) { f32x4 p0, p1;
#pragma unroll
                        for (int j = 0; j < 4; ++j) { p0[j] = __shfl_xor(v0[j], 16); p1[j] = __shfl_xor(v1[j], 16); }
                        if (fq < 2) {
                            v0[0] = v0[0] * cs0[0] + sg * p0[0] * cs0[1]; v0[1] = v0[1] * cs0[2] + sg * p0[1] * cs0[3]; v0[2] = v0[2] * cs1[0] + sg * p0[2] * cs1[1]; v0[3] = v0[3] * cs1[2] + sg * p0[3] * cs1[3];
                            v1[0] = v1[0] * cs2[0] + sg * p1[0] * cs2[1]; v1[1] = v1[1] * cs2[2] + sg * p1[1] * cs2[3]; v1[2] = v1[2] * cs3[0] + sg * p1[2] * cs3[1]; v1[3] = v1[3] * cs3[2] + sg * p1[3] * cs3[3]; } }
                    u32x4 w; w.x = cvt_pk_bf16(v0[0], v0[1]); w.y = cvt_pk_bf16(v0[2], v0[3]); w.z = cvt_pk_bf16(v1[0], v1[1]); w.w = cvt_pk_bf16(v1[2], v1[3]);
                    *(u32x4*)(Z + (size_t)r * 4864 + rb + bj * HALF) = w; } asm volatile("" ::: "memory"); }
    }
};
struct EpiRes {
    static constexpr bool PERM = false, AFTER_DRAIN = false;
    const float* Xlo; const float* Xhi; float* OUT; bf16_t* TB; const float* st; const float* g; const float* b; float* st_out; float sc;
    __device__ __forceinline__ void operator()(const f32x4 (&acc)[2][2][4][2], const Unit& u, int wr, int wc, int fr, int fq) const {
        const int row0 = u.pm * BM + wr * 64 + fr, col0 = u.pn * BM + wc * 32 + 4 * fq;
        const float* X = (u.pm < 128) ? Xlo : Xhi;
        f32x4 gv[2][2], bv[2][2];
#pragma unroll
        for (int bj = 0; bj < 2; ++bj)
#pragma unroll
            for (int n = 0; n < 2; ++n) { gv[bj][n] = *(const f32x4*)(g + col0 + bj * HALF + n * 16); bv[bj][n] = *(const f32x4*)(b + col0 + bj * HALF + n * 16); }
#pragma unroll
        for (int ai = 0; ai < 2; ++ai)
#pragma unroll
            for (int m = 0; m < 4; ++m) { const int r = row0 + ai * HALF + m * 16; float mu, rstd; row_stats(st, r, mu, rstd);
                const size_t off = (size_t)r * 2048 + col0; float s = 0.f, q = 0.f;
#pragma unroll
                for (int bj = 0; bj < 2; ++bj)
#pragma unroll
                    for (int n = 0; n < 2; ++n) { const f32x4 t4 = *(const f32x4*)(X + off + bj * HALF + n * 16);
                        const f32x4 xn = (t4 - mu) * rstd * gv[bj][n] + bv[bj][n];
                        const f32x4 o = xn * ALPHA_RES + acc[ai][bj][m][n] * sc;
                        *(f32x4*)(OUT + off + bj * HALF + n * 16) = o;
                        u32x2 w; w.x = cvt_pk_bf16(o[0], o[1]); w.y = cvt_pk_bf16(o[2], o[3]); *(u32x2*)(TB + off + bj * HALF + n * 16) = w;
                        s += (o[0] + o[1]) + (o[2] + o[3]); q += (o[0] * o[0] + o[1] * o[1]) + (o[2] * o[2] + o[3] * o[3]); }
                s += __shfl_xor(s, 16); s += __shfl_xor(s, 32); q += __shfl_xor(q, 16); q += __shfl_xor(q, 32);
                if (fq == 0) { unsafeAtomicAdd(st_out + 2 * (size_t)r, s); unsafeAtomicAdd(st_out + 2 * (size_t)r + 1, q); }
                asm volatile("" ::: "memory"); }
    }
};

template <class Epi, class Sched, bool ALIGN_EPI = false, bool SP2 = false>
__device__ __forceinline__ void gemm_phase(PG8_LAS unsigned char* lds, const Gemm g, const Sched& S, const Epi& E, const int tid) {
    const int wid = __builtin_amdgcn_readfirstlane(tid >> 6), lane = tid & 63, wr = wid >> 2, wc = wid & 3, fr = lane & 15, fq = lane >> 4;
    const int K = g.K, nt = K / BK;
    unsigned voffA[2], voffB[2];
#pragma unroll
    for (int i = 0; i < 2; ++i) { int R, C; stage_rc(tid * 16 + i * 8192, R, C); const int Rb = Epi::PERM ? ((R & ~31) + perm32(R & 31)) : R;
        voffA[i] = (unsigned)(R * g.lda + C) * 2u; voffB[i] = (unsigned)(Rb * K + C) * 2u; }
    const size_t kstep = (size_t)(BK * 2);
    const size_t hstep = (size_t)HALF * K * 2;
    const size_t tstep = 2 * hstep; const size_t hstepA = (size_t)HALF * g.lda * 2, tstepA = 2 * hstepA;
    const unsigned ldsw = (unsigned)wid * 1024u;
    const int aoff = lds_byte(wr * 64 + fr, fq * 8), boff = lds_byte(wc * 32 + fr, fq * 8);
#define PG8_SA(b, h) (((b) * 2 + (h)) * HTB)
#define PG8_SB(b, h) ((4 + (b) * 2 + (h)) * HTB)
#define PG8_STAGE(bufoff, gbase, voff) do { _Pragma("unroll") for (int _i = 0; _i < 2; ++_i) \
        __builtin_amdgcn_global_load_lds((const unsigned*)((const char*)(gbase) + (voff)[_i]), (PG8_LAS unsigned*)(lds + (bufoff) + ldsw + _i * 8192), 16, 0, 0); } while (0)
#define PG8_LDA(dst, b, h) do { _Pragma("unroll") for (int m = 0; m < 4; ++m) _Pragma("unroll") for (int k = 0; k < 2; ++k) dst[m][k] = *(const PG8_LAS bf16x8*)(lds + PG8_SA(b, h) + aoff + m * 2048 + k * 1024); } while (0)
#define PG8_LDB(dst, b, h) do { _Pragma("unroll") for (int n = 0; n < 2; ++n) _Pragma("unroll") for (int k = 0; k < 2; ++k) dst[n][k] = *(const PG8_LAS bf16x8*)(lds + PG8_SB(b, h) + boff + n * 2048 + k * 1024); } while (0)
#define PG8_MMA(ai, bj, At, Bt) do { __builtin_amdgcn_s_setprio(1); _Pragma("unroll") for (int m = 0; m < 4; ++m) _Pragma("unroll") for (int n = 0; n < 2; ++n) _Pragma("unroll") for (int k = 0; k < 2; ++k) \
        acc[ai][bj][m][n] = __builtin_amdgcn_mfma_f32_16x16x32_bf16(Bt[n][k], At[m][k], acc[ai][bj][m][n], 0, 0, 0); __builtin_amdgcn_s_setprio(0); } while (0)
#define PG8_WAIT_V(n) asm volatile("s_waitcnt vmcnt(" #n ")" ::: "memory")
#define PG8_WAIT_L(n) asm volatile("s_waitcnt lgkmcnt(" #n ")" ::: "memory")
#define PG8_BAR __builtin_amdgcn_s_barrier()
#define PG8_SCHED __builtin_amdgcn_sched_barrier(0)
    Unit cur, nxt; int ui = 0;
    if (!S.next(0, cur)) return;
    f32x4 acc[2][2][4][2];
#pragma unroll
    for (int a = 0; a < 2; ++a)
#pragma unroll
        for (int b = 0; b < 2; ++b)
#pragma unroll
            for (int m = 0; m < 4; ++m)
#pragma unroll
                for (int n = 0; n < 2; ++n) acc[a][b][m][n] = (f32x4){0.f, 0.f, 0.f, 0.f};
    bf16x8 At[4][2], B0[2][2], B1[2][2];
    const char* cA = (const char*)g.A + (size_t)cur.pm * tstepA; const char* cB = (const char*)g.Bt + (size_t)cur.pn * tstep;
    S.a_ready(cur);
    if constexpr (SP2) {
        PG8_STAGE(PG8_SB(0, 0), cB, voffB); PG8_STAGE(PG8_SB(0, 1), cB + hstep, voffB); PG8_STAGE(PG8_SA(0, 0), cA, voffA); PG8_STAGE(PG8_SA(0, 1), cA + hstepA, voffA);
        if (wr == 1) PG8_BAR;
        PG8_WAIT_V(2); PG8_BAR;
        PG8_STAGE(PG8_SB(1, 0), cB + kstep, voffB); PG8_STAGE(PG8_SA(1, 0), cA + kstep, voffA); PG8_STAGE(PG8_SB(1, 1), cB + hstep + kstep, voffB);
        PG8_WAIT_V(6); PG8_BAR;
    } else {
        PG8_STAGE(PG8_SB(0, 0), cB, voffB); PG8_STAGE(PG8_SA(0, 0), cA, voffA); PG8_STAGE(PG8_SB(0, 1), cB + hstep, voffB); PG8_STAGE(PG8_SA(0, 1), cA + hstepA, voffA);
        if (wr == 1) PG8_BAR;
        PG8_WAIT_V(4); PG8_BAR;
        PG8_STAGE(PG8_SB(1, 0), cB + kstep, voffB); PG8_STAGE(PG8_SA(1, 0), cA + kstep, voffA); PG8_STAGE(PG8_SB(1, 1), cB + hstep + kstep, voffB);
        PG8_WAIT_V(6); PG8_BAR;
    }
    for (;;) {
        const bool has_next = S.next(ui + 1, nxt);
        const char* nA = has_next ? (const char*)g.A + (size_t)nxt.pm * tstepA : cA; const char* nB = has_next ? (const char*)g.Bt + (size_t)nxt.pn * tstep : cB;
        for (int t = 0; t < nt; t += 2) {
            const bool last = (t == nt - 2);
            const char* a1 = cA + (size_t)(t + 1) * kstep;
            const char* a2 = last ? nA : cA + (size_t)(t + 2) * kstep; const char* b2 = last ? nB : cB + (size_t)(t + 2) * kstep;
            const char* a3 = a2 + kstep; const char* b3 = b2 + kstep;
            if (last && has_next) S.a_ready(nxt);
            if constexpr (SP2) {
            PG8_LDB(B0, 0, 0); PG8_LDB(B1, 0, 1); PG8_SCHED; PG8_LDA(At, 0, 0); PG8_STAGE(PG8_SA(1, 1), a1 + hstepA, voffA);
            PG8_WAIT_V(8); PG8_WAIT_L(0); PG8_BAR; PG8_MMA(0, 0, At, B0); PG8_MMA(0, 1, At, B1); PG8_BAR; PG8_SCHED;
            PG8_LDA(At, 0, 1); PG8_STAGE(PG8_SB(0, 0), b2, voffB); PG8_STAGE(PG8_SB(0, 1), b2 + hstep, voffB); PG8_STAGE(PG8_SA(0, 0), a2, voffA);
            PG8_WAIT_V(8); PG8_WAIT_L(0); PG8_BAR; PG8_MMA(1, 0, At, B0); PG8_MMA(1, 1, At, B1); PG8_BAR; PG8_SCHED;
            PG8_LDB(B0, 1, 0); PG8_LDB(B1, 1, 1); PG8_SCHED; PG8_LDA(At, 1, 0); PG8_STAGE(PG8_SA(0, 1), a2 + hstepA, voffA);
            PG8_WAIT_V(8); PG8_WAIT_L(0); PG8_BAR; PG8_MMA(0, 0, At, B0); PG8_MMA(0, 1, At, B1); PG8_BAR; PG8_SCHED;
            PG8_LDA(At, 1, 1); PG8_STAGE(PG8_SB(1, 0), b3, voffB); PG8_STAGE(PG8_SB(1, 1), b3 + hstep, voffB); PG8_STAGE(PG8_SA(1, 0), a3, voffA);
            PG8_WAIT_V(8); PG8_WAIT_L(0); PG8_BAR; PG8_MMA(1, 0, At, B0); PG8_MMA(1, 1, At, B1); PG8_BAR; PG8_SCHED;
            } else {
            PG8_LDB(B0, 0, 0); PG8_SCHED; PG8_LDA(At, 0, 0); PG8_STAGE(PG8_SA(1, 1), a1 + hstepA, voffA);
            PG8_WAIT_L(8); PG8_BAR; PG8_WAIT_L(0); PG8_MMA(0, 0, At, B0); PG8_BAR; PG8_SCHED;
            PG8_LDB(B1, 0, 1); PG8_STAGE(PG8_SB(0, 0), b2, voffB);
            PG8_BAR; PG8_WAIT_L(0); PG8_MMA(0, 1, At, B1); PG8_BAR;
            PG8_LDA(At, 0, 1); PG8_STAGE(PG8_SA(0, 0), a2, voffA);
            PG8_BAR; PG8_WAIT_L(0); PG8_MMA(1, 0, At, B0); PG8_BAR; PG8_SCHED;
            PG8_STAGE(PG8_SB(0, 1), b2 + hstep, voffB);
            PG8_WAIT_V(6); PG8_BAR; PG8_MMA(1, 1, At, B1); PG8_BAR;
            PG8_LDB(B0, 1, 0); PG8_SCHED; PG8_LDA(At, 1, 0); PG8_STAGE(PG8_SA(0, 1), a2 + hstepA, voffA);
            PG8_WAIT_L(8); PG8_BAR; PG8_WAIT_L(0); PG8_MMA(0, 0, At, B0); PG8_BAR; PG8_SCHED;
            PG8_LDB(B1, 1, 1); PG8_STAGE(PG8_SB(1, 0), b3, voffB);
            PG8_BAR; PG8_WAIT_L(0); PG8_MMA(0, 1, At, B1); PG8_BAR;
            PG8_LDA(At, 1, 1); PG8_STAGE(PG8_SA(1, 0), a3, voffA);
            PG8_BAR; PG8_WAIT_L(0); PG8_MMA(1, 0, At, B0); PG8_BAR; PG8_SCHED;
            PG8_STAGE(PG8_SB(1, 1), b3 + hstep, voffB);
            PG8_WAIT_V(6); PG8_BAR; PG8_MMA(1, 1, At, B1); PG8_BAR;
            }
        }
        if constexpr (ALIGN_EPI) { if (wr == 0) PG8_BAR; }
        if constexpr (!Epi::AFTER_DRAIN) { E(acc, cur, wr, wc, fr, fq); S.done(cur); }
        if (!has_next) break;
#pragma unroll
        for (int a = 0; a < 2; ++a)
#pragma unroll
            for (int b = 0; b < 2; ++b)
#pragma unroll
                for (int m = 0; m < 4; ++m)
#pragma unroll
                    for (int n = 0; n < 2; ++n) acc[a][b][m][n] = (f32x4){0.f, 0.f, 0.f, 0.f};
        cur = nxt; cA = nA; cB = nB; ++ui;
        if constexpr (ALIGN_EPI) { if (wr == 1) PG8_BAR; }
    }
    PG8_WAIT_V(0);
    if constexpr (!ALIGN_EPI) { if (wr == 0) PG8_BAR; }
    PG8_BAR;
    if constexpr (Epi::AFTER_DRAIN) { E.fused(acc, cur, wr, wc, fr, fq, lds, wid, lane); S.done(cur); }
#undef PG8_SA
#undef PG8_SB
#undef PG8_STAGE
#undef PG8_LDA
#undef PG8_LDB
#undef PG8_MMA
#undef PG8_WAIT_V
#undef PG8_WAIT_L
#undef PG8_BAR
#undef PG8_SCHED
}
}

#ifndef PG8_SP2
#define PG8_SP2 true
#endif
#ifndef PG8_ALIGN
#define PG8_ALIGN true
#endif
constexpr int NWAVES = 8;
constexpr int T = 49152, TPR = 32768, D = 2048, FF = 5632, NIN = 4864, AW = 768, LW = 1280;
constexpr int ZQ = 0, ZGL = 768, ZK = 2048, ZV = 2816, ZXL = 3584;
constexpr int LCH = 64, NCHUNK = T / LCH;
constexpr size_t MiB = 1u << 20;
constexpr size_t WS_CTL = 0, CTL_ZERO_BYTES = 4 * MiB;
constexpr size_t STAT_BYTES = (size_t)T * 8, SSQ_BYTES = (size_t)T * 4;
constexpr size_t WS_ST = 1 * MiB;
constexpr size_t WS_SSQ = WS_ST + 6 * STAT_BYTES;
static_assert(WS_SSQ + 4 * SSQ_BYTES <= CTL_ZERO_BYTES, "zero region");
constexpr size_t WS_ST0 = 4 * MiB;
constexpr size_t WS_VEC = 4 * MiB + 512 * 1024;
constexpr size_t WS_ROPE = 5 * MiB;
constexpr size_t WS_CSB = 6 * MiB;
constexpr size_t WS_LRUW = 7 * MiB;
constexpr size_t WS_TOT = 10 * MiB;
constexpr size_t WS_WGU1 = 26 * MiB, WS_WD1 = 70 * MiB, WS_WIN = 92 * MiB, WS_WOUT = 111 * MiB, WS_WGU2 = 119 * MiB, WS_WD2 = 163 * MiB;
constexpr size_t WS_TB = 185 * MiB;
constexpr size_t WS_BIG = 377 * MiB;
constexpr size_t WS_END = 905 * MiB;
static_assert(WS_TOT + (size_t)NCHUNK * 2 * 1280 * 8 <= WS_WGU1 && WS_WD2 + (size_t)D * FF * 2 <= WS_TB && WS_TB + (size_t)T * D * 2 <= WS_BIG && WS_BIG + (size_t)T * FF * 2 <= WS_END, "d_ws map");
constexpr int CW_BAR = 4096;
constexpr int RING_OFF = 0, RING_BYTES = 131072;
constexpr int LDSCTL_OFF = RING_BYTES, MISC_OFF = LDSCTL_OFF + 320;
constexpr int LDS_BYTES = 147456;
#define GAS __attribute__((address_space(1)))
#define LAS __attribute__((address_space(3)))
typedef unsigned short bf16;
typedef unsigned v4u __attribute__((ext_vector_type(4)));
typedef unsigned v2u __attribute__((ext_vector_type(2)));
typedef float f32x4 __attribute__((ext_vector_type(4)));
typedef float f32x2 __attribute__((ext_vector_type(2)));
typedef short bf16x8 __attribute__((ext_vector_type(8)));
#define LDS_WAIT() asm volatile("s_waitcnt lgkmcnt(0)" ::: "memory")
__device__ __forceinline__ unsigned f2bf(float f) { unsigned u = __builtin_bit_cast(unsigned, f); return (u + 0x7fffu + ((u >> 16) & 1u)) >> 16; }
__device__ __forceinline__ unsigned pk2(float lo, float hi) { return f2bf(lo) | (f2bf(hi) << 16); }
__device__ __forceinline__ float bf_lo(unsigned w) { return __uint_as_float(w << 16); }
__device__ __forceinline__ float bf_hi(unsigned w) { return __uint_as_float(w & 0xffff0000u); }
__device__ __forceinline__ float sigmoid_f(float v) { return __builtin_amdgcn_rcpf(1.0f + __expf(-v)); }
__device__ __forceinline__ float gelu_tanh(float x) { const float y = 0.7978845608028654f * (x + 0.044715f * x * x * x); const float th = 1.0f - 2.0f * __builtin_amdgcn_rcpf(1.0f + __expf(2.0f * y)); return 0.5f * x * (1.0f + th); }
#define XB_TMO      128
#define XB_XCNT(j)  (256  + 64 * (j))
#define XB_XSUB(j)  (1280 + 64 * (j))
#define XB_XGEN(j)  (2304 + 64 * (j))
#define XB_TOP      3328
#define XB_TOPGEN   3392
#define XCD_BAR_WORDS 3456
#define XB_SPIN_CAP (1u << 18)

__device__ __forceinline__ unsigned xb_ld(unsigned* p)              { return __hip_atomic_load(p, __ATOMIC_RELAXED, __HIP_MEMORY_SCOPE_AGENT); }
__device__ __forceinline__ unsigned xb_add(unsigned* p, unsigned v) { return __hip_atomic_fetch_add(p, v, __ATOMIC_RELAXED, __HIP_MEMORY_SCOPE_AGENT); }
__device__ __forceinline__ unsigned xb_xcc_id() { return (unsigned)__builtin_amdgcn_s_getreg((3 << 11) | 20) & 0xFu; }
#define XB_SPIN(cond, bar) do { unsigned _sp = 0; while (cond) { __builtin_amdgcn_s_sleep(1); \
    if ((++_sp & 255u) == 0u) { if (xb_ld(&(bar)[XB_TMO])) break; if (_sp > XB_SPIN_CAP) { atomicAdd(&(bar)[XB_TMO], 1u); break; } } } } while (0)

struct XcdBarrier {
    unsigned* bar; unsigned x;
    volatile LAS unsigned* st;
};

__device__ __forceinline__ XcdBarrier xcd_barrier_post(unsigned* bar, volatile LAS unsigned* st) {
    XcdBarrier b; b.bar = bar; b.x = xb_xcc_id(); b.st = st;
    if (threadIdx.x == 0) (void)xb_add(&bar[XB_XCNT(b.x)], 1u);
    return b;
}
__device__ __forceinline__ void xcd_barrier_complete(unsigned* bar, unsigned x, unsigned& nloc, unsigned& nx) {
    const unsigned G = gridDim.x * gridDim.y * gridDim.z;
    unsigned sum, cnt, mine, sp = 0u;
    for (;;) {
        sum = 0u; cnt = 0u; mine = 0u;
#pragma unroll
        for (unsigned j = 0; j < 16; ++j) { const unsigned c = xb_ld(&bar[XB_XCNT(j)]); sum += c; cnt += (c > 0u) ? 1u : 0u; mine = (j == x) ? c : mine; }
        if (sum == G) break;
        __builtin_amdgcn_s_sleep(1);
        if ((++sp & 255u) == 0u) { if (xb_ld(&bar[XB_TMO])) break; if (sp > XB_SPIN_CAP) { atomicAdd(&bar[XB_TMO], 1u); break; } }
    }
    nloc = mine > 0u ? mine : 1u; nx = cnt > 0u ? cnt : 1u;
}

__device__ __forceinline__ void xcd_barrier(const XcdBarrier& b) {
    asm volatile("s_waitcnt vmcnt(0)" ::: "memory");
    __syncthreads();
    if (threadIdx.x == 0) {
        unsigned* bar = b.bar;
        __builtin_amdgcn_s_waitcnt(0);
        unsigned nloc = b.st[0], nx = b.st[1];
        if (nloc == 0u) { xcd_barrier_complete(bar, b.x, nloc, nx); b.st[0] = nloc; b.st[1] = nx; }
        const unsigned old = xb_add(&bar[XB_XSUB(b.x)], 1u);
        const unsigned gen = old / nloc;
        if (old + 1u == (gen + 1u) * nloc) {
            __builtin_amdgcn_fence(__ATOMIC_RELEASE, "agent");
            asm volatile("s_waitcnt vmcnt(0)" ::: "memory");
            const unsigned og = xb_add(&bar[XB_TOP], 1u);
            const unsigned tg = og / nx;
            if (og + 1u == (tg + 1u) * nx) xb_add(&bar[XB_TOPGEN], 1u);
            else XB_SPIN(xb_ld(&bar[XB_TOPGEN]) == tg, bar);
            __builtin_amdgcn_fence(__ATOMIC_ACQUIRE, "agent");
            xb_add(&bar[XB_XGEN(b.x)], 1u);
            asm volatile("s_waitcnt vmcnt(0)" ::: "memory");
        } else {
            XB_SPIN(xb_ld(&bar[XB_XGEN(b.x)]) == gen, bar);
            __builtin_amdgcn_fence(__ATOMIC_ACQUIRE, "agent");
            asm volatile("s_waitcnt vmcnt(0)" ::: "memory");
        }
    }
    __syncthreads();
}

__device__ __forceinline__ void conv_item(const float* W, int K, int ldw, int n0, bf16* WT, int drow0, const float* g, const float* g2, int ksplit, const float* b, float* cs, float* cb, LAS float* scr, int lane) {
    float csa[4] = {0.f, 0.f, 0.f, 0.f}, cba[4] = {0.f, 0.f, 0.f, 0.f};
    const int c = lane & 7;
    for (int k0 = 0; k0 < K; k0 += 64) {
#pragma unroll 8
        for (int i = 0; i < 32; ++i) { const int kk = 2 * i + (lane >> 5); scr[kk * 33 + (lane & 31)] = W[(size_t)(k0 + kk) * ldw + n0 + (lane & 31)]; }
        LDS_WAIT(); asm volatile("" ::: "memory");
        float gk[8], bk[8];
#pragma unroll
        for (int e = 0; e < 8; ++e) { const int k = k0 + 8 * c + e; gk[e] = g ? (k < ksplit ? g[k] : g2[k - ksplit]) : 1.f; bk[e] = b ? b[k] : 0.f; }
#pragma unroll
        for (int j = 0; j < 4; ++j) { const int n = (lane >> 3) + 8 * j; const LAS float* s = scr + (8 * c) * 33 + n;
            float w[8], wg[8];
#pragma unroll
            for (int e = 0; e < 8; ++e) { w[e] = s[e * 33]; wg[e] = w[e] * gk[e]; }
            v4u o; o.x = pk2(wg[0], wg[1]); o.y = pk2(wg[2], wg[3]); o.z = pk2(wg[4], wg[5]); o.w = pk2(wg[6], wg[7]);
            *(v4u*)(WT + (size_t)(drow0 + n) * K + k0 + 8 * c) = o;
            csa[j] += ((bf_lo(o.x) + bf_hi(o.x)) + (bf_lo(o.y) + bf_hi(o.y))) + ((bf_lo(o.z) + bf_hi(o.z)) + (bf_lo(o.w) + bf_hi(o.w)));
#pragma unroll
            for (int e = 0; e < 8; ++e) cba[j] += bk[e] * w[e]; }
        LDS_WAIT(); asm volatile("" ::: "memory");
    }
    if (cs) {
#pragma unroll
        for (int j = 0; j < 4; ++j) { float a = csa[j], bb = cba[j];
            a += __shfl_xor(a, 1); a += __shfl_xor(a, 2); a += __shfl_xor(a, 4); bb += __shfl_xor(bb, 1); bb += __shfl_xor(bb, 2); bb += __shfl_xor(bb, 4);
            if (c == 0) { cs[drow0 + (lane >> 3) + 8 * j] = a; cb[drow0 + (lane >> 3) + 8 * j] = bb; } }
    }
}
struct Args { const float* in[25]; float* out; unsigned char* ws; int ph_lo, ph_hi; };
typedef Args Ptrs;
#ifndef PHMASK
#define PHMASK 0xFFFF
#endif
#define PHON(k) ((PHMASK >> (k)) & 1)
__device__ __forceinline__ void convert_layer(const Ptrs& P, int l, LAS unsigned char* lds, int gw, int NGW, int wave, int lane) {
    LAS float* scr = (LAS float*)(lds + RING_OFF + wave * 16384);
    unsigned char* ws = P.ws;
    float* csb = (float*)(ws + WS_CSB);
    constexpr int I_D = 64, I_GU = 352, I_IN = 152, I_OUT = 64, I_LRU = 160;
    constexpr int NITEMS = 2 * I_D + 2 * I_GU + I_IN + I_OUT + I_LRU;
    for (int it = gw; it < NITEMS; it += NGW) {
        int r = it;
        if (r < I_D) { conv_item(P.in[6] + (size_t)l * FF * D, FF, D, 32 * r, (bf16*)(ws + WS_WD1), 32 * r, nullptr, nullptr, 0, nullptr, nullptr, nullptr, scr, lane); continue; } r -= I_D;
        if (r < I_D) { conv_item(P.in[24] + (size_t)l * FF * D, FF, D, 32 * r, (bf16*)(ws + WS_WD2), 32 * r, nullptr, nullptr, 0, nullptr, nullptr, nullptr, scr, lane); continue; } r -= I_D;
        if (r < I_GU) { const int up = r >= 176, rr = up ? r - 176 : r, n0 = 32 * rr, dr = 256 * (n0 >> 7) + (n0 & 127) + 128 * up;
            const float* gg = l ? P.in[20] + (size_t)(l - 1) * D : nullptr; const float* bb = l ? P.in[21] + (size_t)(l - 1) * D : nullptr;
            conv_item(P.in[up ? 5 : 4] + (size_t)l * D * FF, D, FF, n0, (bf16*)(ws + WS_WGU1), dr, gg, gg, D, bb, csb, csb + 16384, scr, lane); continue; } r -= I_GU;
        if (r < I_GU) { const int up = r >= 176, rr = up ? r - 176 : r, n0 = 32 * rr, dr = 256 * (n0 >> 7) + (n0 & 127) + 128 * up;
            conv_item(P.in[up ? 23 : 22] + (size_t)l * D * FF, D, FF, n0, (bf16*)(ws + WS_WGU2), dr, P.in[7] + (size_t)l * D, P.in[7] + (size_t)l * D, D, P.in[8] + (size_t)l * D, csb + 4 * 16384, csb + 5 * 16384, scr, lane); continue; } r -= I_GU;
        if (r < I_IN) { const int n0 = 32 * r; int dr;
            if (n0 < 768) dr = n0; else if (n0 < 1536) dr = ZK + (n0 - 768); else if (n0 < 2304) dr = ZV + (n0 - 1536); else if (n0 < 3584) dr = ZXL + (n0 - 2304); else dr = ZGL + (n0 - 3584);
            conv_item(P.in[9] + (size_t)l * D * NIN, D, NIN, n0, (bf16*)(ws + WS_WIN), dr, P.in[2] + (size_t)l * D, P.in[2] + (size_t)l * D, D, P.in[3] + (size_t)l * D, csb + 2 * 16384, csb + 3 * 16384, scr, lane); continue; } r -= I_IN;
        if (r < I_OUT) { conv_item(P.in[19] + (size_t)l * D * D, D, D, 32 * r, (bf16*)(ws + WS_WOUT), 32 * r, P.in[17] + (size_t)l * AW, P.in[18] + (size_t)l * LW, AW, nullptr, nullptr, nullptr, scr, lane); continue; } r -= I_OUT;
        { const int mat = r >> 2, n0 = 32 * (r & 3), gate = mat / 20, rem = mat % 20;
          conv_item(P.in[gate ? 14 : 12] + ((size_t)l * 20 + rem) * 16384, 128, 128, n0, (bf16*)(ws + WS_LRUW) + (size_t)mat * 16384, n0, nullptr, nullptr, 0, nullptr, nullptr, nullptr, scr, lane); }
    }
}
__device__ __forceinline__ void sincos_d(double r, double& s, double& c) {
    const double r2 = r * r; double ts = r, tc = 1.0; s = r; c = 1.0;
#pragma unroll
    for (int k = 1; k <= 14; ++k) { tc = -tc * r2 / (double)((2 * k - 1) * (2 * k)); ts = -ts * r2 / (double)((2 * k) * (2 * k + 1)); c += tc; s += ts; }
}
__device__ __forceinline__ void prologue(const Ptrs& P, LAS unsigned char* lds, int gtid, int NGT, int gw, int NGW, int wave, int lane) {
    unsigned char* ws = P.ws;
    { f32x2* st0 = (f32x2*)(ws + WS_ST0); for (int i = gtid; i < T; i += NGT) st0[i] = (f32x2){0.f, 2048.0f * (1.0f - 1e-5f)}; }
    { float* v = (float*)(ws + WS_VEC); for (int i = gtid; i < 4096; i += NGT) v[i] = i < 2048 ? 1.f : 0.f; }
    { f32x2* rp = (f32x2*)(ws + WS_ROPE);
      for (int i = gtid; i < 16384 * 8; i += NGT) { const int pos = i >> 3, fi = i & 7;
          const double invf = fi == 0 ? 1.0 : fi == 1 ? 0.19392274474868576 : fi == 2 ? 0.03760603093086393 : fi == 3 ? 0.007292664737217109 : fi == 4 ? 0.001414213562373095 : fi == 5 ? 0.0002742481756762073 : fi == 6 ? 5.318295896944988e-05 : 1.031338537721246e-05;
          const double ang = (double)pos * invf; const double kq = __builtin_rint(ang * 0.15915494309189535); const double rr = ang - kq * 6.283185307179586;
          double s, c; sincos_d(rr, s, c); rp[i] = (f32x2){(float)c, (float)s}; } }
    { bf16* tb = (bf16*)(ws + WS_TB);
      for (size_t i = (size_t)gtid; i < (size_t)T * D / 8; i += NGT) { const size_t e = i * 8; const float* src = e < (size_t)TPR * D ? P.in[0] + e : P.in[1] + (e - (size_t)TPR * D);
          const f32x4 a = *(const f32x4*)src, b2 = *(const f32x4*)(src + 4); v4u o; o.x = pk2(a[0], a[1]); o.y = pk2(a[2], a[3]); o.z = pk2(b2[0], b2[1]); o.w = pk2(b2[2], b2[3]); *(v4u*)(tb + e) = o; } }
    convert_layer(P, 0, lds, gw, NGW, wave, lane);
}

__device__ __forceinline__ void attn_valu_phase(LAS unsigned char* lds, bf16* Z, float* ssq, int blk, int G, int wave, int lane) {
    LAS float* sbuf = (LAS float*)lds + wave * 400;
    const int ks = lane >> 3, dp = lane & 7;
    for (int unit = blk; unit < (T / 64) * 12; unit += G) {
        const int tb = unit / 12, h = unit % 12;
        for (int qi = 0; qi < 8; ++qi) {
            const int tok = 64 * tb + 8 * wave + qi;
            const int s0 = tok < TPR ? (tok & ~4095) : TPR, S = tok < TPR ? 4096 : 16384, pos = tok - s0;
            float q8[8];
            { const v4u w = *(const v4u*)(Z + (size_t)tok * NIN + ZQ + h * 64 + 8 * dp);
              q8[0] = bf_lo(w.x) * 0.125f; q8[1] = bf_hi(w.x) * 0.125f; q8[2] = bf_lo(w.y) * 0.125f; q8[3] = bf_hi(w.y) * 0.125f; q8[4] = bf_lo(w.z) * 0.125f; q8[5] = bf_hi(w.z) * 0.125f; q8[6] = bf_lo(w.w) * 0.125f; q8[7] = bf_hi(w.w) * 0.125f; }
            for (int t = 0; t < 49; ++t) {
                const int kk = 8 * t + ks; const int gq = kk >= 258 ? 2 : (kk >= 129 ? 1 : 0); const int j = kk - 129 * gq - 64; const int kp = pos + j * (1 << (2 * gq));
                const bool valid = kk < 387 && kp >= 0 && kp < S; const int row = s0 + (valid ? kp : pos);
                const v4u w = *(const v4u*)(Z + (size_t)row * NIN + ZK + h * 64 + 8 * dp);
                float d = q8[0] * bf_lo(w.x) + q8[1] * bf_hi(w.x) + q8[2] * bf_lo(w.y) + q8[3] * bf_hi(w.y) + q8[4] * bf_lo(w.z) + q8[5] * bf_hi(w.z) + q8[6] * bf_lo(w.w) + q8[7] * bf_hi(w.w);
                d += __shfl_xor(d, 1); d += __shfl_xor(d, 2); d += __shfl_xor(d, 4);
                if (dp == 0) sbuf[kk] = valid ? d : -1e30f;
            }
            LDS_WAIT(); asm volatile("" ::: "memory");
            float sv[7]; float mx = -1e30f;
#pragma unroll
            for (int p = 0; p < 7; ++p) { const int idx = lane + 64 * p; sv[p] = idx < 392 ? sbuf[idx] : -1e30f; mx = fmaxf(mx, sv[p]); }
#pragma unroll
            for (int o = 1; o < 64; o <<= 1) mx = fmaxf(mx, __shfl_xor(mx, o));
            float sum = 0.f;
#pragma unroll
            for (int p = 0; p < 7; ++p) { const int idx = lane + 64 * p; const float e = sv[p] > -1e29f ? __expf(sv[p] - mx) : 0.f; sum += e; if (idx < 392) sbuf[idx] = e; }
#pragma unroll
            for (int o = 1; o < 64; o <<= 1) sum += __shfl_xor(sum, o);
            LDS_WAIT(); asm volatile("" ::: "memory");
            float a8[8] = {0.f, 0.f, 0.f, 0.f, 0.f, 0.f, 0.f, 0.f};
            for (int t = 0; t < 49; ++t) {
                const int kk = 8 * t + ks; const int gq = kk >= 258 ? 2 : (kk >= 129 ? 1 : 0); const int j = kk - 129 * gq - 64; const int kp = pos + j * (1 << (2 * gq));
                const bool valid = kk < 387 && kp >= 0 && kp < S; const int row = s0 + (valid ? kp : pos);
                const float p = sbuf[kk];
                const v4u w = *(const v4u*)(Z + (size_t)row * NIN + ZV + h * 64 + 8 * dp);
                a8[0] += p * bf_lo(w.x); a8[1] += p * bf_hi(w.x); a8[2] += p * bf_lo(w.y); a8[3] += p * bf_hi(w.y); a8[4] += p * bf_lo(w.z); a8[5] += p * bf_hi(w.z); a8[6] += p * bf_lo(w.w); a8[7] += p * bf_hi(w.w);
            }
            const float inv = 1.0f / sum; float sq = 0.f;
#pragma unroll
            for (int e = 0; e < 8; ++e) { float v = a8[e]; v += __shfl_xor(v, 8); v += __shfl_xor(v, 16); v += __shfl_xor(v, 32); a8[e] = v * inv; sq += a8[e] * a8[e]; }
            sq += __shfl_xor(sq, 1); sq += __shfl_xor(sq, 2); sq += __shfl_xor(sq, 4);
            if (ks == 0) { v4u o; o.x = pk2(a8[0], a8[1]); o.y = pk2(a8[2], a8[3]); o.z = pk2(a8[4], a8[5]); o.w = pk2(a8[6], a8[7]); *(v4u*)(Z + (size_t)tok * NIN + ZQ + h * 64 + 8 * dp) = o; }
            if (lane == 0) unsafeAtomicAdd(ssq + tok, sq);
            LDS_WAIT(); asm volatile("" ::: "memory");
        }
    }
}

template <int MODE>
__device__ __forceinline__ void lru_phase(LAS unsigned char* lds, int blk, int G, int tid, int lane, int wave, bf16* Z, const bf16* LWT, const float* convw, const float* convb, const float* ba, const float* bx, const float* lam, float* tot, float* ssq) {
    LAS float* xcf = (LAS float*)lds;
    LAS bf16* xcb = (LAS bf16*)(lds + 33792);
    LAS float* hf = (LAS float*)(lds + 33792 + 17408);
    LAS float* hbw = (LAS float*)(lds + 33792 + 17408 + 33792);
    const int dir = wave >> 2, dbase = 32 * (wave & 3), c = lane & 15, g = lane >> 4;
    for (int unit = blk; unit < NCHUNK * 10; unit += G) {
        const int ck = unit / 10, nb = unit % 10;
        const int tok0 = LCH * ck; const int s0 = tok0 < TPR ? (tok0 & ~4095) : TPR; const int send = tok0 < TPR ? s0 + 4096 : T;
        __syncthreads();
        { const int cp = tid & 63, ch = 128 * nb + 2 * cp;
          float w0[4], w1[4];
#pragma unroll
          for (int j = 0; j < 4; ++j) { w0[j] = convw[j * LW + ch]; w1[j] = convw[j * LW + ch + 1]; }
          const float b0 = convb[ch], b1 = convb[ch + 1];
#pragma unroll
          for (int i = 0; i < 8; ++i) { const int tt = (tid >> 6) + 8 * i; float a0 = 0.f, a1 = 0.f;
#pragma unroll
              for (int j = 0; j < 4; ++j) { const int row = tok0 + tt + j - 2; if (row >= s0 && row < send) { const unsigned w = *(const unsigned*)(Z + (size_t)row * NIN + ZXL + ch); a0 += bf_lo(w) * w0[j]; a1 += bf_hi(w) * w1[j]; } }
              a0 += b0; a1 += b1;
              xcf[tt * 132 + 2 * cp] = a0; xcf[tt * 132 + 2 * cp + 1] = a1; *(LAS unsigned*)(xcb + tt * 136 + 2 * cp) = pk2(a0, a1); } }
        __syncthreads();
        float sp8[2], bav[2], bxv[2], C[2] = {0.f, 0.f}, Atot[2] = {1.f, 1.f}; bf16x8 Bfa[2][4], Bfx[2][4];
#pragma unroll
        for (int nt = 0; nt < 2; ++nt) { const int dl = dbase + 16 * nt + c, ch = 128 * nb + dl;
            sp8[nt] = 8.0f * log1pf(expf(-lam[dir * LW + ch])); bav[nt] = ba[dir * LW + ch]; bxv[nt] = bx[dir * LW + ch];
            const bf16* wa = LWT + ((size_t)((0 * 2 + dir) * 10 + nb) * 128 + dl) * 128; const bf16* wx = LWT + ((size_t)((1 * 2 + dir) * 10 + nb) * 128 + dl) * 128;
#pragma unroll
            for (int ks = 0; ks < 4; ++ks) { Bfa[nt][ks] = *(const bf16x8*)(wa + 32 * ks + 8 * g); Bfx[nt][ks] = *(const bf16x8*)(wx + 32 * ks + 8 * g); } }
        if (MODE == 1) {
            const int cfirst = s0 / LCH, clast = send / LCH - 1; const int n = dir ? (clast - ck) : (ck - cfirst); const int q = (n + 3) >> 2, i0 = g * q, i1 = (i0 + q) < n ? (i0 + q) : n;
#pragma unroll
            for (int nt = 0; nt < 2; ++nt) { const int ch = 128 * nb + dbase + 16 * nt + c; float FA = 1.f, FH = 0.f;
                for (int i = i0; i < i1; i += 8) { f32x2 v[8];
#pragma unroll
                    for (int e = 0; e < 8; ++e) { const int ii = (i + e) < i1 ? (i + e) : (i1 - 1); const int kc = dir ? clast - ii : cfirst + ii; v[e] = *(const f32x2*)(tot + (((size_t)kc * 2 + dir) * LW + ch) * 2); }
#pragma unroll
                    for (int e = 0; e < 8; ++e) if ((i + e) < i1) { FH = v[e].x * FH + v[e].y; FA = v[e].x * FA; } }
                float Cc = 0.f;
#pragma unroll
                for (int gg = 0; gg < 4; ++gg) { const float A_g = __shfl(FA, c + 16 * gg), H_g = __shfl(FH, c + 16 * gg); Cc = A_g * Cc + H_g; }
                C[nt] = Cc; }
        }
        for (int it = 0; it < LCH / 16; ++it) { const int mt = dir ? (LCH / 16 - 1 - it) : it;
            bf16x8 Af[4];
#pragma unroll
            for (int ks = 0; ks < 4; ++ks) Af[ks] = *(const LAS bf16x8*)(xcb + (16 * mt + c) * 136 + 32 * ks + 8 * g);
#pragma unroll
            for (int nt = 0; nt < 2; ++nt) { f32x4 aa = {0.f, 0.f, 0.f, 0.f}, ax = {0.f, 0.f, 0.f, 0.f};
#pragma unroll
                for (int ks = 0; ks < 4; ++ks) { aa = __builtin_amdgcn_mfma_f32_16x16x32_bf16(Af[ks], Bfa[nt][ks], aa, 0, 0, 0); ax = __builtin_amdgcn_mfma_f32_16x16x32_bf16(Af[ks], Bfx[nt][ks], ax, 0, 0, 0); }
                float av[4], uv[4];
#pragma unroll
                for (int j = 0; j < 4; ++j) { const int tl = 16 * mt + 4 * g + j; const float r = sigmoid_f(aa[j] + bav[nt]), ig = sigmoid_f(ax[j] + bxv[nt]); const float la = -sp8[nt] * r;
                    av[j] = __expf(la); uv[j] = sqrtf(-expm1f(2.0f * la)) * ig * xcf[tl * 132 + dbase + 16 * nt + c]; }
                float Pp = 1.f, Hh = 0.f, pj[4], hj[4];
#pragma unroll
                for (int jj = 0; jj < 4; ++jj) { const int j = dir ? 3 - jj : jj; Hh = av[j] * Hh + uv[j]; Pp *= av[j]; pj[j] = Pp; hj[j] = Hh; }
                float IA = Pp, IH = Hh;
                { const int src = (dir ? lane + 16 : lane - 16) & 63; const bool ok = dir ? (g <= 2) : (g >= 1); const float sA = __shfl(IA, src), sH = __shfl(IH, src); if (ok) { IH = IA * sH + IH; IA = IA * sA; } }
                { const int src = (dir ? lane + 32 : lane - 32) & 63; const bool ok = dir ? (g <= 1) : (g >= 2); const float sA = __shfl(IA, src), sH = __shfl(IH, src); if (ok) { IH = IA * sH + IH; IA = IA * sA; } }
                const float after = IA * C[nt] + IH;
                float Xin; { const int src = (dir ? lane + 16 : lane - 16) & 63; const bool ok = dir ? (g <= 2) : (g >= 1); const float s = __shfl(after, src); Xin = ok ? s : C[nt]; }
                const int lastl = (dir ? 0 : 48) + c;
                const float Cn = __shfl(after, lastl);
                if (MODE == 0) Atot[nt] *= __shfl(IA, lastl);
                C[nt] = Cn;
                if (MODE == 1) { LAS float* hd = dir ? hbw : hf;
#pragma unroll
                    for (int j = 0; j < 4; ++j) hd[(16 * mt + 4 * g + j) * 132 + dbase + 16 * nt + c] = pj[j] * Xin + hj[j]; }
            }
        }
        if (MODE == 0) { if (g == 0) {
#pragma unroll
            for (int nt = 0; nt < 2; ++nt) { const int ch = 128 * nb + dbase + 16 * nt + c; *(f32x2*)(tot + (((size_t)ck * 2 + dir) * LW + ch) * 2) = (f32x2){Atot[nt], C[nt]}; } } }
        if (MODE == 1) {
            __syncthreads();
#pragma unroll
            for (int i = 0; i < 2; ++i) { const int itx = tid + 512 * i, tt = itx >> 4, cg = itx & 15;
                const f32x4 f0 = *(const LAS f32x4*)(hf + tt * 132 + 8 * cg), f1 = *(const LAS f32x4*)(hf + tt * 132 + 8 * cg + 4), b0 = *(const LAS f32x4*)(hbw + tt * 132 + 8 * cg), b1 = *(const LAS f32x4*)(hbw + tt * 132 + 8 * cg + 4);
                bf16* gp = Z + (size_t)(tok0 + tt) * NIN + ZGL + 128 * nb + 8 * cg; const v4u gw = *(const v4u*)gp;
                float rv[8];
                rv[0] = (f0[0] + b0[0]) * gelu_tanh(bf_lo(gw.x)); rv[1] = (f0[1] + b0[1]) * gelu_tanh(bf_hi(gw.x)); rv[2] = (f0[2] + b0[2]) * gelu_tanh(bf_lo(gw.y)); rv[3] = (f0[3] + b0[3]) * gelu_tanh(bf_hi(gw.y));
                rv[4] = (f1[0] + b1[0]) * gelu_tanh(bf_lo(gw.z)); rv[5] = (f1[1] + b1[1]) * gelu_tanh(bf_hi(gw.z)); rv[6] = (f1[2] + b1[2]) * gelu_tanh(bf_lo(gw.w)); rv[7] = (f1[3] + b1[3]) * gelu_tanh(bf_hi(gw.w));
                float sq = 0.f;
#pragma unroll
                for (int e = 0; e < 8; ++e) sq += rv[e] * rv[e];
                sq += __shfl_xor(sq, 1); sq += __shfl_xor(sq, 2); sq += __shfl_xor(sq, 4); sq += __shfl_xor(sq, 8);
                v4u o; o.x = pk2(rv[0], rv[1]); o.y = pk2(rv[2], rv[3]); o.z = pk2(rv[4], rv[5]); o.w = pk2(rv[6], rv[7]); *(v4u*)gp = o;
                if (cg == 0) unsafeAtomicAdd(ssq + tok0 + tt, sq); }
        }
    }
    __syncthreads();
}

__device__ __forceinline__ void rmsnorm_phase(bf16* Z, const float* ssq_att, const float* ssq_rec, int gw, int NGW, int lane) {
    for (int r = gw; r < T; r += NGW) {
        const float ra = rsqrtf(ssq_att[r] * (1.0f / AW) + 1e-5f), rr = rsqrtf(ssq_rec[r] * (1.0f / LW) + 1e-5f);
#pragma unroll
        for (int i = 0; i < 4; ++i) { const int col = 8 * (lane + 64 * i); const float sc = col < AW ? ra : rr; bf16* p = Z + (size_t)r * NIN + col; const v4u w = *(const v4u*)p;
            v4u o; o.x = pk2(bf_lo(w.x) * sc, bf_hi(w.x) * sc); o.y = pk2(bf_lo(w.y) * sc, bf_hi(w.y) * sc); o.z = pk2(bf_lo(w.z) * sc, bf_hi(w.z) * sc); o.w = pk2(bf_lo(w.w) * sc, bf_hi(w.w) * sc); *(v4u*)p = o; }
    }
}
__device__ __forceinline__ void final_ln_phase(float* out, const float* st, const float* g, const float* b, int gw, int NGW, int lane) {
    for (int r = gw; r < T; r += NGW) {
        const f32x2 s = *(const f32x2*)(st + 2 * (size_t)r); const float mu = s.x * (1.0f / 2048.0f); const float rstd = rsqrtf(fmaxf(s.y * (1.0f / 2048.0f) - mu * mu, 0.f) + 1e-5f);
#pragma unroll
        for (int i = 0; i < 8; ++i) { const int col = 4 * (lane + 64 * i); float* p = out + (size_t)r * D + col; const f32x4 t4 = *(const f32x4*)p, g4 = *(const f32x4*)(g + col), b4 = *(const f32x4*)(b + col);
            *(f32x4*)p = (t4 - mu) * rstd * g4 + b4; }
    }
}

__global__ void __launch_bounds__(NWAVES * 64, 2) enc_fwd(Args args) {
    extern __shared__ __attribute__((aligned(16))) unsigned char lds_raw[];
    LAS unsigned char* lds = (LAS unsigned char*)lds_raw;
    volatile LAS unsigned* MISC = (volatile LAS unsigned*)(lds + MISC_OFF);
    const int tid = threadIdx.x, lane = tid & 63, wave = __builtin_amdgcn_readfirstlane(tid >> 6);
    const int G = gridDim.x, blk = blockIdx.x;
    const int NGW = G * NWAVES, NGT = G * NWAVES * 64; (void)lane; (void)wave;
    unsigned char* ws = args.ws;
    const Args& P = args;
    for (int u = tid; u < (LDS_BYTES - LDSCTL_OFF) / 4; u += NWAVES * 64) ((LAS unsigned*)(lds + LDSCTL_OFF))[u] = 0u;
    __syncthreads();
    XcdBarrier bar = xcd_barrier_post((unsigned*)(ws + WS_CTL) + CW_BAR, MISC + 8);
    int ph = 0;
    const int lo = args.ph_lo, hi = args.ph_hi;
#define PHASE_BEGIN(k) if (ph >= lo && ph < hi) { if (PHON(k)) { int tidx = tid; asm volatile("" : "+s"(ws), "+s"(out), "+v"(tidx)); const int lanex = tidx & 63, wavex = __builtin_amdgcn_readfirstlane(tidx >> 6), gwx = blk * NWAVES + wavex, gtidx = blk * (NWAVES * 64) + tidx; (void)lanex; (void)gwx; (void)gtidx;
#define PHASE_END   } if (ph + 1 < hi) xcd_barrier(bar); } ++ph;

    float* out = args.out;

    PHASE_BEGIN(0) prologue(P, lds, gtidx, NGT, gwx, NGW, wavex, lanex); PHASE_END

#pragma unroll 1
    for (int l = 0; l < 2; ++l) {
#define TB ((bf16*)(ws + WS_TB))
#define HB ((bf16*)(ws + WS_BIG))
#define Z ((bf16*)(ws + WS_BIG))
#define csb ((float*)(ws + WS_CSB))
#define ones ((const float*)(ws + WS_VEC))
#define zeros (ones + 2048)
#define st_prev (l ? (const float*)(ws + WS_ST + 2 * STAT_BYTES) : (const float*)(ws + WS_ST0))
#define g_prev (l ? P.in[20] : ones)
#define b_prev (l ? P.in[21] : zeros)
#define st1 ((float*)(ws + WS_ST + (size_t)(3 * l + 0) * STAT_BYTES))
#define st2 ((float*)(ws + WS_ST + (size_t)(3 * l + 1) * STAT_BYTES))
#define st3 ((float*)(ws + WS_ST + (size_t)(3 * l + 2) * STAT_BYTES))
#define ssq_att ((float*)(ws + WS_SSQ + (size_t)(2 * l) * SSQ_BYTES))
#define ssq_rec ((float*)(ws + WS_SSQ + (size_t)(2 * l + 1) * SSQ_BYTES))
        PHASE_BEGIN(1) { pg8::Gemm gm{TB, (const bf16*)(ws + WS_WGU1), T, 2 * FF, D, D}; pg8::StaticOrder S; S.init(T, 2 * FF, G, blk);
            pg8::EpiGU E{HB, st_prev, csb, csb + 16384};
            pg8::gemm_phase<pg8::EpiGU, pg8::StaticOrder, PG8_ALIGN, PG8_SP2>(lds + RING_OFF, gm, S, E, tidx); } PHASE_END
        PHASE_BEGIN(2) { pg8::Gemm gm{HB, (const bf16*)(ws + WS_WD1), T, D, FF, FF}; pg8::StaticOrder S; S.init(T, D, G, blk);
            pg8::EpiRes E{l ? out : P.in[0], l ? out : P.in[1] - (size_t)TPR * D, out, TB, st_prev, g_prev, b_prev, st1, 0.5f};
            pg8::gemm_phase<pg8::EpiRes, pg8::StaticOrder, PG8_ALIGN, PG8_SP2>(lds + RING_OFF, gm, S, E, tidx); } PHASE_END
        PHASE_BEGIN(3) { pg8::Gemm gm{TB, (const bf16*)(ws + WS_WIN), T, NIN, D, D}; pg8::StaticOrder S; S.init(T, NIN, G, blk);
            pg8::EpiIn E{Z, st1, csb + 2 * 16384, csb + 3 * 16384, (const float*)(ws + WS_ROPE)};
            pg8::gemm_phase<pg8::EpiIn, pg8::StaticOrder, PG8_ALIGN, PG8_SP2>(lds + RING_OFF, gm, S, E, tidx); } PHASE_END
        PHASE_BEGIN(4) attn_valu_phase(lds, Z, ssq_att, blk, G, wavex, lanex);
            if (PHON(5)) lru_phase<0>(lds, blk, G, tidx, lanex, wavex, Z, (const bf16*)(ws + WS_LRUW), P.in[10] + (size_t)l * 4 * LW, P.in[11] + (size_t)l * LW, P.in[13] + (size_t)l * 2 * LW, P.in[15] + (size_t)l * 2 * LW, P.in[16] + (size_t)l * 2 * LW, (float*)(ws + WS_TOT), ssq_rec); PHASE_END
        PHASE_BEGIN(6) lru_phase<1>(lds, blk, G, tidx, lanex, wavex, Z, (const bf16*)(ws + WS_LRUW), P.in[10] + (size_t)l * 4 * LW, P.in[11] + (size_t)l * LW, P.in[13] + (size_t)l * 2 * LW, P.in[15] + (size_t)l * 2 * LW, P.in[16] + (size_t)l * 2 * LW, (float*)(ws + WS_TOT), ssq_rec); PHASE_END
        PHASE_BEGIN(7) rmsnorm_phase(Z, ssq_att, ssq_rec, gwx, NGW, lanex); PHASE_END
        PHASE_BEGIN(8) { pg8::Gemm gm{Z, (const bf16*)(ws + WS_WOUT), T, D, D, NIN}; pg8::StaticOrder S; S.init(T, D, G, blk);
            pg8::EpiRes E{out, out, out, TB, st1, P.in[2] + (size_t)l * D, P.in[3] + (size_t)l * D, st2, 1.0f};
            pg8::gemm_phase<pg8::EpiRes, pg8::StaticOrder, PG8_ALIGN, PG8_SP2>(lds + RING_OFF, gm, S, E, tidx); } PHASE_END
        PHASE_BEGIN(1) { pg8::Gemm gm{TB, (const bf16*)(ws + WS_WGU2), T, 2 * FF, D, D}; pg8::StaticOrder S; S.init(T, 2 * FF, G, blk);
            pg8::EpiGU E{HB, st2, csb + 4 * 16384, csb + 5 * 16384};
            pg8::gemm_phase<pg8::EpiGU, pg8::StaticOrder, PG8_ALIGN, PG8_SP2>(lds + RING_OFF, gm, S, E, tidx); } PHASE_END
        PHASE_BEGIN(2) { pg8::Gemm gm{HB, (const bf16*)(ws + WS_WD2), T, D, FF, FF}; pg8::StaticOrder S; S.init(T, D, G, blk);
            pg8::EpiRes E{out, out, out, TB, st2, P.in[7] + (size_t)l * D, P.in[8] + (size_t)l * D, st3, 0.5f};
            pg8::gemm_phase<pg8::EpiRes, pg8::StaticOrder, PG8_ALIGN, PG8_SP2>(lds + RING_OFF, gm, S, E, tidx); } PHASE_END
        if (l == 0) { PHASE_BEGIN(9) convert_layer(P, 1, lds, gwx, NGW, wavex, lanex); PHASE_END }
    }
    PHASE_BEGIN(10) final_ln_phase(out, (const float*)(ws + WS_ST + 5 * STAT_BYTES), P.in[20] + D, P.in[21] + D, gwx, NGW, lanex); PHASE_END
#undef PHASE_BEGIN
#undef PHASE_END
#undef TB
#undef HB
#undef Z
#undef csb
#undef ones
#undef zeros
#undef st_prev
#undef g_prev
#undef b_prev
#undef st1
#undef st2
#undef st3
#undef ssq_att
#undef ssq_rec
}
constexpr int N_PHASES = 1 + 9 + 1 + 9 + 1;

#ifndef MK_N_LAUNCHES
#define MK_N_LAUNCHES 1
#endif
extern "C" void kernel_launch(void* const* d_in, const int* in_sizes, int n_in, void* d_out, int out_size, void* d_ws, size_t ws_size, hipStream_t stream) {
    static int grid = 0;
    if (grid == 0) {
        if (n_in != 25 || out_size != T * D || ws_size < WS_END) { fprintf(stderr, "kernel_launch: unexpected shapes (n_in %d, out %d, ws %zu)\n", n_in, out_size, ws_size); grid = -1; return; }
        int dev = 0, cus = 0, per_cu = 0;
        if (hipGetDevice(&dev) != hipSuccess || hipDeviceGetAttribute(&cus, hipDeviceAttributeMultiprocessorCount, dev) != hipSuccess) { grid = -1; return; }
        if (hipFuncSetAttribute((const void*)enc_fwd, hipFuncAttributeMaxDynamicSharedMemorySize, LDS_BYTES) != hipSuccess) { grid = -1; return; }
        if (hipOccupancyMaxActiveBlocksPerMultiprocessor(&per_cu, (const void*)enc_fwd, NWAVES * 64, LDS_BYTES) != hipSuccess || per_cu < 1) fprintf(stderr, "kernel_launch: occupancy query reports %d\n", per_cu);
        (void)hipGetLastError();
        grid = cus;
    }
    if (grid < 0) return;
    if (hipMemsetAsync((char*)d_ws + WS_CTL, 0, CTL_ZERO_BYTES, stream) != hipSuccess) return;
    Args a{};
    for (int i = 0; i < 25; ++i) a.in[i] = (const float*)d_in[i];
    a.out = (float*)d_out; a.ws = (unsigned char*)d_ws;
#if MK_N_LAUNCHES == 1
    a.ph_lo = 0; a.ph_hi = N_PHASES;
    hipLaunchKernelGGL(enc_fwd, dim3(grid), dim3(NWAVES * 64), LDS_BYTES, stream, a);
#else
    for (int p = 0; p < N_PHASES; ++p) { a.ph_lo = p; a.ph_hi = p + 1; hipLaunchKernelGGL(enc_fwd, dim3(grid), dim3(NWAVES * 64), LDS_BYTES, stream, a); }
#endif
}
```

```cpp
#include <hip/hip_runtime.h>
#include <cstdio>
#include <cstdint>
namespace pg8 {
#define PG8_LAS __attribute__((address_space(3)))
typedef unsigned short bf16_t;
typedef short bf16x8 __attribute__((ext_vector_type(8)));
typedef float f32x4 __attribute__((ext_vector_type(4)));
typedef unsigned u32x4 __attribute__((ext_vector_type(4)));
constexpr int BM = 256, BK = 64, HALF = 128, HTB = HALF * BK * 2  , STAGE_BYTES = 8 * HTB, NXCD = 8, WGM = 8;

__host__ __device__ __forceinline__ int lds_byte(int r, int c) { const int st = (r >> 4) * 2 + (c >> 5), rr = r & 15, cc = c & 31, ob = rr * 64 + cc * 2; return st * 1024 + (ob ^ (((ob >> 9) & 1) << 5)); }
__host__ __device__ __forceinline__ void stage_rc(int b, int& R, int& C) { const int st = b / 1024, sb = b % 1024, swz = sb ^ (((sb >> 9) & 1) << 5); R = (st >> 1) * 16 + swz / 64; C = (st & 1) * 32 + (swz % 64) / 2; }
__host__ __device__ __forceinline__ int perm32(int rho) { const int n = rho >> 4, i = rho & 15; return 8 * (i >> 2) + 4 * n + (i & 3); }

struct Unit { int pm, pn; };
struct Gemm { const bf16_t* A; const bf16_t* Bt; int M, N, K, lda; };

struct StaticOrder {
    int nM, nN, nwg, G, c;
    __host__ __device__ void init(int M, int N, int G_, int c_) { nM = M / BM; nN = N / BM; nwg = nM * nN; G = G_; c = c_; }
    __host__ __device__ bool next(int i, Unit& u) const {
        const long L = (long)i * G + c; if (L >= nwg) return false;
        int wgid = (int)L; { const int q = nwg / NXCD, r = nwg % NXCD, xcd = wgid % NXCD, off = wgid / NXCD; wgid = (xcd < r ? xcd * (q + 1) : r * (q + 1) + (xcd - r) * q) + off; }
        const int nig = WGM * nN, gid = wgid / nig, fm = gid * WGM, gsz = (nM - fm) < WGM ? (nM - fm) : WGM;
        u.pm = fm + ((wgid % nig) % gsz); u.pn = (wgid % nig) / gsz; return true;
    }
    __device__ __forceinline__ void a_ready(const Unit&) const {}
    __device__ __forceinline__ void done(const Unit&) const {}
};


__device__ __forceinline__ unsigned cvt_pk_bf16(float lo, float hi) { unsigned r; asm volatile("v_cvt_pk_bf16_f32 %0, %1, %2" : "=v"(r) : "v"(lo), "v"(hi)); return r; }
typedef float f32x2 __attribute__((ext_vector_type(2)));
typedef unsigned u32x2 __attribute__((ext_vector_type(2)));
constexpr float ALPHA_RES = 1.41421356237309515f;
__device__ __forceinline__ void row_stats(const float* st, int r, float& mu, float& rstd) {
    const f32x2 s = *(const f32x2*)(st + 2 * (size_t)r);
    mu = s.x * (1.0f / 2048.0f); const float var = s.y * (1.0f / 2048.0f) - mu * mu;
    rstd = rsqrtf(fmaxf(var, 0.0f) + 1e-5f);
}
__device__ __forceinline__ float silu_f(float v) { return v * __builtin_amdgcn_rcpf(1.0f + __expf(-v)); }

struct EpiGU {
    static constexpr bool PERM = true, AFTER_DRAIN = false;
    bf16_t* H; const float* st; const float* cs; const float* cb;
    __device__ __forceinline__ void operator()(const f32x4 (&acc)[2][2][4][2], const Unit& u, int wr, int wc, int fr, int fq) const {
        const int row0 = u.pm * BM + wr * 64 + fr, rb = u.pn * BM + wc * 32 + 8 * fq, hc = u.pn * 128 + wc * 32 + 8 * fq;
        f32x4 csv[2][2], cbv[2][2];
#pragma unroll
        for (int bj = 0; bj < 2; ++bj)
#pragma unroll
            for (int n = 0; n < 2; ++n) { csv[bj][n] = *(const f32x4*)(cs + rb + bj * HALF + 4 * n); cbv[bj][n] = *(const f32x4*)(cb + rb + bj * HALF + 4 * n); }
#pragma unroll
        for (int ai = 0; ai < 2; ++ai)
#pragma unroll
            for (int m = 0; m < 4; ++m) { const int r = row0 + ai * HALF + m * 16; float mu, rstd; row_stats(st, r, mu, rstd);
                f32x4 hv[2];
#pragma unroll
                for (int n = 0; n < 2; ++n) { const f32x4 gt = (acc[ai][0][m][n] - csv[0][n] * mu) * rstd + cbv[0][n], up = (acc[ai][1][m][n] - csv[1][n] * mu) * rstd + cbv[1][n];
#pragma unroll
                    for (int j = 0; j < 4; ++j) hv[n][j] = silu_f(gt[j]) * up[j]; }
                u32x4 w; w.x = cvt_pk_bf16(hv[0][0], hv[0][1]); w.y = cvt_pk_bf16(hv[0][2], hv[0][3]); w.z = cvt_pk_bf16(hv[1][0], hv[1][1]); w.w = cvt_pk_bf16(hv[1][2], hv[1][3]);
                *(u32x4*)(H + (size_t)r * 5632 + hc) = w; asm volatile("" ::: "memory"); }
    }
};
struct EpiIn {
    static constexpr bool PERM = true, AFTER_DRAIN = false;
    bf16_t* Z; const float* st; const float* cs; const float* cb; const float* rope;
    __device__ __forceinline__ void operator()(const f32x4 (&acc)[2][2][4][2], const Unit& u, int wr, int wc, int fr, int fq) const {
        const int row0 = u.pm * BM + wr * 64 + fr, rb = u.pn * BM + wc * 32 + 8 * fq;
        const bool rot = (u.pn < 3 || (u.pn >= 8 && u.pn < 11)) && ((wc & 1) == 0);
        f32x4 csv[2][2], cbv[2][2];
#pragma unroll
        for (int bj = 0; bj < 2; ++bj)
#pragma unroll
            for (int n = 0; n < 2; ++n) { csv[bj][n] = *(const f32x4*)(cs + rb + bj * HALF + 4 * n); cbv[bj][n] = *(const f32x4*)(cb + rb + bj * HALF + 4 * n); }
#pragma unroll
        for (int ai = 0; ai < 2; ++ai)
#pragma unroll
            for (int m = 0; m < 4; ++m) { const int r = row0 + ai * HALF + m * 16; float mu, rstd; row_stats(st, r, mu, rstd);
                f32x4 cs0 = {1.f, 0.f, 1.f, 0.f}, cs1 = cs0, cs2 = cs0, cs3 = cs0;
                if (rot && fq < 2) { const int pos = r < 32768 ? (r & 4095) : (r - 32768); const f32x4* rp = (const f32x4*)(rope + (size_t)pos * 16); cs0 = rp[0]; cs1 = rp[1]; cs2 = rp[2]; cs3 = rp[3]; }
                const float sg = (fq == 0) ? -1.f : 1.f;
#pragma unroll
                for (int bj = 0; bj < 2; ++bj) { f32x4 v0 = (acc[ai][bj][m][0] - csv[bj][0] * mu) * rstd + cbv[bj][0], v1 = (acc[ai][bj][m][1] - csv[bj][1] * mu) * rstd + cbv[bj][1];
                    if (rot) { f32x4 p0, p1;
#pragma unroll
                        for (int j = 0; j < 4; ++j) { p0[j] = __shfl_xor(v0[j], 16); p1[j] = __shfl_xor(v1[j], 16); }
                        if (fq < 2) {
                            v0[0] = v0[0] * cs0[0] + sg * p0[0] * cs0[1]; v0[1] = v0[1] * cs0[2] + sg * p0[1] * cs0[3]; v0[2] = v0[2] * cs1[0] + sg * p0[2] * cs1[1]; v0[3] = v0[3] * cs1[2] + sg * p0[3] * cs1[3];
                            v1[0] = v1[0] * cs2[0] + sg * p1[0] * cs2[1]; v1[1] = v1[1] * cs2[2] + sg * p1[1] * cs2[3]; v1[2] = v1[2] * cs3[0] + sg * p1[2] * cs3[1]; v1[3] = v1[3] * cs3[2] + sg * p1[3] * cs3[3]; } }
                    u32x4 w; w.x = cvt_pk_bf16(v0[0], v0[1]); w.y = cvt_pk_bf16(v0[2], v0[3]); w.z = cvt_pk_bf16(v1[0], v1[1]); w.w = cvt_pk_bf16(v1[2], v1[3]);
                    *(u32x4*)(Z + (size_t)r * 4864 + rb + bj * HALF) = w; } asm volatile("" ::: "memory"); }
    }
};
struct EpiRes {
    static constexpr bool PERM = false, AFTER_DRAIN = false;
    const float* Xlo; const float* Xhi; float* OUT; bf16_t* TB; const float* st; const float* g; const float* b; float* st_out; float sc;
    __device__ __forceinline__ void operator()(const f32x4 (&acc)[2][2][4][2], const Unit& u, int wr, int wc, int fr, int fq) const {
        const int row0 = u.pm * BM + wr * 64 + fr, col0 = u.pn * BM + wc * 32 + 4 * fq;
        const float* X = (u.pm < 128) ? Xlo : Xhi;
        f32x4 gv[2][2], bv[2][2];
#pragma unroll
        for (int bj = 0; bj < 2; ++bj)
#pragma unroll
            for (int n = 0; n < 2; ++n) { gv[bj][n] = *(const f32x4*)(g + col0 + bj * HALF + n * 16); bv[bj][n] = *(const f32x4*)(b + col0 + bj * HALF + n * 16); }
#pragma unroll
        for (int ai = 0; ai < 2; ++ai)
#pragma unroll
            for (int m = 0; m < 4; ++m) { const int r = row0 + ai * HALF + m * 16; float mu, rstd; row_stats(st, r, mu, rstd);
                const size_t off = (size_t)r * 2048 + col0; float s = 0.f, q = 0.f;
#pragma unroll
                for (int bj = 0; bj < 2; ++bj)
#pragma unroll
                    for (int n = 0; n < 2; ++n) { const f32x4 t4 = *(const f32x4*)(X + off + bj * HALF + n * 16);
                        const f32x4 xn = (t4 - mu) * rstd * gv[bj][n] + bv[bj][n];
                        const f32x4 o = xn * ALPHA_RES + acc[ai][bj][m][n] * sc;
                        *(f32x4*)(OUT + off + bj * HALF + n * 16) = o;
                        u32x2 w; w.x = cvt_pk_bf16(o[0], o[1]); w.y = cvt_pk_bf16(o[2], o[3]); *(u32x2*)(TB + off + bj * HALF + n * 16) = w;
                        s += (o[0] + o[1]) + (o[2] + o[3]); q += (o[0] * o[0] + o[1] * o[1]) + (o[2] * o[2] + o[3] * o[3]); }
                s += __shfl_xor(s, 16); s += __shfl_xor(s, 32); q += __shfl_xor(q, 16); q += __shfl_xor(q, 32);
                if (fq == 0) { unsafeAtomicAdd(st_out + 2 * (size_t)r, s); unsafeAtomicAdd(st_out + 2 * (size_t)r + 1, q); }
                asm volatile("" ::: "memory"); }
    }
};

template <class Epi, class Sched, bool ALIGN_EPI = false, bool SP2 = false>
__device__ __forceinline__ void gemm_phase(PG8_LAS unsigned char* lds, const Gemm g, const Sched& S, const Epi& E, const int tid) {
    const int wid = __builtin_amdgcn_readfirstlane(tid >> 6), lane = tid & 63, wr = wid >> 2, wc = wid & 3, fr = lane & 15, fq = lane >> 4;
    const int K = g.K, nt = K / BK;
    unsigned voffA[2], voffB[2];
#pragma unroll
    for (int i = 0; i < 2; ++i) { int R, C; stage_rc(tid * 16 + i * 8192, R, C); const int Rb = Epi::PERM ? ((R & ~31) + perm32(R & 31)) : R;
        voffA[i] = (unsigned)(R * g.lda + C) * 2u; voffB[i] = (unsigned)(Rb * K + C) * 2u; }
    const size_t kstep = (size_t)(BK * 2);
    const size_t hstep = (size_t)HALF * K * 2;
    const size_t tstep = 2 * hstep; const size_t hstepA = (size_t)HALF * g.lda * 2, tstepA = 2 * hstepA;
    const unsigned ldsw = (unsigned)wid * 1024u;
    const int aoff = lds_byte(wr * 64 + fr, fq * 8), boff = lds_byte(wc * 32 + fr, fq * 8);
#define PG8_SA(b, h) (((b) * 2 + (h)) * HTB)
#define PG8_SB(b, h) ((4 + (b) * 2 + (h)) * HTB)
#define PG8_STAGE(bufoff, gbase, voff) do { _Pragma("unroll") for (int _i = 0; _i < 2; ++_i) \
        __builtin_amdgcn_global_load_lds((const unsigned*)((const char*)(gbase) + (voff)[_i]), (PG8_LAS unsigned*)(lds + (bufoff) + ldsw + _i * 8192), 16, 0, 0); } while (0)
#define PG8_LDA(dst, b, h) do { _Pragma("unroll") for (int m = 0; m < 4; ++m) _Pragma("unroll") for (int k = 0; k < 2; ++k) dst[m][k] = *(const PG8_LAS bf16x8*)(lds + PG8_SA(b, h) + aoff + m * 2048 + k * 1024); } while (0)
#define PG8_LDB(dst, b, h) do { _Pragma("unroll") for (int n = 0; n < 2; ++n) _Pragma("unroll") for (int k = 0; k < 2; ++k) dst[n][k] = *(const PG8_LAS bf16x8*)(lds + PG8_SB(b, h) + boff + n * 2048 + k * 1024); } while (0)
#define PG8_MMA(ai, bj, At, Bt) do { __builtin_amdgcn_s_setprio(1); _Pragma("unroll") for (int m = 0; m < 4; ++m) _Pragma("unroll") for (int n = 0; n < 2; ++n) _Pragma("unroll") for (int k = 0; k < 2; ++k) \
        acc[ai][bj][m][n] = __builtin_amdgcn_mfma_f32_16x16x32_bf16(Bt[n][k], At[m][k], acc[ai][bj][m][n], 0, 0, 0); __builtin_amdgcn_s_setprio(0); } while (0)
#define PG8_WAIT_V(n) asm volatile("s_waitcnt vmcnt(" #n ")" ::: "memory")
#define PG8_WAIT_L(n) asm volatile("s_waitcnt lgkmcnt(" #n ")" ::: "memory")
#define PG8_BAR __builtin_amdgcn_s_barrier()
#define PG8_SCHED __builtin_amdgcn_sched_barrier(0)
    Unit cur, nxt; int ui = 0;
    if (!S.next(0, cur)) return;
    f32x4 acc[2][2][4][2];
#pragma unroll
    for (int a = 0; a < 2; ++a)
#pragma unroll
        for (int b = 0; b < 2; ++b)
#pragma unroll
            for (int m = 0; m < 4; ++m)
#pragma unroll
                for (int n = 0; n < 2; ++n) acc[a][b][m][n] = (f32x4){0.f, 0.f, 0.f, 0.f};
    bf16x8 At[4][2], B0[2][2], B1[2][2];
    const char* cA = (const char*)g.A + (size_t)cur.pm * tstepA; const char* cB = (const char*)g.Bt + (size_t)cur.pn * tstep;
    S.a_ready(cur);
    if constexpr (SP2) {
        PG8_STAGE(PG8_SB(0, 0), cB, voffB); PG8_STAGE(PG8_SB(0, 1), cB + hstep, voffB); PG8_STAGE(PG8_SA(0, 0), cA, voffA); PG8_STAGE(PG8_SA(0, 1), cA + hstepA, voffA);
        if (wr == 1) PG8_BAR;
        PG8_WAIT_V(2); PG8_BAR;
        PG8_STAGE(PG8_SB(1, 0), cB + kstep, voffB); PG8_STAGE(PG8_SA(1, 0), cA + kstep, voffA); PG8_STAGE(PG8_SB(1, 1), cB + hstep + kstep, voffB);
        PG8_WAIT_V(6); PG8_BAR;
    } else {
        PG8_STAGE(PG8_SB(0, 0), cB, voffB); PG8_STAGE(PG8_SA(0, 0), cA, voffA); PG8_STAGE(PG8_SB(0, 1), cB + hstep, voffB); PG8_STAGE(PG8_SA(0, 1), cA + hstepA, voffA);
        if (wr == 1) PG8_BAR;
        PG8_WAIT_V(4); PG8_BAR;
        PG8_STAGE(PG8_SB(1, 0), cB + kstep, voffB); PG8_STAGE(PG8_SA(1, 0), cA + kstep, voffA); PG8_STAGE(PG8_SB(1, 1), cB + hstep + kstep, voffB);
        PG8_WAIT_V(6); PG8_BAR;
    }
    for (;;) {
        const bool has_next = S.next(ui + 1, nxt);
        const char* nA = has_next ? (const char*)g.A + (size_t)nxt.pm * tstepA : cA; const char* nB = has_next ? (const char*)g.Bt + (size_t)nxt.pn * tstep : cB;
        for (int t = 0; t < nt; t += 2) {
            const bool last = (t == nt - 2);
            const char* a1 = cA + (size_t)(t + 1) * kstep;
            const char* a2 = last ? nA : cA + (size_t)(t + 2) * kstep; const char* b2 = last ? nB : cB + (size_t)(t + 2) * kstep;
            const char* a3 = a2 + kstep; const char* b3 = b2 + kstep;
            if (last && has_next) S.a_ready(nxt);
            if constexpr (SP2) {
            PG8_LDB(B0, 0, 0); PG8_LDB(B1, 0, 1); PG8_SCHED; PG8_LDA(At, 0, 0); PG8_STAGE(PG8_SA(1, 1), a1 + hstepA, voffA);
            PG8_WAIT_V(8); PG8_WAIT_L(0); PG8_BAR; PG8_MMA(0, 0, At, B0); PG8_MMA(0, 1, At, B1); PG8_BAR; PG8_SCHED;
            PG8_LDA(At, 0, 1); PG8_STAGE(PG8_SB(0, 0), b2, voffB); PG8_STAGE(PG8_SB(0, 1), b2 + hstep, voffB); PG8_STAGE(PG8_SA(0, 0), a2, voffA);
            PG8_WAIT_V(8); PG8_WAIT_L(0); PG8_BAR; PG8_MMA(1, 0, At, B0); PG8_MMA(1, 1, At, B1); PG8_BAR; PG8_SCHED;
            PG8_LDB(B0, 1, 0); PG8_LDB(B1, 1, 1); PG8_SCHED; PG8_LDA(At, 1, 0); PG8_STAGE(PG8_SA(0, 1), a2 + hstepA, voffA);
            PG8_WAIT_V(8); PG8_WAIT_L(0); PG8_BAR; PG8_MMA(0, 0, At, B0); PG8_MMA(0, 1, At, B1); PG8_BAR; PG8_SCHED;
            PG8_LDA(At, 1, 1); PG8_STAGE(PG8_SB(1, 0), b3, voffB); PG8_STAGE(PG8_SB(1, 1), b3 + hstep, voffB); PG8_STAGE(PG8_SA(1, 0), a3, voffA);
            PG8_WAIT_V(8); PG8_WAIT_L(0); PG8_BAR; PG8_MMA(1, 0, At, B0); PG8_MMA(1, 1, At, B1); PG8_BAR; PG8_SCHED;
            } else {
            PG8_LDB(B0, 0, 0); PG8_SCHED; PG8_LDA(At, 0, 0); PG8_STAGE(PG8_SA(1, 1), a1 + hstepA, voffA);
            PG8_WAIT_L(8); PG8_BAR; PG8_WAIT_L(0); PG8_MMA(0, 0, At, B0); PG8_BAR; PG8_SCHED;
            PG8_LDB(B1, 0, 1); PG8_STAGE(PG8_SB(0, 0), b2, voffB);
            PG8_BAR; PG8_WAIT_L(0); PG8_MMA(0, 1, At, B1); PG8_BAR;
            PG8_LDA(At, 0, 1); PG8_STAGE(PG8_SA(0, 0), a2, voffA);
            PG8_BAR; PG8_WAIT_L(0); PG8_MMA(1, 0, At, B0); PG8_BAR; PG8_SCHED;
            PG8_STAGE(PG8_SB(0, 1), b2 + hstep, voffB);
            PG8_WAIT_V(6); PG8_BAR; PG8_MMA(1, 1, At, B1); PG8_BAR;
            PG8_LDB(B0, 1, 0); PG8_SCHED; PG8_LDA(At, 1, 0); PG8_STAGE(PG8_SA(0, 1), a2 + hstepA, voffA);
            PG8_WAIT_L(8); PG8_BAR; PG8_WAIT_L(0); PG8_MMA(0, 0, At, B0); PG8_BAR; PG8_SCHED;
            PG8_LDB(B1, 1, 1); PG8_STAGE(PG8_SB(1, 0), b3, voffB);
            PG8_BAR; PG8_WAIT_L(0); PG8_MMA(0, 1, At, B1); PG8_BAR;
            PG8_LDA(At, 1, 1); PG8_STAGE(PG8_SA(1, 0), a3, voffA);
            PG8_BAR; PG8_WAIT_L(0); PG8_MMA(1, 0, At, B0); PG8_BAR; PG8_SCHED;
            PG8_STAGE(PG8_SB(1, 1), b3 + hstep, voffB);
            PG8_WAIT_V(6); PG8_BAR; PG8_MMA(1, 1, At, B1); PG8_BAR;
            }
        }
        if constexpr (ALIGN_EPI) { if (wr == 0) PG8_BAR; }
        if constexpr (!Epi::AFTER_DRAIN) { E(acc, cur, wr, wc, fr, fq); S.done(cur); }
        if (!has_next) break;
#pragma unroll
        for (int a = 0; a < 2; ++a)
#pragma unroll
            for (int b = 0; b < 2; ++b)
#pragma unroll
                for (int m = 0; m < 4; ++m)
#pragma unroll
                    for (int n = 0; n < 2; ++n) acc[a][b][m][n] = (f32x4){0.f, 0.f, 0.f, 0.f};
        cur = nxt; cA = nA; cB = nB; ++ui;
        if constexpr (ALIGN_EPI) { if (wr == 1) PG8_BAR; }
    }
    PG8_WAIT_V(0);
    if constexpr (!ALIGN_EPI) { if (wr == 0) PG8_BAR; }
    PG8_BAR;
    if constexpr (Epi::AFTER_DRAIN) { E.fused(acc, cur, wr, wc, fr, fq, lds, wid, lane); S.done(cur); }
#undef PG8_SA
#undef PG8_SB
#undef PG8_STAGE
#undef PG8_LDA
#undef PG8_LDB
#undef PG8_MMA
#undef PG8_WAIT_V
#undef PG8_WAIT_L
#undef PG8_BAR
#undef PG8_SCHED
}
}

#ifndef PG8_SP2
#define PG8_SP2 true
#endif
#ifndef PG8_ALIGN
#define PG8_ALIGN true
#endif
constexpr int NWAVES = 8;
constexpr int T = 49152, TPR = 32768, D = 2048, FF = 5632, NIN = 4864, AW = 768, LW = 1280;
constexpr int ZQ = 0, ZGL = 768, ZK = 2048, ZV = 2816, ZXL = 3584;
constexpr int LCH = 64, NCHUNK = T / LCH;
constexpr size_t MiB = 1u << 20;
constexpr size_t WS_CTL = 0, CTL_ZERO_BYTES = 4 * MiB;
constexpr size_t STAT_BYTES = (size_t)T * 8, SSQ_BYTES = (size_t)T * 4;
constexpr size_t WS_ST = 1 * MiB;
constexpr size_t WS_SSQ = WS_ST + 6 * STAT_BYTES;
static_assert(WS_SSQ + 4 * SSQ_BYTES <= CTL_ZERO_BYTES, "zero region");
constexpr size_t WS_ST0 = 4 * MiB;
constexpr size_t WS_VEC = 4 * MiB + 512 * 1024;
constexpr size_t WS_ROPE = 5 * MiB;
constexpr size_t WS_CSB = 6 * MiB;
constexpr size_t WS_LRUW = 7 * MiB;
constexpr size_t WS_TOT = 10 * MiB;
constexpr size_t WS_WGU1 = 26 * MiB, WS_WD1 = 70 * MiB, WS_WIN = 92 * MiB, WS_WOUT = 111 * MiB, WS_WGU2 = 119 * MiB, WS_WD2 = 163 * MiB;
constexpr size_t WS_TB = 185 * MiB;
constexpr size_t WS_BIG = 377 * MiB;
constexpr size_t WS_END = 905 * MiB;
static_assert(WS_TOT + (size_t)NCHUNK * 2 * 1280 * 8 <= WS_WGU1 && WS_WD2 + (size_t)D * FF * 2 <= WS_TB && WS_TB + (size_t)T * D * 2 <= WS_BIG && WS_BIG + (size_t)T * FF * 2 <= WS_END, "d_ws map");
constexpr int CW_BAR = 4096;
constexpr int RING_OFF = 0, RING_BYTES = 131072;
constexpr int LDSCTL_OFF = RING_BYTES, MISC_OFF = LDSCTL_OFF + 320;
constexpr int LDS_BYTES = 147456;
#define GAS __attribute__((address_space(1)))
#define LAS __attribute__((address_space(3)))
typedef unsigned short bf16;
typedef unsigned v4u __attribute__((ext_vector_type(4)));
typedef unsigned v2u __attribute__((ext_vector_type(2)));
typedef float f32x4 __attribute__((ext_vector_type(4)));
typedef float f32x2 __attribute__((ext_vector_type(2)));
typedef short bf16x8 __attribute__((ext_vector_type(8)));
#define LDS_WAIT() asm volatile("s_waitcnt lgkmcnt(0)" ::: "memory")
__device__ __forceinline__ unsigned f2bf(float f) { unsigned u = __builtin_bit_cast(unsigned, f); return (u + 0x7fffu + ((u >> 16) & 1u)) >> 16; }
__device__ __forceinline__ unsigned pk2(float lo, float hi) { return f2bf(lo) | (f2bf(hi) << 16); }
__device__ __forceinline__ float bf_lo(unsigned w) { return __uint_as_float(w << 16); }
__device__ __forceinline__ float bf_hi(unsigned w) { return __uint_as_float(w & 0xffff0000u); }
__device__ __forceinline__ float sigmoid_f(float v) { return __builtin_amdgcn_rcpf(1.0f + __expf(-v)); }
__device__ __forceinline__ float gelu_tanh(float x) { const float y = 0.7978845608028654f * (x + 0.044715f * x * x * x); const float th = 1.0f - 2.0f * __builtin_amdgcn_rcpf(1.0f + __expf(2.0f * y)); return 0.5f * x * (1.0f + th); }
#define XB_TMO      128
#define XB_XCNT(j)  (256  + 64 * (j))
#define XB_XSUB(j)  (1280 + 64 * (j))
#define XB_XGEN(j)  (2304 + 64 * (j))
#define XB_TOP      3328
#define XB_TOPGEN   3392
#define XCD_BAR_WORDS 3456
#define XB_SPIN_CAP (1u << 18)

__device__ __forceinline__ unsigned xb_ld(unsigned* p)              { return __hip_atomic_load(p, __ATOMIC_RELAXED, __HIP_MEMORY_SCOPE_AGENT); }
__device__ __forceinline__ unsigned xb_add(unsigned* p, unsigned v) { return __hip_atomic_fetch_add(p, v, __ATOMIC_RELAXED, __HIP_MEMORY_SCOPE_AGENT); }
__device__ __forceinline__ unsigned xb_xcc_id() { return (unsigned)__builtin_amdgcn_s_getreg((3 << 11) | 20) & 0xFu; }
#define XB_SPIN(cond, bar) do { unsigned _sp = 0; while (cond) { __builtin_amdgcn_s_sleep(1); \
    if ((++_sp & 255u) == 0u) { if (xb_ld(&(bar)[XB_TMO])) break; if (_sp > XB_SPIN_CAP) { atomicAdd(&(bar)[XB_TMO], 1u); break; } } } } while (0)

struct XcdBarrier {
    unsigned* bar; unsigned x;
    volatile LAS unsigned* st;
};

__device__ __forceinline__ XcdBarrier xcd_barrier_post(unsigned* bar, volatile LAS unsigned* st) {
    XcdBarrier b; b.bar = bar; b.x = xb_xcc_id(); b.st = st;
    if (threadIdx.x == 0) (void)xb_add(&bar[XB_XCNT(b.x)], 1u);
    return b;
}
__device__ __forceinline__ void xcd_barrier_complete(unsigned* bar, unsigned x, unsigned& nloc, unsigned& nx) {
    const unsigned G = gridDim.x * gridDim.y * gridDim.z;
    unsigned sum, cnt, mine, sp = 0u;
    for (;;) {
        sum = 0u; cnt = 0u; mine = 0u;
#pragma unroll
        for (unsigned j = 0; j < 16; ++j) { const unsigned c = xb_ld(&bar[XB_XCNT(j)]); sum += c; cnt += (c > 0u) ? 1u : 0u; mine = (j == x) ? c : mine; }
        if (sum == G) break;
        __builtin_amdgcn_s_sleep(1);
        if ((++sp & 255u) == 0u) { if (xb_ld(&bar[XB_TMO])) break; if (sp > XB_SPIN_CAP) { atomicAdd(&bar[XB_TMO], 1u); break; } }
    }
    nloc = mine > 0u ? mine : 1u; nx = cnt > 0u ? cnt : 1u;
}

__device__ __forceinline__ void xcd_barrier(const XcdBarrier& b) {
    asm volatile("s_waitcnt vmcnt(0)" ::: "memory");
    __syncthreads();
    if (threadIdx.x == 0) {
        unsigned* bar = b.bar;
        __builtin_amdgcn_s_waitcnt(0);
        unsigned nloc = b.st[0], nx = b.st[1];
        if (nloc == 0u) { xcd_barrier_complete(bar, b.x, nloc, nx); b.st[0] = nloc; b.st[1] = nx; }
        const unsigned old = xb_add(&bar[XB_XSUB(b.x)], 1u);
        const unsigned gen = old / nloc;
        if (old + 1u == (gen + 1u) * nloc) {
            __builtin_amdgcn_fence(__ATOMIC_RELEASE, "agent");
            asm volatile("s_waitcnt vmcnt(0)" ::: "memory");
            const unsigned og = xb_add(&bar[XB_TOP], 1u);
            const unsigned tg = og / nx;
            if (og + 1u == (tg + 1u) * nx) xb_add(&bar[XB_TOPGEN], 1u);
            else XB_SPIN(xb_ld(&bar[XB_TOPGEN]) == tg, bar);
            __builtin_amdgcn_fence(__ATOMIC_ACQUIRE, "agent");
            xb_add(&bar[XB_XGEN(b.x)], 1u);
            asm volatile("s_waitcnt vmcnt(0)" ::: "memory");
        } else {
            XB_SPIN(xb_ld(&bar[XB_XGEN(b.x)]) == gen, bar);
            __builtin_amdgcn_fence(__ATOMIC_ACQUIRE, "agent");
            asm volatile("s_waitcnt vmcnt(0)" ::: "memory");
        }
    }
    __syncthreads();
}

typedef short v4i16_t __attribute__((ext_vector_type(4)));
__device__ __forceinline__ void attn_mfma_phase(LAS unsigned char* lds, bf16* Z, float* ssq, int blk, int G, int tid, int wave, int lane) {
    LAS float* Os = (LAS float*)lds;
    LAS float* ms = (LAS float*)(lds + 69632);
    LAS float* ls = (LAS float*)(lds + 70656);
    LAS unsigned char* vb = lds + 71680 + wave * 4608;
    const int c = lane & 15, g = lane >> 4;
    constexpr float SC = 0.125f * 1.4426950408889634f;
    for (int unit = blk; unit < (T / 256) * 12; unit += G) {
        const int tb = unit / 12, h = unit % 12;
        const int tok0 = 256 * tb; const int s0 = tok0 < TPR ? (tok0 & ~4095) : TPR; const int S = tok0 < TPR ? 4096 : 16384; const int B0 = tok0 - s0;
        __syncthreads();
#pragma unroll 1
        for (int pass = 0; pass < 3; ++pass) {
            const int dsh = 2 * pass; const int L = S >> dsh;
#pragma unroll 1
            for (int k2 = 0; k2 < 2; ++k2) {
                const int ti = 2 * wave + k2;
                int r, tq, pq0;
                if (pass == 0) { r = 0; tq = 16 * ti + c; pq0 = B0 + 16 * ti; }
                else if (pass == 1) { r = ti & 3; tq = r + 64 * (ti >> 2) + 4 * c; pq0 = (B0 >> 2) + 16 * (ti >> 2); }
                else { r = ti; tq = r + 16 * c; pq0 = B0 >> 4; }
                const bf16* zq = Z + (size_t)(tok0 + tq) * NIN + ZQ + h * 64 + 8 * g;
                const bf16x8 Qf0 = *(const bf16x8*)zq, Qf1 = *(const bf16x8*)(zq + 32);
                f32x4 sc[10];
#pragma unroll
                for (int kt = 0; kt < 9; ++kt) { int pk = pq0 - 64 + 16 * kt + c; pk = pk < 0 ? 0 : (pk > L - 1 ? L - 1 : pk);
                    const bf16* zk = Z + (size_t)(s0 + r + (pk << dsh)) * NIN + ZK + h * 64 + 8 * g;
                    const bf16x8 Kf0 = *(const bf16x8*)zk, Kf1 = *(const bf16x8*)(zk + 32);
                    f32x4 a = {0.f, 0.f, 0.f, 0.f};
                    a = __builtin_amdgcn_mfma_f32_16x16x32_bf16(Kf0, Qf0, a, 0, 0, 0); a = __builtin_amdgcn_mfma_f32_16x16x32_bf16(Kf1, Qf1, a, 0, 0, 0); sc[kt] = a; }
                sc[9] = (f32x4){-1e30f, -1e30f, -1e30f, -1e30f};
                float mx = -1e30f;
#pragma unroll
                for (int kt = 0; kt < 9; ++kt)
#pragma unroll
                    for (int rr = 0; rr < 4; ++rr) { const int kk = 16 * kt + 4 * g + rr, pk = pq0 - 64 + kk; const bool valid = kk >= c && kk <= c + 128 && pk >= 0 && pk < L;
                        sc[kt][rr] = valid ? sc[kt][rr] : -1e30f; mx = fmaxf(mx, sc[kt][rr]); }
                mx = fmaxf(mx, __shfl_xor(mx, 16)); mx = fmaxf(mx, __shfl_xor(mx, 32));
                float lsum = 0.f;
#pragma unroll
                for (int kt = 0; kt < 10; ++kt)
#pragma unroll
                    for (int rr = 0; rr < 4; ++rr) { const float p = __builtin_amdgcn_exp2f((sc[kt][rr] - mx) * SC); sc[kt][rr] = p; lsum += p; }
                lsum += __shfl_xor(lsum, 16); lsum += __shfl_xor(lsum, 32);
                f32x4 o[4];
#pragma unroll
                for (int dt = 0; dt < 4; ++dt) o[dt] = (f32x4){0.f, 0.f, 0.f, 0.f};
#pragma unroll
                for (int s = 0; s < 5; ++s) {
                    v4u vv[4];
#pragma unroll
                    for (int i = 0; i < 4; ++i) { const int j = (lane >> 3) + 8 * i; int pk = pq0 - 64 + 32 * s + j; pk = pk < 0 ? 0 : (pk > L - 1 ? L - 1 : pk);
                        vv[i] = *(const v4u*)(Z + (size_t)(s0 + r + (pk << dsh)) * NIN + ZV + h * 64 + 8 * (lane & 7)); }
                    asm volatile("s_waitcnt lgkmcnt(0)" ::: "memory");
#pragma unroll
                    for (int i = 0; i < 4; ++i) *(LAS v4u*)(vb + ((lane >> 3) + 8 * i) * 144 + 16 * (lane & 7)) = vv[i];
                    asm volatile("s_waitcnt lgkmcnt(0)" ::: "memory");
                    union { unsigned u[4]; bf16x8 v; } pf;
                    pf.u[0] = pg8::cvt_pk_bf16(sc[2 * s][0], sc[2 * s][1]); pf.u[1] = pg8::cvt_pk_bf16(sc[2 * s][2], sc[2 * s][3]); pf.u[2] = pg8::cvt_pk_bf16(sc[2 * s + 1][0], sc[2 * s + 1][1]); pf.u[3] = pg8::cvt_pk_bf16(sc[2 * s + 1][2], sc[2 * s + 1][3]);
#pragma unroll
                    for (int dt = 0; dt < 4; ++dt) {
                        LAS unsigned char* p0 = vb + (4 * g + (c >> 2)) * 144 + (16 * dt + 4 * (c & 3)) * 2;
                        const v4i16_t lo = __builtin_amdgcn_ds_read_tr16_b64_v4i16((LAS v4i16_t*)p0), hi = __builtin_amdgcn_ds_read_tr16_b64_v4i16((LAS v4i16_t*)(p0 + 16 * 144));
                        bf16x8 af; af[0] = lo[0]; af[1] = lo[1]; af[2] = lo[2]; af[3] = lo[3]; af[4] = hi[0]; af[5] = hi[1]; af[6] = hi[2]; af[7] = hi[3];
                        o[dt] = __builtin_amdgcn_mfma_f32_16x16x32_bf16(af, pf.v, o[dt], 0, 0, 0); }
                }
                LAS float* orow = Os + tq * 68 + 4 * g;
                if (pass == 0) {
#pragma unroll
                    for (int dt = 0; dt < 4; ++dt) *(LAS f32x4*)(orow + 16 * dt) = o[dt];
                    if (g == 0) { ms[tq] = mx; ls[tq] = lsum; }
                } else {
                    const float m_s = ms[tq], l_s = ls[tq]; const float mn = fmaxf(m_s, mx); const float a = __builtin_amdgcn_exp2f((m_s - mn) * SC), b = __builtin_amdgcn_exp2f((mx - mn) * SC);
#pragma unroll
                    for (int dt = 0; dt < 4; ++dt) { const f32x4 os = *(const LAS f32x4*)(orow + 16 * dt); *(LAS f32x4*)(orow + 16 * dt) = os * a + o[dt] * b; }
                    asm volatile("s_waitcnt lgkmcnt(0)" ::: "memory");
                    if (g == 0) { ms[tq] = mn; ls[tq] = l_s * a + lsum * b; }
                }
            }
            __syncthreads();
        }
#pragma unroll
        for (int i = 0; i < 4; ++i) { const int item = tid + 512 * i, tk = item >> 3, ch = item & 7;
            const float inv = 1.0f / ls[tk]; const f32x4 a = *(const LAS f32x4*)(Os + tk * 68 + 8 * ch), b = *(const LAS f32x4*)(Os + tk * 68 + 8 * ch + 4);
            float v[8] = {a[0] * inv, a[1] * inv, a[2] * inv, a[3] * inv, b[0] * inv, b[1] * inv, b[2] * inv, b[3] * inv};
            float sq = 0.f;
#pragma unroll
            for (int e = 0; e < 8; ++e) sq += v[e] * v[e];
            sq += __shfl_xor(sq, 1); sq += __shfl_xor(sq, 2); sq += __shfl_xor(sq, 4);
            v4u ov; ov.x = pk2(v[0], v[1]); ov.y = pk2(v[2], v[3]); ov.z = pk2(v[4], v[5]); ov.w = pk2(v[6], v[7]);
            *(v4u*)(Z + (size_t)(tok0 + tk) * NIN + ZQ + h * 64 + 8 * ch) = ov;
            if (ch == 0) unsafeAtomicAdd(ssq + tok0 + tk, sq); }
    }
    __syncthreads();
}

__device__ __forceinline__ void conv_item(const float* W, int K, int ldw, int n0, bf16* WT, int drow0, const float* g, const float* g2, int ksplit, const float* b, float* cs, float* cb, LAS float* scr, int lane) {
    float csa[4] = {0.f, 0.f, 0.f, 0.f}, cba[4] = {0.f, 0.f, 0.f, 0.f};
    const int c = lane & 7;
    for (int k0 = 0; k0 < K; k0 += 64) {
#pragma unroll 8
        for (int i = 0; i < 32; ++i) { const int kk = 2 * i + (lane >> 5); scr[kk * 33 + (lane & 31)] = W[(size_t)(k0 + kk) * ldw + n0 + (lane & 31)]; }
        LDS_WAIT(); asm volatile("" ::: "memory");
        float gk[8], bk[8];
#pragma unroll
        for (int e = 0; e < 8; ++e) { const int k = k0 + 8 * c + e; gk[e] = g ? (k < ksplit ? g[k] : g2[k - ksplit]) : 1.f; bk[e] = b ? b[k] : 0.f; }
#pragma unroll
        for (int j = 0; j < 4; ++j) { const int n = (lane >> 3) + 8 * j; const LAS float* s = scr + (8 * c) * 33 + n;
            float w[8], wg[8];
#pragma unroll
            for (int e = 0; e < 8; ++e) { w[e] = s[e * 33]; wg[e] = w[e] * gk[e]; }
            v4u o; o.x = pk2(wg[0], wg[1]); o.y = pk2(wg[2], wg[3]); o.z = pk2(wg[4], wg[5]); o.w = pk2(wg[6], wg[7]);
            *(v4u*)(WT + (size_t)(drow0 + n) * K + k0 + 8 * c) = o;
            csa[j] += ((bf_lo(o.x) + bf_hi(o.x)) + (bf_lo(o.y) + bf_hi(o.y))) + ((bf_lo(o.z) + bf_hi(o.z)) + (bf_lo(o.w) + bf_hi(o.w)));
#pragma unroll
            for (int e = 0; e < 8; ++e) cba[j] += bk[e] * w[e]; }
        LDS_WAIT(); asm volatile("" ::: "memory");
    }
    if (cs) {
#pragma unroll
        for (int j = 0; j < 4; ++j) { float a = csa[j], bb = cba[j];
            a += __shfl_xor(a, 1); a += __shfl_xor(a, 2); a += __shfl_xor(a, 4); bb += __shfl_xor(bb, 1); bb += __shfl_xor(bb, 2); bb += __shfl_xor(bb, 4);
            if (c == 0) { cs[drow0 + (lane >> 3) + 8 * j] = a; cb[drow0 + (lane >> 3) + 8 * j] = bb; } }
    }
}
struct Args { const float* in[25]; float* out; unsigned char* ws; int ph_lo, ph_hi; };
typedef Args Ptrs;
#ifndef PHMASK
#define PHMASK 0xFFFF
#endif
#define PHON(k) ((PHMASK >> (k)) & 1)
__device__ __forceinline__ void convert_layer(const Ptrs& P, int l, LAS unsigned char* lds, int gw, int NGW, int wave, int lane) {
    LAS float* scr = (LAS float*)(lds + RING_OFF + wave * 16384);
    unsigned char* ws = P.ws;
    float* csb = (float*)(ws + WS_CSB);
    constexpr int I_D = 64, I_GU = 352, I_IN = 152, I_OUT = 64, I_LRU = 160;
    constexpr int NITEMS = 2 * I_D + 2 * I_GU + I_IN + I_OUT + I_LRU;
    for (int it = gw; it < NITEMS; it += NGW) {
        int r = it;
        if (r < I_D) { conv_item(P.in[6] + (size_t)l * FF * D, FF, D, 32 * r, (bf16*)(ws + WS_WD1), 32 * r, nullptr, nullptr, 0, nullptr, nullptr, nullptr, scr, lane); continue; } r -= I_D;
        if (r < I_D) { conv_item(P.in[24] + (size_t)l * FF * D, FF, D, 32 * r, (bf16*)(ws + WS_WD2), 32 * r, nullptr, nullptr, 0, nullptr, nullptr, nullptr, scr, lane); continue; } r -= I_D;
        if (r < I_GU) { const int up = r >= 176, rr = up ? r - 176 : r, n0 = 32 * rr, dr = 256 * (n0 >> 7) + (n0 & 127) + 128 * up;
            const float* gg = l ? P.in[20] + (size_t)(l - 1) * D : nullptr; const float* bb = l ? P.in[21] + (size_t)(l - 1) * D : nullptr;
            conv_item(P.in[up ? 5 : 4] + (size_t)l * D * FF, D, FF, n0, (bf16*)(ws + WS_WGU1), dr, gg, gg, D, bb, csb, csb + 16384, scr, lane); continue; } r -= I_GU;
        if (r < I_GU) { const int up = r >= 176, rr = up ? r - 176 : r, n0 = 32 * rr, dr = 256 * (n0 >> 7) + (n0 & 127) + 128 * up;
            conv_item(P.in[up ? 23 : 22] + (size_t)l * D * FF, D, FF, n0, (bf16*)(ws + WS_WGU2), dr, P.in[7] + (size_t)l * D, P.in[7] + (size_t)l * D, D, P.in[8] + (size_t)l * D, csb + 4 * 16384, csb + 5 * 16384, scr, lane); continue; } r -= I_GU;
        if (r < I_IN) { const int n0 = 32 * r; int dr;
            if (n0 < 768) dr = n0; else if (n0 < 1536) dr = ZK + (n0 - 768); else if (n0 < 2304) dr = ZV + (n0 - 1536); else if (n0 < 3584) dr = ZXL + (n0 - 2304); else dr = ZGL + (n0 - 3584);
            conv_item(P.in[9] + (size_t)l * D * NIN, D, NIN, n0, (bf16*)(ws + WS_WIN), dr, P.in[2] + (size_t)l * D, P.in[2] + (size_t)l * D, D, P.in[3] + (size_t)l * D, csb + 2 * 16384, csb + 3 * 16384, scr, lane); continue; } r -= I_IN;
        if (r < I_OUT) { conv_item(P.in[19] + (size_t)l * D * D, D, D, 32 * r, (bf16*)(ws + WS_WOUT), 32 * r, P.in[17] + (size_t)l * AW, P.in[18] + (size_t)l * LW, AW, nullptr, nullptr, nullptr, scr, lane); continue; } r -= I_OUT;
        { const int mat = r >> 2, n0 = 32 * (r & 3), gate = mat / 20, rem = mat % 20;
          conv_item(P.in[gate ? 14 : 12] + ((size_t)l * 20 + rem) * 16384, 128, 128, n0, (bf16*)(ws + WS_LRUW) + (size_t)mat * 16384, n0, nullptr, nullptr, 0, nullptr, nullptr, nullptr, scr, lane); }
    }
}
__device__ __forceinline__ void sincos_d(double r, double& s, double& c) {
    const double r2 = r * r; double ts = r, tc = 1.0; s = r; c = 1.0;
#pragma unroll
    for (int k = 1; k <= 14; ++k) { tc = -tc * r2 / (double)((2 * k - 1) * (2 * k)); ts = -ts * r2 / (double)((2 * k) * (2 * k + 1)); c += tc; s += ts; }
}
__device__ __forceinline__ void prologue(const Ptrs& P, LAS unsigned char* lds, int gtid, int NGT, int gw, int NGW, int wave, int lane) {
    unsigned char* ws = P.ws;
    { f32x2* st0 = (f32x2*)(ws + WS_ST0); for (int i = gtid; i < T; i += NGT) st0[i] = (f32x2){0.f, 2048.0f * (1.0f - 1e-5f)}; }
    { float* v = (float*)(ws + WS_VEC); for (int i = gtid; i < 4096; i += NGT) v[i] = i < 2048 ? 1.f : 0.f; }
    { f32x2* rp = (f32x2*)(ws + WS_ROPE);
      for (int i = gtid; i < 16384 * 8; i += NGT) { const int pos = i >> 3, fi = i & 7;
          const double invf = fi == 0 ? 1.0 : fi == 1 ? 0.19392274474868576 : fi == 2 ? 0.03760603093086393 : fi == 3 ? 0.007292664737217109 : fi == 4 ? 0.001414213562373095 : fi == 5 ? 0.0002742481756762073 : fi == 6 ? 5.318295896944988e-05 : 1.031338537721246e-05;
          const double ang = (double)pos * invf; const double kq = __builtin_rint(ang * 0.15915494309189535); const double rr = ang - kq * 6.283185307179586;
          double s, c; sincos_d(rr, s, c); rp[i] = (f32x2){(float)c, (float)s}; } }
    { bf16* tb = (bf16*)(ws + WS_TB);
      for (size_t i = (size_t)gtid; i < (size_t)T * D / 8; i += NGT) { const size_t e = i * 8; const float* src = e < (size_t)TPR * D ? P.in[0] + e : P.in[1] + (e - (size_t)TPR * D);
          const f32x4 a = *(const f32x4*)src, b2 = *(const f32x4*)(src + 4); v4u o; o.x = pk2(a[0], a[1]); o.y = pk2(a[2], a[3]); o.z = pk2(b2[0], b2[1]); o.w = pk2(b2[2], b2[3]); *(v4u*)(tb + e) = o; } }
    convert_layer(P, 0, lds, gw, NGW, wave, lane);
}

__device__ __forceinline__ void attn_valu_phase(LAS unsigned char* lds, bf16* Z, float* ssq, int blk, int G, int wave, int lane) {
    LAS float* sbuf = (LAS float*)lds + wave * 400;
    const int ks = lane >> 3, dp = lane & 7;
    for (int unit = blk; unit < (T / 64) * 12; unit += G) {
        const int tb = unit / 12, h = unit % 12;
        for (int qi = 0; qi < 8; ++qi) {
            const int tok = 64 * tb + 8 * wave + qi;
            const int s0 = tok < TPR ? (tok & ~4095) : TPR, S = tok < TPR ? 4096 : 16384, pos = tok - s0;
            float q8[8];
            { const v4u w = *(const v4u*)(Z + (size_t)tok * NIN + ZQ + h * 64 + 8 * dp);
              q8[0] = bf_lo(w.x) * 0.125f; q8[1] = bf_hi(w.x) * 0.125f; q8[2] = bf_lo(w.y) * 0.125f; q8[3] = bf_hi(w.y) * 0.125f; q8[4] = bf_lo(w.z) * 0.125f; q8[5] = bf_hi(w.z) * 0.125f; q8[6] = bf_lo(w.w) * 0.125f; q8[7] = bf_hi(w.w) * 0.125f; }
            for (int t = 0; t < 49; ++t) {
                const int kk = 8 * t + ks; const int gq = kk >= 258 ? 2 : (kk >= 129 ? 1 : 0); const int j = kk - 129 * gq - 64; const int kp = pos + j * (1 << (2 * gq));
                const bool valid = kk < 387 && kp >= 0 && kp < S; const int row = s0 + (valid ? kp : pos);
                const v4u w = *(const v4u*)(Z + (size_t)row * NIN + ZK + h * 64 + 8 * dp);
                float d = q8[0] * bf_lo(w.x) + q8[1] * bf_hi(w.x) + q8[2] * bf_lo(w.y) + q8[3] * bf_hi(w.y) + q8[4] * bf_lo(w.z) + q8[5] * bf_hi(w.z) + q8[6] * bf_lo(w.w) + q8[7] * bf_hi(w.w);
                d += __shfl_xor(d, 1); d += __shfl_xor(d, 2); d += __shfl_xor(d, 4);
                if (dp == 0) sbuf[kk] = valid ? d : -1e30f;
            }
            LDS_WAIT(); asm volatile("" ::: "memory");
            float sv[7]; float mx = -1e30f;
#pragma unroll
            for (int p = 0; p < 7; ++p) { const int idx = lane + 64 * p; sv[p] = idx < 392 ? sbuf[idx] : -1e30f; mx = fmaxf(mx, sv[p]); }
#pragma unroll
            for (int o = 1; o < 64; o <<= 1) mx = fmaxf(mx, __shfl_xor(mx, o));
            float sum = 0.f;
#pragma unroll
            for (int p = 0; p < 7; ++p) { const int idx = lane + 64 * p; const float e = sv[p] > -1e29f ? __expf(sv[p] - mx) : 0.f; sum += e; if (idx < 392) sbuf[idx] = e; }
#pragma unroll
            for (int o = 1; o < 64; o <<= 1) sum += __shfl_xor(sum, o);
            LDS_WAIT(); asm volatile("" ::: "memory");
            float a8[8] = {0.f, 0.f, 0.f, 0.f, 0.f, 0.f, 0.f, 0.f};
            for (int t = 0; t < 49; ++t) {
                const int kk = 8 * t + ks; const int gq = kk >= 258 ? 2 : (kk >= 129 ? 1 : 0); const int j = kk - 129 * gq - 64; const int kp = pos + j * (1 << (2 * gq));
                const bool valid = kk < 387 && kp >= 0 && kp < S; const int row = s0 + (valid ? kp : pos);
                const float p = sbuf[kk];
                const v4u w = *(const v4u*)(Z + (size_t)row * NIN + ZV + h * 64 + 8 * dp);
                a8[0] += p * bf_lo(w.x); a8[1] += p * bf_hi(w.x); a8[2] += p * bf_lo(w.y); a8[3] += p * bf_hi(w.y); a8[4] += p * bf_lo(w.z); a8[5] += p * bf_hi(w.z); a8[6] += p * bf_lo(w.w); a8[7] += p * bf_hi(w.w);
            }
            const float inv = 1.0f / sum; float sq = 0.f;
#pragma unroll
            for (int e = 0; e < 8; ++e) { float v = a8[e]; v += __shfl_xor(v, 8); v += __shfl_xor(v, 16); v += __shfl_xor(v, 32); a8[e] = v * inv; sq += a8[e] * a8[e]; }
            sq += __shfl_xor(sq, 1); sq += __shfl_xor(sq, 2); sq += __shfl_xor(sq, 4);
            if (ks == 0) { v4u o; o.x = pk2(a8[0], a8[1]); o.y = pk2(a8[2], a8[3]); o.z = pk2(a8[4], a8[5]); o.w = pk2(a8[6], a8[7]); *(v4u*)(Z + (size_t)tok * NIN + ZQ + h * 64 + 8 * dp) = o; }
            if (lane == 0) unsafeAtomicAdd(ssq + tok, sq);
            LDS_WAIT(); asm volatile("" ::: "memory");
        }
    }
}

template <int MODE>
__device__ __forceinline__ void lru_phase(LAS unsigned char* lds, int blk, int G, int tid, int lane, int wave, bf16* Z, const bf16* LWT, const float* convw, const float* convb, const float* ba, const float* bx, const float* lam, float* tot, float* ssq) {
    LAS float* xcf = (LAS float*)lds;
    LAS bf16* xcb = (LAS bf16*)(lds + 33792);
    LAS float* hf = (LAS float*)(lds + 33792 + 17408);
    LAS float* hbw = (LAS float*)(lds + 33792 + 17408 + 33792);
    const int dir = wave >> 2, dbase = 32 * (wave & 3), c = lane & 15, g = lane >> 4;
    for (int unit = blk; unit < NCHUNK * 10; unit += G) {
        const int ck = unit / 10, nb = unit % 10;
        const int tok0 = LCH * ck; const int s0 = tok0 < TPR ? (tok0 & ~4095) : TPR; const int send = tok0 < TPR ? s0 + 4096 : T;
        __syncthreads();
        { const int cp = tid & 63, ch = 128 * nb + 2 * cp;
          float w0[4], w1[4];
#pragma unroll
          for (int j = 0; j < 4; ++j) { w0[j] = convw[j * LW + ch]; w1[j] = convw[j * LW + ch + 1]; }
          const float b0 = convb[ch], b1 = convb[ch + 1];
#pragma unroll
          for (int i = 0; i < 8; ++i) { const int tt = (tid >> 6) + 8 * i; float a0 = 0.f, a1 = 0.f;
#pragma unroll
              for (int j = 0; j < 4; ++j) { const int row = tok0 + tt + j - 2; if (row >= s0 && row < send) { const unsigned w = *(const unsigned*)(Z + (size_t)row * NIN + ZXL + ch); a0 += bf_lo(w) * w0[j]; a1 += bf_hi(w) * w1[j]; } }
              a0 += b0; a1 += b1;
              xcf[tt * 132 + 2 * cp] = a0; xcf[tt * 132 + 2 * cp + 1] = a1; *(LAS unsigned*)(xcb + tt * 136 + 2 * cp) = pk2(a0, a1); } }
        __syncthreads();
        float sp8[2], bav[2], bxv[2], C[2] = {0.f, 0.f}, Atot[2] = {1.f, 1.f}; bf16x8 Bfa[2][4], Bfx[2][4];
#pragma unroll
        for (int nt = 0; nt < 2; ++nt) { const int dl = dbase + 16 * nt + c, ch = 128 * nb + dl;
            sp8[nt] = 8.0f * log1pf(expf(-lam[dir * LW + ch])); bav[nt] = ba[dir * LW + ch]; bxv[nt] = bx[dir * LW + ch];
            const bf16* wa = LWT + ((size_t)((0 * 2 + dir) * 10 + nb) * 128 + dl) * 128; const bf16* wx = LWT + ((size_t)((1 * 2 + dir) * 10 + nb) * 128 + dl) * 128;
#pragma unroll
            for (int ks = 0; ks < 4; ++ks) { Bfa[nt][ks] = *(const bf16x8*)(wa + 32 * ks + 8 * g); Bfx[nt][ks] = *(const bf16x8*)(wx + 32 * ks + 8 * g); } }
        if (MODE == 1) {
            const int cfirst = s0 / LCH, clast = send / LCH - 1; const int n = dir ? (clast - ck) : (ck - cfirst); const int q = (n + 3) >> 2, i0 = g * q, i1 = (i0 + q) < n ? (i0 + q) : n;
#pragma unroll
            for (int nt = 0; nt < 2; ++nt) { const int ch = 128 * nb + dbase + 16 * nt + c; float FA = 1.f, FH = 0.f;
                for (int i = i0; i < i1; i += 8) { f32x2 v[8];
#pragma unroll
                    for (int e = 0; e < 8; ++e) { const int ii = (i + e) < i1 ? (i + e) : (i1 - 1); const int kc = dir ? clast - ii : cfirst + ii; v[e] = *(const f32x2*)(tot + (((size_t)kc * 2 + dir) * LW + ch) * 2); }
#pragma unroll
                    for (int e = 0; e < 8; ++e) if ((i + e) < i1) { FH = v[e].x * FH + v[e].y; FA = v[e].x * FA; } }
                float Cc = 0.f;
#pragma unroll
                for (int gg = 0; gg < 4; ++gg) { const float A_g = __shfl(FA, c + 16 * gg), H_g = __shfl(FH, c + 16 * gg); Cc = A_g * Cc + H_g; }
                C[nt] = Cc; }
        }
        for (int it = 0; it < LCH / 16; ++it) { const int mt = dir ? (LCH / 16 - 1 - it) : it;
            bf16x8 Af[4];
#pragma unroll
            for (int ks = 0; ks < 4; ++ks) Af[ks] = *(const LAS bf16x8*)(xcb + (16 * mt + c) * 136 + 32 * ks + 8 * g);
#pragma unroll
            for (int nt = 0; nt < 2; ++nt) { f32x4 aa = {0.f, 0.f, 0.f, 0.f}, ax = {0.f, 0.f, 0.f, 0.f};
#pragma unroll
                for (int ks = 0; ks < 4; ++ks) { aa = __builtin_amdgcn_mfma_f32_16x16x32_bf16(Af[ks], Bfa[nt][ks], aa, 0, 0, 0); ax = __builtin_amdgcn_mfma_f32_16x16x32_bf16(Af[ks], Bfx[nt][ks], ax, 0, 0, 0); }
                float av[4], uv[4];
#pragma unroll
                for (int j = 0; j < 4; ++j) { const int tl = 16 * mt + 4 * g + j; const float r = sigmoid_f(aa[j] + bav[nt]), ig = sigmoid_f(ax[j] + bxv[nt]); const float la = -sp8[nt] * r;
                    av[j] = __expf(la); uv[j] = sqrtf(-expm1f(2.0f * la)) * ig * xcf[tl * 132 + dbase + 16 * nt + c]; }
                float Pp = 1.f, Hh = 0.f, pj[4], hj[4];
#pragma unroll
                for (int jj = 0; jj < 4; ++jj) { const int j = dir ? 3 - jj : jj; Hh = av[j] * Hh + uv[j]; Pp *= av[j]; pj[j] = Pp; hj[j] = Hh; }
                float IA = Pp, IH = Hh;
                { const int src = (dir ? lane + 16 : lane - 16) & 63; const bool ok = dir ? (g <= 2) : (g >= 1); const float sA = __shfl(IA, src), sH = __shfl(IH, src); if (ok) { IH = IA * sH + IH; IA = IA * sA; } }
                { const int src = (dir ? lane + 32 : lane - 32) & 63; const bool ok = dir ? (g <= 1) : (g >= 2); const float sA = __shfl(IA, src), sH = __shfl(IH, src); if (ok) { IH = IA * sH + IH; IA = IA * sA; } }
                const float after = IA * C[nt] + IH;
                float Xin; { const int src = (dir ? lane + 16 : lane - 16) & 63; const bool ok = dir ? (g <= 2) : (g >= 1); const float s = __shfl(after, src); Xin = ok ? s : C[nt]; }
                const int lastl = (dir ? 0 : 48) + c;
                const float Cn = __shfl(after, lastl);
                if (MODE == 0) Atot[nt] *= __shfl(IA, lastl);
                C[nt] = Cn;
                if (MODE == 1) { LAS float* hd = dir ? hbw : hf;
#pragma unroll
                    for (int j = 0; j < 4; ++j) hd[(16 * mt + 4 * g + j) * 132 + dbase + 16 * nt + c] = pj[j] * Xin + hj[j]; }
            }
        }
        if (MODE == 0) { if (g == 0) {
#pragma unroll
            for (int nt = 0; nt < 2; ++nt) { const int ch = 128 * nb + dbase + 16 * nt + c; *(f32x2*)(tot + (((size_t)ck * 2 + dir) * LW + ch) * 2) = (f32x2){Atot[nt], C[nt]}; } } }
        if (MODE == 1) {
            __syncthreads();
#pragma unroll
            for (int i = 0; i < 2; ++i) { const int itx = tid + 512 * i, tt = itx >> 4, cg = itx & 15;
                const f32x4 f0 = *(const LAS f32x4*)(hf + tt * 132 + 8 * cg), f1 = *(const LAS f32x4*)(hf + tt * 132 + 8 * cg + 4), b0 = *(const LAS f32x4*)(hbw + tt * 132 + 8 * cg), b1 = *(const LAS f32x4*)(hbw + tt * 132 + 8 * cg + 4);
                bf16* gp = Z + (size_t)(tok0 + tt) * NIN + ZGL + 128 * nb + 8 * cg; const v4u gw = *(const v4u*)gp;
                float rv[8];
                rv[0] = (f0[0] + b0[0]) * gelu_tanh(bf_lo(gw.x)); rv[1] = (f0[1] + b0[1]) * gelu_tanh(bf_hi(gw.x)); rv[2] = (f0[2] + b0[2]) * gelu_tanh(bf_lo(gw.y)); rv[3] = (f0[3] + b0[3]) * gelu_tanh(bf_hi(gw.y));
                rv[4] = (f1[0] + b1[0]) * gelu_tanh(bf_lo(gw.z)); rv[5] = (f1[1] + b1[1]) * gelu_tanh(bf_hi(gw.z)); rv[6] = (f1[2] + b1[2]) * gelu_tanh(bf_lo(gw.w)); rv[7] = (f1[3] + b1[3]) * gelu_tanh(bf_hi(gw.w));
                float sq = 0.f;
#pragma unroll
                for (int e = 0; e < 8; ++e) sq += rv[e] * rv[e];
                sq += __shfl_xor(sq, 1); sq += __shfl_xor(sq, 2); sq += __shfl_xor(sq, 4); sq += __shfl_xor(sq, 8);
                v4u o; o.x = pk2(rv[0], rv[1]); o.y = pk2(rv[2], rv[3]); o.z = pk2(rv[4], rv[5]); o.w = pk2(rv[6], rv[7]); *(v4u*)gp = o;
                if (cg == 0) unsafeAtomicAdd(ssq + tok0 + tt, sq); }
        }
    }
    __syncthreads();
}

__device__ __forceinline__ void rmsnorm_phase(bf16* Z, const float* ssq_att, const float* ssq_rec, int gw, int NGW, int lane) {
    for (int r = gw; r < T; r += NGW) {
        const float ra = rsqrtf(ssq_att[r] * (1.0f / AW) + 1e-5f), rr = rsqrtf(ssq_rec[r] * (1.0f / LW) + 1e-5f);
#pragma unroll
        for (int i = 0; i < 4; ++i) { const int col = 8 * (lane + 64 * i); const float sc = col < AW ? ra : rr; bf16* p = Z + (size_t)r * NIN + col; const v4u w = *(const v4u*)p;
            v4u o; o.x = pk2(bf_lo(w.x) * sc, bf_hi(w.x) * sc); o.y = pk2(bf_lo(w.y) * sc, bf_hi(w.y) * sc); o.z = pk2(bf_lo(w.z) * sc, bf_hi(w.z) * sc); o.w = pk2(bf_lo(w.w) * sc, bf_hi(w.w) * sc); *(v4u*)p = o; }
    }
}
__device__ __forceinline__ void final_ln_phase(float* out, const float* st, const float* g, const float* b, int gw, int NGW, int lane) {
    for (int r = gw; r < T; r += NGW) {
        const f32x2 s = *(const f32x2*)(st + 2 * (size_t)r); const float mu = s.x * (1.0f / 2048.0f); const float rstd = rsqrtf(fmaxf(s.y * (1.0f / 2048.0f) - mu * mu, 0.f) + 1e-5f);
#pragma unroll
        for (int i = 0; i < 8; ++i) { const int col = 4 * (lane + 64 * i); float* p = out + (size_t)r * D + col; const f32x4 t4 = *(const f32x4*)p, g4 = *(const f32x4*)(g + col), b4 = *(const f32x4*)(b + col);
            *(f32x4*)p = (t4 - mu) * rstd * g4 + b4; }
    }
}

__global__ void __launch_bounds__(NWAVES * 64, 2) enc_fwd(Args args) {
    extern __shared__ __attribute__((aligned(16))) unsigned char lds_raw[];
    LAS unsigned char* lds = (LAS unsigned char*)lds_raw;
    volatile LAS unsigned* MISC = (volatile LAS unsigned*)(lds + MISC_OFF);
    const int tid = threadIdx.x, lane = tid & 63, wave = __builtin_amdgcn_readfirstlane(tid >> 6);
    const int G = gridDim.x, blk = blockIdx.x;
    const int NGW = G * NWAVES, NGT = G * NWAVES * 64; (void)lane; (void)wave;
    GAS unsigned char* ws = (GAS unsigned char*)args.ws;
    const Args& P = args;
    for (int u = tid; u < (LDS_BYTES - LDSCTL_OFF) / 4; u += NWAVES * 64) ((LAS unsigned*)(lds + LDSCTL_OFF))[u] = 0u;
    __syncthreads();
    XcdBarrier bar = xcd_barrier_post((unsigned*)(args.ws + WS_CTL) + CW_BAR, MISC + 8);
    int ph = 0;
    const int lo = args.ph_lo, hi = args.ph_hi;
#define PHASE_BEGIN(k) if (ph >= lo && ph < hi) { if (PHON(k)) { int tidx = tid; asm volatile("" : "+s"(ws), "+s"(outg), "+v"(tidx)); const int lanex = tidx & 63, wavex = __builtin_amdgcn_readfirstlane(tidx >> 6), gwx = blk * NWAVES + wavex, gtidx = blk * (NWAVES * 64) + tidx; (void)lanex; (void)gwx; (void)gtidx;
#define PHASE_END   } if (ph + 1 < hi) xcd_barrier(bar); } ++ph;

    GAS float* outg = (GAS float*)args.out;
#define out ((float*)outg)

    PHASE_BEGIN(0) prologue(P, lds, gtidx, NGT, gwx, NGW, wavex, lanex); PHASE_END

#pragma unroll 1
    for (int l = 0; l < 2; ++l) {
#define TB ((bf16*)(ws + WS_TB))
#define HB ((bf16*)(ws + WS_BIG))
#define Z ((bf16*)(ws + WS_BIG))
#define csb ((float*)(ws + WS_CSB))
#define ones ((const float*)(ws + WS_VEC))
#define zeros (ones + 2048)
#define st_prev (l ? (const float*)(ws + WS_ST + 2 * STAT_BYTES) : (const float*)(ws + WS_ST0))
#define g_prev (l ? P.in[20] : ones)
#define b_prev (l ? P.in[21] : zeros)
#define st1 ((float*)(ws + WS_ST + (size_t)(3 * l + 0) * STAT_BYTES))
#define st2 ((float*)(ws + WS_ST + (size_t)(3 * l + 1) * STAT_BYTES))
#define st3 ((float*)(ws + WS_ST + (size_t)(3 * l + 2) * STAT_BYTES))
#define ssq_att ((float*)(ws + WS_SSQ + (size_t)(2 * l) * SSQ_BYTES))
#define ssq_rec ((float*)(ws + WS_SSQ + (size_t)(2 * l + 1) * SSQ_BYTES))
        PHASE_BEGIN(1) { pg8::Gemm gm{TB, (const bf16*)(ws + WS_WGU1), T, 2 * FF, D, D}; pg8::StaticOrder S; S.init(T, 2 * FF, G, blk);
            pg8::EpiGU E{HB, st_prev, csb, csb + 16384};
            pg8::gemm_phase<pg8::EpiGU, pg8::StaticOrder, PG8_ALIGN, PG8_SP2>(lds + RING_OFF, gm, S, E, tidx); } PHASE_END
        PHASE_BEGIN(2) { pg8::Gemm gm{HB, (const bf16*)(ws + WS_WD1), T, D, FF, FF}; pg8::StaticOrder S; S.init(T, D, G, blk);
            pg8::EpiRes E{l ? out : P.in[0], l ? out : P.in[1] - (size_t)TPR * D, out, TB, st_prev, g_prev, b_prev, st1, 0.5f};
            pg8::gemm_phase<pg8::EpiRes, pg8::StaticOrder, PG8_ALIGN, PG8_SP2>(lds + RING_OFF, gm, S, E, tidx); } PHASE_END
        PHASE_BEGIN(3) { pg8::Gemm gm{TB, (const bf16*)(ws + WS_WIN), T, NIN, D, D}; pg8::StaticOrder S; S.init(T, NIN, G, blk);
            pg8::EpiIn E{Z, st1, csb + 2 * 16384, csb + 3 * 16384, (const float*)(ws + WS_ROPE)};
            pg8::gemm_phase<pg8::EpiIn, pg8::StaticOrder, PG8_ALIGN, PG8_SP2>(lds + RING_OFF, gm, S, E, tidx); } PHASE_END
        PHASE_BEGIN(4)
#if defined(ATTN_VALU)
            attn_valu_phase(lds, Z, ssq_att, blk, G, wavex, lanex);
#else
            attn_mfma_phase(lds, Z, ssq_att, blk, G, tidx, wavex, lanex);
#endif
            if (PHON(5)) lru_phase<0>(lds, blk, G, tidx, lanex, wavex, Z, (const bf16*)(ws + WS_LRUW), P.in[10] + (size_t)l * 4 * LW, P.in[11] + (size_t)l * LW, P.in[13] + (size_t)l * 2 * LW, P.in[15] + (size_t)l * 2 * LW, P.in[16] + (size_t)l * 2 * LW, (float*)(ws + WS_TOT), ssq_rec); PHASE_END
        PHASE_BEGIN(6) lru_phase<1>(lds, blk, G, tidx, lanex, wavex, Z, (const bf16*)(ws + WS_LRUW), P.in[10] + (size_t)l * 4 * LW, P.in[11] + (size_t)l * LW, P.in[13] + (size_t)l * 2 * LW, P.in[15] + (size_t)l * 2 * LW, P.in[16] + (size_t)l * 2 * LW, (float*)(ws + WS_TOT), ssq_rec); PHASE_END
        PHASE_BEGIN(7) rmsnorm_phase(Z, ssq_att, ssq_rec, gwx, NGW, lanex); PHASE_END
        PHASE_BEGIN(8) { pg8::Gemm gm{Z, (const bf16*)(ws + WS_WOUT), T, D, D, NIN}; pg8::StaticOrder S; S.init(T, D, G, blk);
            pg8::EpiRes E{out, out, out, TB, st1, P.in[2] + (size_t)l * D, P.in[3] + (size_t)l * D, st2, 1.0f};
            pg8::gemm_phase<pg8::EpiRes, pg8::StaticOrder, PG8_ALIGN, PG8_SP2>(lds + RING_OFF, gm, S, E, tidx); } PHASE_END
        PHASE_BEGIN(1) { pg8::Gemm gm{TB, (const bf16*)(ws + WS_WGU2), T, 2 * FF, D, D}; pg8::StaticOrder S; S.init(T, 2 * FF, G, blk);
            pg8::EpiGU E{HB, st2, csb + 4 * 16384, csb + 5 * 16384};
            pg8::gemm_phase<pg8::EpiGU, pg8::StaticOrder, PG8_ALIGN, PG8_SP2>(lds + RING_OFF, gm, S, E, tidx); } PHASE_END
        PHASE_BEGIN(2) { pg8::Gemm gm{HB, (const bf16*)(ws + WS_WD2), T, D, FF, FF}; pg8::StaticOrder S; S.init(T, D, G, blk);
            pg8::EpiRes E{out, out, out, TB, st2, P.in[7] + (size_t)l * D, P.in[8] + (size_t)l * D, st3, 0.5f};
            pg8::gemm_phase<pg8::EpiRes, pg8::StaticOrder, PG8_ALIGN, PG8_SP2>(lds + RING_OFF, gm, S, E, tidx); } PHASE_END
        if (l == 0) { PHASE_BEGIN(9) convert_layer(P, 1, lds, gwx, NGW, wavex, lanex); PHASE_END }
    }
    PHASE_BEGIN(10) final_ln_phase(out, (const float*)(ws + WS_ST + 5 * STAT_BYTES), P.in[20] + D, P.in[21] + D, gwx, NGW, lanex); PHASE_END
#undef PHASE_BEGIN
#undef PHASE_END
#undef TB
#undef HB
#undef Z
#undef csb
#undef ones
#undef zeros
#undef st_prev
#undef g_prev
#undef b_prev
#undef st1
#undef st2
#undef st3
#undef ssq_att
#undef ssq_rec
#undef out
}
constexpr int N_PHASES = 1 + 9 + 1 + 9 + 1;

#ifndef MK_N_LAUNCHES
#define MK_N_LAUNCHES 1
#endif
extern "C" void kernel_launch(void* const* d_in, const int* in_sizes, int n_in, void* d_out, int out_size, void* d_ws, size_t ws_size, hipStream_t stream) {
    static int grid = 0;
    if (grid == 0) {
        if (n_in != 25 || out_size != T * D || ws_size < WS_END) { fprintf(stderr, "kernel_launch: unexpected shapes (n_in %d, out %d, ws %zu)\n", n_in, out_size, ws_size); grid = -1; return; }
        int dev = 0, cus = 0, per_cu = 0;
        if (hipGetDevice(&dev) != hipSuccess || hipDeviceGetAttribute(&cus, hipDeviceAttributeMultiprocessorCount, dev) != hipSuccess) { grid = -1; return; }
        if (hipFuncSetAttribute((const void*)enc_fwd, hipFuncAttributeMaxDynamicSharedMemorySize, LDS_BYTES) != hipSuccess) { grid = -1; return; }
        if (hipOccupancyMaxActiveBlocksPerMultiprocessor(&per_cu, (const void*)enc_fwd, NWAVES * 64, LDS_BYTES) != hipSuccess || per_cu < 1) fprintf(stderr, "kernel_launch: occupancy query reports %d\n", per_cu);
        (void)hipGetLastError();
        grid = cus;
    }
    if (grid < 0) return;
    if (hipMemsetAsync((char*)d_ws + WS_CTL, 0, CTL_ZERO_BYTES, stream) != hipSuccess) return;
    Args a{};
    for (int i = 0; i < 25; ++i) a.in[i] = (const float*)d_in[i];
    a.out = (float*)d_out; a.ws = (unsigned char*)d_ws;
#if MK_N_LAUNCHES == 1
    a.ph_lo = 0; a.ph_hi = N_PHASES;
    hipLaunchKernelGGL(enc_fwd, dim3(grid), dim3(NWAVES * 64), LDS_BYTES, stream, a);
#else
    for (int p = 0; p < N_PHASES; ++p) { a.ph_lo = p; a.ph_hi = p + 1; hipLaunchKernelGGL(enc_fwd, dim3(grid), dim3(NWAVES * 64), LDS_BYTES, stream, a); }
#endif
}
```

```cpp
#include <hip/hip_runtime.h>
#include <cstdio>
#include <cstdint>

#ifndef PG8_SP2
#define PG8_SP2 true
#endif
#ifndef PG8_ALIGN
#define PG8_ALIGN true
#endif
constexpr int NWAVES = 8;
constexpr int T = 49152, TPR = 32768, D = 2048, FF = 5632, NIN = 4864, AW = 768, LW = 1280;
constexpr int ZQ = 0, ZGL = 768, ZK = 2048, ZV = 2816, ZXL = 3584;
constexpr int LCH = 128, NCHUNK = T / LCH;
constexpr size_t MiB = 1u << 20;
constexpr size_t WS_CTL = 0, CTL_ZERO_BYTES = 5 * MiB;
constexpr size_t STAT_BYTES = (size_t)T * 8, SSQ_BYTES = (size_t)T * 4;
constexpr size_t WS_ST = 1 * MiB;
constexpr size_t WS_SSQ = WS_ST + 6 * STAT_BYTES;
constexpr size_t WS_CSB = 4 * MiB;
static_assert(WS_SSQ + 4 * SSQ_BYTES <= WS_CSB && WS_CSB + 2 * 6 * 65536 <= CTL_ZERO_BYTES, "zero region");
constexpr size_t WS_ST0 = 5 * MiB;
constexpr size_t WS_VEC = 5 * MiB + 512 * 1024;
constexpr size_t WS_ROPE = 6 * MiB;
constexpr size_t WS_LRUW = 7 * MiB;
constexpr size_t WS_TOT = 10 * MiB;
constexpr size_t WS_WGU1 = 26 * MiB, WS_WD1 = 70 * MiB, WS_WIN = 92 * MiB, WS_WOUT = 111 * MiB, WS_WGU2 = 119 * MiB, WS_WD2 = 163 * MiB;
constexpr size_t WS_TB = 185 * MiB;
constexpr size_t WS_BIG = 377 * MiB;
constexpr size_t WS_TB8 = 905 * MiB;
constexpr size_t WS_END = 1001 * MiB;
static_assert(WS_TOT + (size_t)NCHUNK * 2 * 1280 * 8 <= WS_WGU1 && WS_WD2 + (size_t)D * FF * 2 <= WS_TB && WS_TB + (size_t)T * D * 2 <= WS_BIG && WS_BIG + (size_t)T * FF * 2 <= WS_TB8 && WS_TB8 + (size_t)T * D <= WS_END, "d_ws map");
constexpr int CW_BAR = 4096;
constexpr int RING_OFF = 0, RING_BYTES = 131072;
constexpr int LDSCTL_OFF = RING_BYTES, MISC_OFF = LDSCTL_OFF + 320;
constexpr int LDS_BYTES = 147456;
struct Args { const float* in[25]; float* out; unsigned char* ws; int ph_lo, ph_hi; };
#define GAS __attribute__((address_space(1)))
typedef const __attribute__((address_space(4))) Args* CArgs;
namespace pg8 {
#define PG8_LAS __attribute__((address_space(3)))
typedef unsigned short bf16_t;
typedef short bf16x8 __attribute__((ext_vector_type(8)));
typedef float f32x4 __attribute__((ext_vector_type(4)));
typedef unsigned u32x4 __attribute__((ext_vector_type(4)));
constexpr int BM = 256, BK = 64, HALF = 128, HTB = HALF * BK * 2  , STAGE_BYTES = 8 * HTB, NXCD = 8;
#ifndef PG8_WGM
#define PG8_WGM 4
#endif
constexpr int WGM = PG8_WGM;

__host__ __device__ __forceinline__ int lds_byte(int r, int c) { const int st = (r >> 4) * 2 + (c >> 5), rr = r & 15, cc = c & 31, ob = rr * 64 + cc * 2; return st * 1024 + (ob ^ (((ob >> 9) & 1) << 5)); }
__host__ __device__ __forceinline__ void stage_rc(int b, int& R, int& C) { const int st = b / 1024, sb = b % 1024, swz = sb ^ (((sb >> 9) & 1) << 5); R = (st >> 1) * 16 + swz / 64; C = (st & 1) * 32 + (swz % 64) / 2; }
__host__ __device__ __forceinline__ int perm32(int rho) { const int n = rho >> 4, i = rho & 15; return 8 * (i >> 2) + 4 * n + (i & 3); }

struct Unit { int pm, pn; };
struct Gemm { const bf16_t* A; const bf16_t* Bt; int M, N, K, lda; };

struct StaticOrder {
    int nM, nN, nwg, G, c, wgm;
    __host__ __device__ void init(int M, int N, int G_, int c_, int wgm_ = WGM) { nM = M / BM; nN = N / BM; nwg = nM * nN; G = G_; c = c_; wgm = wgm_; }
    __host__ __device__ bool next(int i, Unit& u) const {
        const long L = (long)i * G + c; if (L >= nwg) return false;
        int wgid = (int)L; { const int q = nwg / NXCD, r = nwg % NXCD, xcd = wgid % NXCD, off = wgid / NXCD; wgid = (xcd < r ? xcd * (q + 1) : r * (q + 1) + (xcd - r) * q) + off; }
        const int nig = wgm * nN, gid = wgid / nig, fm = gid * wgm, gsz = (nM - fm) < wgm ? (nM - fm) : wgm;
        u.pm = fm + ((wgid % nig) % gsz); u.pn = (wgid % nig) / gsz; return true;
    }
    __device__ __forceinline__ void a_ready(const Unit&) const {}
    __device__ __forceinline__ void done(const Unit&) const {}
};


struct FixedOrder : StaticOrder {
    __host__ __device__ bool next(int i, Unit& u) const { const long L = (long)i * G + c; if (L >= nwg) return false; u.pm = 0; u.pn = 0; return true; }
};

__device__ __forceinline__ unsigned cvt_pk_bf16(float lo, float hi) { unsigned r; asm volatile("v_cvt_pk_bf16_f32 %0, %1, %2" : "=v"(r) : "v"(lo), "v"(hi)); return r; }
__device__ __forceinline__ float shx(float v, int m, int lane) { return __builtin_bit_cast(float, __builtin_amdgcn_ds_bpermute((lane ^ m) << 2, __builtin_bit_cast(int, v))); }
__device__ __forceinline__ float shl(float v, int src) { return __builtin_bit_cast(float, __builtin_amdgcn_ds_bpermute(src << 2, __builtin_bit_cast(int, v))); }
__device__ __forceinline__ int lane_now() { int l; asm volatile("v_mbcnt_lo_u32_b32 %0, -1, 0\n\tv_mbcnt_hi_u32_b32 %0, -1, %0" : "=v"(l)); return l; }
template <int SH> __device__ __forceinline__ float qgrid(float x) { return __builtin_rintf(x * (float)(1 << SH)) * (1.0f / (float)(1 << SH)); }
typedef float f32x2 __attribute__((ext_vector_type(2)));
typedef unsigned u32x2 __attribute__((ext_vector_type(2)));
constexpr float ALPHA_RES = 1.41421356237309515f;
__device__ __forceinline__ void row_stats(const float* st, int r, float& mu, float& rstd) {
    const f32x2 s = *(const f32x2*)(st + 2 * (size_t)r);
    mu = s.x * (1.0f / 2048.0f); const float var = s.y * (1.0f / 2048.0f) - mu * mu;
    rstd = __builtin_amdgcn_rsqf(fmaxf(var, 0.0f) + 1e-5f);
}
__device__ __forceinline__ unsigned pk_f16(float lo, float hi) { unsigned r; asm("v_cvt_pk_f16_f32 %0, %1, %2" : "=v"(r) : "v"(lo), "v"(hi)); return r; }
__device__ __forceinline__ float f16_lo(unsigned w) { return (float)__builtin_bit_cast(_Float16, (unsigned short)(w & 0xffffu)); }
__device__ __forceinline__ float f16_hi(unsigned w) { return (float)__builtin_bit_cast(_Float16, (unsigned short)(w >> 16)); }
__device__ __forceinline__ unsigned pk4_fp8(float a, float b, float c, float d) {
    int w = __builtin_amdgcn_cvt_pk_fp8_f32(a, b, 0, false); w = __builtin_amdgcn_cvt_pk_fp8_f32(c, d, w, true); return (unsigned)w; }
constexpr float F8_WSC = 512.0f, F8_HSC = 32.0f;
#ifndef FFN6_GU
#define FFN6_GU 0
#endif
#ifndef FFN6_D
#define FFN6_D 0
#endif
constexpr float GU_WSC = FFN6_GU ? 128.0f : 512.0f;
typedef float f32x16 __attribute__((ext_vector_type(16)));
typedef unsigned u32x6 __attribute__((ext_vector_type(6)));
constexpr float F6_WGU = 128.0f, F6_WD = 224.0f, F6_HSC = 6.0f;
__device__ __forceinline__ void swap32(float& a, float& b) { asm volatile("s_nop 1\n\tv_permlane32_swap_b32 %0, %1" : "+v"(a), "+v"(b)); }
__device__ __forceinline__ void swap16(float& a, float& b) { asm volatile("s_nop 1\n\tv_permlane16_swap_b32 %0, %1" : "+v"(a), "+v"(b)); }
__device__ __forceinline__ void tr4(float& x0, float& x1, float& x2, float& x3) { swap32(x0, x2); swap32(x1, x3); swap16(x0, x1); swap16(x2, x3); }
__device__ __forceinline__ void st_frag6(unsigned char* rowkt, int kb, int sw, const f32x16 lo, const f32x16 hi) {
    const u32x6 w = __builtin_amdgcn_cvt_scalef32_2xpk16_fp6_f32(lo, hi, 1.0f);
    *(u32x4*)(rowkt + 16 * kb) = (u32x4){w[0], w[1], w[2], w[3]}; *(u32x2*)(rowkt + 64 + 8 * (kb ^ sw)) = (u32x2){w[4], w[5]}; }
__device__ __forceinline__ float silu_f(float v) { return v * __builtin_amdgcn_rcpf(1.0f + __builtin_amdgcn_exp2f(v * -1.4426950408889634f)); }

struct EpiGU {
    static constexpr bool PERM = true, AFTER_DRAIN = false, PF = false; static constexpr int MIDK = 0;
    unsigned char* H; const float* st; const float* cs; const float* cb;
    __device__ __forceinline__ void operator()(const f32x4 (&acc)[2][2][4][2], const Unit& u, int wr, int wc, int fr, int fq) const {
        const int row0 = u.pm * BM + wr * 64 + fr, rb = u.pn * BM + wc * 32 + 8 * fq, hc = u.pn * 128 + wc * 32 + 8 * fq; constexpr float dsc = 1.0f / GU_WSC;
        f32x4 csg[2], cbg[2], csu[2], cbu[2]; f32x2 sv[8];
#pragma unroll
        for (int i = 0; i < 8; ++i) sv[i] = *(const f32x2*)(st + 2 * (size_t)(row0 + (i >> 2) * HALF + (i & 3) * 16));
        constexpr float NL2E = -1.4426950408889634f, NLN2 = -0.6931471805599453f;
#pragma unroll
        for (int n = 0; n < 2; ++n) { csg[n] = *(const f32x4*)(cs + rb + 4 * n) * NL2E; cbg[n] = *(const f32x4*)(cb + rb + 4 * n) * NL2E; csu[n] = *(const f32x4*)(cs + rb + HALF + 4 * n) * (F8_HSC * NLN2); cbu[n] = *(const f32x4*)(cb + rb + HALF + 4 * n) * (F8_HSC * NLN2); }
#pragma unroll
        for (int ai = 0; ai < 2; ++ai)
#pragma unroll
            for (int m = 0; m < 4; ++m) { const int r = row0 + ai * HALF + m * 16; const f32x2 s2 = sv[ai * 4 + m];
                const float mu = s2.x * (1.0f / 2048.0f), rstd = __builtin_amdgcn_rsqf(fmaxf(s2.y * (1.0f / 2048.0f) - mu * mu, 0.0f) + 1e-5f);
                const float ag = dsc * rstd * NL2E, au = dsc * rstd * (F8_HSC * NLN2), mr = mu * rstd;
                f32x4 hv[2];
#pragma unroll
                for (int n = 0; n < 2; ++n) { const f32x4 z = acc[ai][0][m][n] * ag + (cbg[n] - csg[n] * mr), up = acc[ai][1][m][n] * au + (cbu[n] - csu[n] * mr);
                    const f32x4 gt = z; f32x4 e, r;
#pragma unroll
                    for (int j = 0; j < 4; ++j) e[j] = __builtin_amdgcn_exp2f(z[j]);
                    const f32x4 den = e + 1.0f;
#pragma unroll
                    for (int j = 0; j < 4; ++j) r[j] = __builtin_amdgcn_rcpf(den[j]);
                    hv[n] = (gt * up) * r; }
                u32x2 w; w.x = pk4_fp8(hv[0][0], hv[0][1], hv[0][2], hv[0][3]); w.y = pk4_fp8(hv[1][0], hv[1][1], hv[1][2], hv[1][3]);
                *(u32x2*)(H + (size_t)r * 5632 + hc) = w; }
    }
};
struct EpiGU6 {
    static constexpr bool PERM = true, AFTER_DRAIN = false, PF = false; static constexpr int MIDK = 0;
    unsigned char* H; const float* st; const float* cs; const float* cb;
    __device__ __forceinline__ void operator()(const f32x4 (&acc)[2][2][4][2], const Unit& u, int wr, int wc, int fr, int fq) const {
        const int row0 = u.pm * BM + wr * 64 + fr, rb = u.pn * BM + wc * 32 + 8 * fq; constexpr float dsc = 1.0f / GU_WSC;
        f32x4 csg[2], cbg[2], csu[2], cbu[2]; f32x2 sv[8];
#pragma unroll
        for (int i = 0; i < 8; ++i) sv[i] = *(const f32x2*)(st + 2 * (size_t)(row0 + (i >> 2) * HALF + (i & 3) * 16));
#pragma unroll
        for (int n = 0; n < 2; ++n) { csg[n] = *(const f32x4*)(cs + rb + 4 * n); cbg[n] = *(const f32x4*)(cb + rb + 4 * n); csu[n] = *(const f32x4*)(cs + rb + HALF + 4 * n) * F6_HSC; cbu[n] = *(const f32x4*)(cb + rb + HALF + 4 * n) * F6_HSC; }
#pragma unroll
        for (int ai = 0; ai < 2; ++ai) { float hv[4][8];
#pragma unroll
            for (int m = 0; m < 4; ++m) { const f32x2 s2 = sv[ai * 4 + m];
                const float mu = s2.x * (1.0f / 2048.0f), rstd = __builtin_amdgcn_rsqf(fmaxf(s2.y * (1.0f / 2048.0f) - mu * mu, 0.0f) + 1e-5f);
                const float ag = dsc * rstd, au = ag * F6_HSC, mr = mu * rstd;
#pragma unroll
                for (int n = 0; n < 2; ++n) { const f32x4 gt = acc[ai][0][m][n] * ag + (cbg[n] - csg[n] * mr), up = acc[ai][1][m][n] * au + (cbu[n] - csu[n] * mr);
#pragma unroll
                    for (int j = 0; j < 4; ++j) hv[m][4 * n + j] = gt[j] * __builtin_amdgcn_rcpf(1.0f + __builtin_amdgcn_exp2f(gt[j] * -1.4426950408889634f)) * up[j]; } }
#pragma unroll
            for (int d = 0; d < 8; ++d) tr4(hv[0][d], hv[1][d], hv[2][d], hv[3][d]);
            f32x16 lo, hi;
#pragma unroll
            for (int d = 0; d < 8; ++d) { lo[d] = hv[0][d]; lo[8 + d] = hv[1][d]; hi[d] = hv[2][d]; hi[8 + d] = hv[3][d]; }
            const int r = u.pm * BM + wr * 64 + ai * HALF + fq * 16 + fr;
            st_frag6(H + (size_t)r * 4224 + 96 * u.pn, wc, (fr & 8) ? 2 : 0, lo, hi); }
    }
};
struct EpiIn {
    static constexpr bool PERM = true, AFTER_DRAIN = false, PF = false; static constexpr int MIDK = 0;
    bf16_t* Z; const float* st; const float* cs; const float* cb; const float* rope;
    __device__ __forceinline__ void operator()(const f32x4 (&acc)[2][2][4][2], const Unit& u, int wr, int wc, int fr, int fq) const {
        const int row0 = u.pm * BM + wr * 64 + fr, rb = u.pn * BM + wc * 32 + 8 * fq;
        const bool rot = (u.pn < 3 || (u.pn >= 8 && u.pn < 11)) && ((wc & 1) == 0);
        f32x4 csv[2][2], cbv[2][2];
#pragma unroll
        for (int bj = 0; bj < 2; ++bj)
#pragma unroll
            for (int n = 0; n < 2; ++n) { csv[bj][n] = *(const f32x4*)(cs + rb + bj * HALF + 4 * n); cbv[bj][n] = *(const f32x4*)(cb + rb + bj * HALF + 4 * n); }
        f32x2 sv[8];
#pragma unroll
        for (int i = 0; i < 8; ++i) sv[i] = *(const f32x2*)(st + 2 * (size_t)(row0 + (i >> 2) * HALF + (i & 3) * 16));
#pragma unroll
        for (int ai = 0; ai < 2; ++ai)
#pragma unroll
            for (int m = 0; m < 4; ++m) { const int r = row0 + ai * HALF + m * 16; const f32x2 s2 = sv[ai * 4 + m];
                const float mu = s2.x * (1.0f / 2048.0f), rstd = __builtin_amdgcn_rsqf(fmaxf(s2.y * (1.0f / 2048.0f) - mu * mu, 0.0f) + 1e-5f);
                f32x4 cs0 = {1.f, 0.f, 1.f, 0.f}, cs1 = cs0, cs2 = cs0, cs3 = cs0;
                if (rot && fq < 2) { const int pos = r < 32768 ? (r & 4095) : (r - 32768); const f32x4* rp = (const f32x4*)(rope + (size_t)pos * 16); cs0 = rp[0]; cs1 = rp[1]; cs2 = rp[2]; cs3 = rp[3]; }
                const float sg = (fq == 0) ? -1.f : 1.f;
#pragma unroll
                for (int bj = 0; bj < 2; ++bj) { f32x4 v0 = (acc[ai][bj][m][0] - csv[bj][0] * mu) * rstd + cbv[bj][0], v1 = (acc[ai][bj][m][1] - csv[bj][1] * mu) * rstd + cbv[bj][1];
                    if (rot) { f32x4 p0, p1;
#pragma unroll
                        for (int j = 0; j < 4; ++j) { p0[j] = shx(v0[j], 16, (fr + 16 * fq)); p1[j] = shx(v1[j], 16, (fr + 16 * fq)); }
                        if (fq < 2) {
                            v0[0] = v0[0] * cs0[0] + sg * p0[0] * cs0[1]; v0[1] = v0[1] * cs0[2] + sg * p0[1] * cs0[3]; v0[2] = v0[2] * cs1[0] + sg * p0[2] * cs1[1]; v0[3] = v0[3] * cs1[2] + sg * p0[3] * cs1[3];
                            v1[0] = v1[0] * cs2[0] + sg * p1[0] * cs2[1]; v1[1] = v1[1] * cs2[2] + sg * p1[1] * cs2[3]; v1[2] = v1[2] * cs3[0] + sg * p1[2] * cs3[1]; v1[3] = v1[3] * cs3[2] + sg * p1[3] * cs3[3]; } }
                    u32x4 w; w.x = cvt_pk_bf16(v0[0], v0[1]); w.y = cvt_pk_bf16(v0[2], v0[3]); w.z = cvt_pk_bf16(v1[0], v1[1]); w.w = cvt_pk_bf16(v1[2], v1[3]);
                    *(u32x4*)(Z + (size_t)r * 4864 + rb + bj * HALF) = w; } }
    }
};
template <bool TB8, bool DUMMY = false, int MK = 0, bool FIN = false> struct EpiRes {
#ifndef RES_PF
#define RES_PF 0
#endif
    static constexpr bool PERM = true, AFTER_DRAIN = false, PF = (RES_PF != 0); static constexpr int MIDK = MK;
    CArgs a; GAS unsigned char* ws; int x_in;
    unsigned st_off, stout_off; int gi, bi, goff; float sc; unsigned ssq_off;
    __device__ __forceinline__ void pf(const Unit& u, int wid, int lane, PG8_LAS unsigned char* junk) const {
        if (x_in) return;
#pragma unroll
        for (int j = 0; j < 4; ++j) { const int sidx = (wid * 4 + j) * 64 + lane, row = sidx >> 3, sec = sidx & 7;
            GAS const unsigned char* p = ws + WS_TB + (size_t)(u.pm * BM + row) * 4096 + (size_t)(u.pn * 512 + sec * 64);
            __builtin_amdgcn_global_load_lds((GAS void*)p, (PG8_LAS void*)(junk + wid * 1024 + j * 256), 4, 0, 0); }
    }
    __device__ __forceinline__ void midk(f32x4 (&acc)[2][2][4][2], const Unit& u, int wr, int wc, int fr, int fq) const {
        const int row0 = u.pm * BM + wr * 64 + fr; const float* sa = (const float*)(ws + ssq_off); const float* sr = sa + T;
        float ra[8];
#pragma unroll
        for (int i = 0; i < 8; ++i) { const int r = row0 + (i >> 2) * HALF + (i & 3) * 16; ra[i] = __builtin_amdgcn_rsqf(sa[r] * (1.0f / 768.0f) + 1e-5f) * __builtin_amdgcn_sqrtf(sr[r] * (1.0f / 1280.0f) + 1e-5f); }
#pragma unroll
        for (int i = 0; i < 8; ++i)
#pragma unroll
            for (int bj = 0; bj < 2; ++bj)
#pragma unroll
                for (int n = 0; n < 2; ++n) acc[i >> 2][bj][i & 3][n] *= ra[i];
    }
    __device__ __forceinline__ void operator()(const f32x4 (&acc)[2][2][4][2], const Unit& u, int wr, int wc, int fr, int fq) const {
        const int row0 = u.pm * BM + wr * 64 + fr, col0 = u.pn * BM + wc * 32 + 8 * fq;
        unsigned char* RES = (unsigned char*)(ws + WS_TB); unsigned char* T8 = (unsigned char*)(ws + WS_TB8);
        f32x4 (&am)[2][2][4][2] = const_cast<f32x4 (&)[2][2][4][2]>(acc);
        const float* X = (u.pm < 128) ? a->in[0] : a->in[1] - (size_t)TPR * D;
        const float* st = (const float*)(ws + st_off); float* st_out = (float*)(ws + stout_off);
        const float* g = gi < 0 ? (const float*)(ws + WS_VEC) : a->in[gi] + goff; const float* b = gi < 0 ? (const float*)(ws + WS_VEC) + 2048 : a->in[bi] + goff;
        const unsigned rbase = (unsigned)row0 * 8192u + (unsigned)col0 * 4u;
#define RES_ROWOFF(i) ((unsigned)(((i) >> 2) * HALF + ((i) & 3) * 16) * 8192u)
#define RES_LOAD(dst, sdst, i) do { const unsigned ob_ = rbase + RES_ROWOFF(i); sdst = *(const f32x2*)((const char*)st + (size_t)(row0 + ((i) >> 2) * HALF + ((i) & 3) * 16) * 8); \
        if (x_in) { _Pragma("unroll") for (int bj = 0; bj < 2; ++bj) _Pragma("unroll") for (int n = 0; n < 2; ++n) dst[bj][n] = *(const f32x4*)((const char*)X + (ob_ + (unsigned)(bj * HALF + 4 * n) * 4u)); } \
        else { _Pragma("unroll") for (int bj = 0; bj < 2; ++bj) { const u32x4 w_ = *(const u32x4*)(RES + ((ob_ + (unsigned)(bj * HALF) * 4u) >> 1)); \
            dst[bj][0] = (f32x4){f16_lo(w_.x), f16_hi(w_.x), f16_lo(w_.y), f16_hi(w_.y)}; dst[bj][1] = (f32x4){f16_lo(w_.z), f16_hi(w_.z), f16_lo(w_.w), f16_hi(w_.w)}; } } } while (0)
        f32x4 gv[2][2], bv[2][2];
#pragma unroll
        for (int bj = 0; bj < 2; ++bj)
#pragma unroll
            for (int n = 0; n < 2; ++n) { gv[bj][n] = *(const f32x4*)(g + col0 + bj * HALF + 4 * n); bv[bj][n] = *(const f32x4*)(b + col0 + bj * HALF + 4 * n); }
#pragma unroll
        for (int bj = 0; bj < 2; ++bj)
#pragma unroll
            for (int n = 0; n < 2; ++n) { gv[bj][n] = gv[bj][n] * ALPHA_RES; bv[bj][n] = bv[bj][n] * ALPHA_RES; }
        const bool dmy_ = DUMMY && (sc == 12345.678f);
        f32x4 oo[2][2], oe[2][2];
        f32x4 t0[2][2], t1[2][2], t2[2][2]; f32x2 s0, s1, s2;
#ifndef RES_LA
#define RES_LA 2
#endif
        u32x4 rw[8][2]; f32x2 sw_[8];
#define RES_RAW(i) do { const unsigned ob_ = rbase + RES_ROWOFF(i); sw_[i] = *(const f32x2*)((const char*)st + (size_t)(row0 + ((i) >> 2) * HALF + ((i) & 3) * 16) * 8); \
        _Pragma("unroll") for (int bj = 0; bj < 2; ++bj) rw[i][bj] = *(const u32x4*)(RES + ((ob_ + (unsigned)(bj * HALF) * 4u) >> 1)); } while (0)
        if (x_in) { RES_LOAD(t0, s0, 0); RES_LOAD(t1, s1, 1); }
        else {
#pragma unroll
            for (int i = 0; i < RES_LA; ++i) RES_RAW(i); }
#pragma unroll
        for (int i = 0; i < 8; ++i) { const int r = row0 + (i >> 2) * HALF + (i & 3) * 16;
                if (x_in) { if (i < 6) RES_LOAD(t2, s2, i + 2); }
                else { if (i + RES_LA < 8) RES_RAW(i + RES_LA);
                    s0 = sw_[i];
#pragma unroll
                    for (int bj = 0; bj < 2; ++bj) { const u32x4 w_ = rw[i][bj]; t0[bj][0] = (f32x4){f16_lo(w_.x), f16_hi(w_.x), f16_lo(w_.y), f16_hi(w_.y)}; t0[bj][1] = (f32x4){f16_lo(w_.z), f16_hi(w_.z), f16_lo(w_.w), f16_hi(w_.w)}; } }
                const float mu = s0.x * (1.0f / 2048.0f), rstd = __builtin_amdgcn_rsqf(fmaxf(s0.y * (1.0f / 2048.0f) - mu * mu, 0.0f) + 1e-5f);
                float scr = sc; if constexpr (MK > 0) scr = sc * __builtin_amdgcn_rsqf(((const float*)(ws + ssq_off))[T + r] * (1.0f / 1280.0f) + 1e-5f);
                const unsigned ob = rbase + RES_ROWOFF(i); const float nmr = -mu * rstd; f32x4 sv4 = {0.f, 0.f, 0.f, 0.f}, qv4 = {0.f, 0.f, 0.f, 0.f};
#pragma unroll
                for (int bj = 0; bj < 2; ++bj) { f32x4 (&o)[2] = oo[bj];
#pragma unroll
                    for (int n = 0; n < 2; ++n) {
                        const f32x4 A_ = gv[bj][n] * rstd, C_ = gv[bj][n] * nmr + bv[bj][n];
                        o[n] = acc[i >> 2][bj][i & 3][n] * scr + (t0[bj][n] * A_ + C_);
                        sv4 = sv4 + o[n]; qv4 = o[n] * o[n] + qv4; }
                    const unsigned cb_ = ob + (unsigned)(bj * HALF) * 4u;
                    if constexpr (FIN) { am[i >> 2][bj][i & 3][0] = o[0]; am[i >> 2][bj][i & 3][1] = o[1]; }
                    else { u32x4 w; w.x = pk_f16(o[0][0], o[0][1]); w.y = pk_f16(o[0][2], o[0][3]); w.z = pk_f16(o[1][0], o[1][1]); w.w = pk_f16(o[1][2], o[1][3]); if (!DUMMY || dmy_) *(u32x4*)(RES + (cb_ >> 1)) = w; }
                    if constexpr (TB8 && !FFN6_GU) { u32x2 w; w.x = pk4_fp8(o[0][0], o[0][1], o[0][2], o[0][3]); w.y = pk4_fp8(o[1][0], o[1][1], o[1][2], o[1][3]); if (!DUMMY || dmy_) *(u32x2*)(T8 + (cb_ >> 2)) = w; } }
                if constexpr (TB8 && FFN6_GU) {
                    if ((i & 1) == 0) {
#pragma unroll
                        for (int bj = 0; bj < 2; ++bj)
#pragma unroll
                            for (int n = 0; n < 2; ++n) oe[bj][n] = oo[bj][n]; }
                    else { f32x16 lo, hi;
#pragma unroll
                        for (int d = 0; d < 8; ++d) { float x0 = oe[0][d >> 2][d & 3], x1 = oe[1][d >> 2][d & 3], x2 = oo[0][d >> 2][d & 3], x3 = oo[1][d >> 2][d & 3]; tr4(x0, x1, x2, x3); lo[d] = x0; lo[8 + d] = x1; hi[d] = x2; hi[8 + d] = x3; }
                        const int ri = row0 + ((i - 1 + (fq >> 1)) >> 2) * HALF + ((i - 1 + (fq >> 1)) & 3) * 16;
                        st_frag6(T8 + (size_t)ri * 1536 + 96 * (2 * u.pn + (fq & 1)), wc, (fr & 8) ? 2 : 0, lo, hi); } }
                float s = (sv4[0] + sv4[1]) + (sv4[2] + sv4[3]), q = (qv4[0] + qv4[1]) + (qv4[2] + qv4[3]);
                s += shx(s, 16, (fr + 16 * fq)); s += shx(s, 32, (fr + 16 * fq)); q += shx(q, 16, (fr + 16 * fq)); q += shx(q, 32, (fr + 16 * fq));
                if (fq == 0 && (!DUMMY || dmy_)) { unsafeAtomicAdd(st_out + 2 * (size_t)r, qgrid<8>(s)); unsafeAtomicAdd(st_out + 2 * (size_t)r + 1, qgrid<6>(q)); }
                if (x_in) {
#pragma unroll
                for (int bj = 0; bj < 2; ++bj)
#pragma unroll
                    for (int n = 0; n < 2; ++n) { t0[bj][n] = t1[bj][n]; t1[bj][n] = t2[bj][n]; }
                s0 = s1; s1 = s2; }
                asm volatile("" ::: "memory"); }
        if constexpr (FIN) {
            unsigned* cnt = (unsigned*)(ws + WS_CTL + 524288) + u.pm * 16;
            __builtin_amdgcn_fence(__ATOMIC_RELEASE, "agent");
            if (fr + 16 * fq == 0) __hip_atomic_fetch_add(cnt, 1u, __ATOMIC_RELAXED, __HIP_MEMORY_SCOPE_AGENT);
            { const unsigned long long t0_ = __builtin_amdgcn_s_memrealtime();
              while ((unsigned)__builtin_amdgcn_readfirstlane((int)__hip_atomic_load(cnt, __ATOMIC_RELAXED, __HIP_MEMORY_SCOPE_AGENT)) < 64u) { if (__builtin_amdgcn_s_memrealtime() - t0_ > 2000000ull) break; __builtin_amdgcn_s_sleep(2); } }
            __builtin_amdgcn_fence(__ATOMIC_ACQUIRE, "agent");
            const float* g3 = a->in[20] + D; const float* b3 = a->in[21] + D; float* OUT = a->out;
#pragma unroll
            for (int bj = 0; bj < 2; ++bj)
#pragma unroll
                for (int n = 0; n < 2; ++n) { gv[bj][n] = *(const f32x4*)(g3 + col0 + bj * HALF + 4 * n); bv[bj][n] = *(const f32x4*)(b3 + col0 + bj * HALF + 4 * n); }
#pragma unroll
            for (int i = 0; i < 8; ++i) { const int r = row0 + (i >> 2) * HALF + (i & 3) * 16;
                const float sx = __hip_atomic_load(st_out + 2 * (size_t)r, __ATOMIC_RELAXED, __HIP_MEMORY_SCOPE_AGENT), sy = __hip_atomic_load(st_out + 2 * (size_t)r + 1, __ATOMIC_RELAXED, __HIP_MEMORY_SCOPE_AGENT);
                const float mu = sx * (1.0f / 2048.0f), rstd = __builtin_amdgcn_rsqf(fmaxf(sy * (1.0f / 2048.0f) - mu * mu, 0.0f) + 1e-5f);
#pragma unroll
                for (int bj = 0; bj < 2; ++bj)
#pragma unroll
                    for (int n = 0; n < 2; ++n) *(f32x4*)(OUT + (size_t)r * 2048 + col0 + bj * HALF + 4 * n) = (am[i >> 2][bj][i & 3][n] - mu) * rstd * gv[bj][n] + bv[bj][n]; }
        }
#undef RES_LOAD
#undef RES_RAW
#undef RES_ROWOFF
    }
};

struct EpiNull {
    static constexpr bool PERM = true, AFTER_DRAIN = false, PF = false; static constexpr int MIDK = 0;
    float* sink;
    __device__ __forceinline__ void operator()(const f32x4 (&acc)[2][2][4][2], const Unit& u, int wr, int wc, int fr, int fq) const {
        float s = 0.f;
#pragma unroll
        for (int ai = 0; ai < 2; ++ai)
#pragma unroll
            for (int bj = 0; bj < 2; ++bj)
#pragma unroll
                for (int m = 0; m < 4; ++m)
#pragma unroll
                    for (int n = 0; n < 2; ++n) s += acc[ai][bj][m][n][0] + acc[ai][bj][m][n][1] + acc[ai][bj][m][n][2] + acc[ai][bj][m][n][3];
        if (s == 12345.678f) sink[0] = s;
    }
};
typedef int v4i_t __attribute__((ext_vector_type(4)));
typedef int v8i_t __attribute__((ext_vector_type(8)));
typedef int v2i_t __attribute__((ext_vector_type(2)));
__device__ __forceinline__ v8i_t cat8(bf16x8 lo, bf16x8 hi) { const v4i_t a = __builtin_bit_cast(v4i_t, lo), b = __builtin_bit_cast(v4i_t, hi); return __builtin_shufflevector(a, b, 0, 1, 2, 3, 4, 5, 6, 7); }
typedef _Float16 f16x8_t __attribute__((ext_vector_type(8)));
template <class Epi, class Sched, bool ALIGN_EPI = false, bool SP2 = false, bool F8 = false, bool F16 = false, int MREP = 1, bool F6 = false, bool CV6 = false, int BMASK = 0>
__device__ __forceinline__ void gemm_phase(PG8_LAS unsigned char* lds, const Gemm g, const Sched& S, const Epi& E, const int tid) {
    const int wid = __builtin_amdgcn_readfirstlane(tid >> 6), lane = tid & 63, wr = wid >> 2, wc = wid & 3, fr = lane & 15, fq = lane >> 4;
    const int K = g.K, nt = K / BK;
    static_assert(!F6 || SP2, "F6 is written for the SP2 loop");
    unsigned voffA[2], voffB[2];
#pragma unroll
    for (int i = 0; i < 2; ++i) {
        if constexpr (F6) { const int p0 = tid + 512 * i, p = p0 >= 768 ? p0 - 256 : p0, R = p / 6, Rb = Epi::PERM ? ((R & ~31) + perm32(R & 31)) : R;
            voffA[i] = (unsigned)(R * (g.lda * 3 / 2) + (p % 6) * 16); voffB[i] = (unsigned)(Rb * (K * 3 / 2) + (p % 6) * 16); }
        else { int R, C; stage_rc(tid * 16 + i * 8192, R, C); const int Rb = Epi::PERM ? ((R & ~31) + perm32(R & 31)) : R;
            voffA[i] = (unsigned)(R * g.lda + C) * 2u; voffB[i] = (unsigned)(Rb * K + C) * 2u; } }
    const size_t kstep = F6 ? (size_t)96 : (size_t)(BK * 2);
    const size_t hstep = F6 ? (size_t)HALF * K * 3 / 2 : (size_t)HALF * K * 2;
    const size_t tstep = 2 * hstep; const size_t hstepA = F6 ? (size_t)HALF * g.lda * 3 / 2 : (size_t)HALF * g.lda * 2, tstepA = 2 * hstepA;
    const unsigned ldsw = (unsigned)wid * 1024u;
    const int sw6 = (fr & 8) ? 2 : 0;
    const int aoff = F6 ? (wr * 64 + fr) * 96 + 16 * fq : lds_byte(wr * 64 + fr, fq * 8), boff = F6 ? (wc * 32 + fr) * 96 + 16 * fq : lds_byte(wc * 32 + fr, fq * 8); constexpr int KOFF = 1024;
    const int atl = (wr * 64 + fr) * 96 + 64 + 8 * (fq ^ sw6), btl = (wc * 32 + fr) * 96 + 64 + 8 * (fq ^ sw6);
#define PG8_SA(b, h) (((b) * 2 + (h)) * HTB)
#define PG8_SB(b, h) ((4 + (b) * 2 + (h)) * HTB)
    const __amdgpu_buffer_rsrc_t rsrcA = __builtin_amdgcn_make_buffer_rsrc((void*)g.A, 0, 0x7fffffff, 0x00020000), rsrcB = __builtin_amdgcn_make_buffer_rsrc((void*)g.Bt, 0, 0x7fffffff, 0x00020000);
#define PG8_STAGE(bufoff, goff, voff) do { if constexpr (BMASK != 0) { if ((BMASK == 3) || ((voff) == voffB && (BMASK & 1)) || ((voff) == voffA && (BMASK & 2))) asm volatile("s_mov_b64 exec, 0xffff" ::: "memory"); } _Pragma("unroll") for (int _i = 0; _i < 2; ++_i) { \
        __builtin_amdgcn_raw_ptr_buffer_load_lds(((voff) == voffA) ? rsrcA : rsrcB, (PG8_LAS void*)(lds + (bufoff) + ldsw + _i * 8192), 16, (int)(voff)[_i], (int)(goff), 0, 0); } if constexpr (BMASK != 0) asm volatile("s_mov_b64 exec, -1" ::: "memory"); } while (0)
#define PG8_LD6(dst, base, mainoff, tailoff) do { dst[0] = *(const PG8_LAS bf16x8*)(lds + (base) + (mainoff)); const v2i_t t_ = *(const PG8_LAS v2i_t*)(lds + (base) + (tailoff)); \
        dst[1] = __builtin_bit_cast(bf16x8, __builtin_shufflevector(t_, t_, 0, 1, -1, -1)); } while (0)
#define PG8_LDA(dst, b, h) do { _Pragma("unroll") for (int m = 0; m < 4; ++m) { if constexpr (F6) PG8_LD6(dst[m], PG8_SA(b, h) + m * 1536, aoff, atl); \
        else { _Pragma("unroll") for (int k = 0; k < 2; ++k) dst[m][k] = *(const PG8_LAS bf16x8*)(lds + PG8_SA(b, h) + aoff + m * 2048 + k * KOFF); if constexpr (CV6) { PG8_WAIT_L(0); PG8_CV6(dst[m], 4.0f); } } } } while (0)
#define PG8_LDB(dst, b, h) do { _Pragma("unroll") for (int n = 0; n < 2; ++n) { if constexpr (F6) PG8_LD6(dst[n], PG8_SB(b, h) + n * 1536, boff, btl); \
        else { _Pragma("unroll") for (int k = 0; k < 2; ++k) dst[n][k] = *(const PG8_LAS bf16x8*)(lds + PG8_SB(b, h) + boff + n * 2048 + k * KOFF); if constexpr (CV6) { PG8_WAIT_L(0); PG8_CV6(dst[n], 2.0f); } } } } while (0)
#define PG8_CV6(fr_, dv) do { const v4i_t a_ = __builtin_bit_cast(v4i_t, fr_[0]), b_ = __builtin_bit_cast(v4i_t, fr_[1]); f32x16 lo_, hi_; \
        _Pragma("unroll") for (int q_ = 0; q_ < 4; ++q_) { lo_[4 * q_] = __builtin_amdgcn_cvt_f32_fp8(a_[q_], 0); lo_[4 * q_ + 1] = __builtin_amdgcn_cvt_f32_fp8(a_[q_], 1); lo_[4 * q_ + 2] = __builtin_amdgcn_cvt_f32_fp8(a_[q_], 2); lo_[4 * q_ + 3] = __builtin_amdgcn_cvt_f32_fp8(a_[q_], 3); \
            hi_[4 * q_] = __builtin_amdgcn_cvt_f32_fp8(b_[q_], 0); hi_[4 * q_ + 1] = __builtin_amdgcn_cvt_f32_fp8(b_[q_], 1); hi_[4 * q_ + 2] = __builtin_amdgcn_cvt_f32_fp8(b_[q_], 2); hi_[4 * q_ + 3] = __builtin_amdgcn_cvt_f32_fp8(b_[q_], 3); } \
        const u32x6 w_ = __builtin_amdgcn_cvt_scalef32_2xpk16_fp6_f32(lo_, hi_, dv); fr_[0] = __builtin_bit_cast(bf16x8, (u32x4){w_[0], w_[1], w_[2], w_[3]}); fr_[1] = __builtin_bit_cast(bf16x8, (u32x4){w_[4], w_[5], 0u, 0u}); } while (0)
#define PG8_MMA(ai, bj, At, Bt) do { __builtin_amdgcn_s_setprio(1); _Pragma("unroll") for (int rep_ = 0; rep_ < MREP; ++rep_) _Pragma("unroll") for (int m = 0; m < 4; ++m) _Pragma("unroll") for (int n = 0; n < 2; ++n) { \
        if constexpr (F6 || CV6) acc[ai][bj][m][n] = __builtin_amdgcn_mfma_scale_f32_16x16x128_f8f6f4(cat8(Bt[n][0], Bt[n][1]), cat8(At[m][0], At[m][1]), acc[ai][bj][m][n], 2, 2, 0, 0x7f7f7f7f, 0, 0x7f7f7f7f); \
        else if constexpr (F8) acc[ai][bj][m][n] = __builtin_amdgcn_mfma_scale_f32_16x16x128_f8f6f4(cat8(Bt[n][0], Bt[n][1]), cat8(At[m][0], At[m][1]), acc[ai][bj][m][n], 0, 0, 0, 0x7f7f7f7f, 0, 0x7f7f7f7f); \
        else if constexpr (F16) { _Pragma("unroll") for (int k = 0; k < 2; ++k) acc[ai][bj][m][n] = __builtin_amdgcn_mfma_f32_16x16x32_f16(__builtin_bit_cast(f16x8_t, Bt[n][k]), __builtin_bit_cast(f16x8_t, At[m][k]), acc[ai][bj][m][n], 0, 0, 0); } \
        else { _Pragma("unroll") for (int k = 0; k < 2; ++k) acc[ai][bj][m][n] = __builtin_amdgcn_mfma_f32_16x16x32_bf16(Bt[n][k], At[m][k], acc[ai][bj][m][n], 0, 0, 0); } } __builtin_amdgcn_s_setprio(0); } while (0)
#define PG8_ST1(bufoff, goff, voff, _i) do { __builtin_amdgcn_raw_ptr_buffer_load_lds(((voff) == voffA) ? rsrcA : rsrcB, (PG8_LAS void*)(lds + (bufoff) + ldsw + (_i) * 8192), 16, (int)(voff)[_i], (int)(goff), 0, 0); PG8_SCHED; } while (0)
#define PG8_MMQ(ai, bj, m, At, Bt) do { _Pragma("unroll") for (int n = 0; n < 2; ++n) { \
        if constexpr (F6 || CV6) acc[ai][bj][m][n] = __builtin_amdgcn_mfma_scale_f32_16x16x128_f8f6f4(cat8(Bt[n][0], Bt[n][1]), cat8(At[m][0], At[m][1]), acc[ai][bj][m][n], 2, 2, 0, 0x7f7f7f7f, 0, 0x7f7f7f7f); \
        else if constexpr (F8) acc[ai][bj][m][n] = __builtin_amdgcn_mfma_scale_f32_16x16x128_f8f6f4(cat8(Bt[n][0], Bt[n][1]), cat8(At[m][0], At[m][1]), acc[ai][bj][m][n], 0, 0, 0, 0x7f7f7f7f, 0, 0x7f7f7f7f); \
        else if constexpr (F16) { _Pragma("unroll") for (int k = 0; k < 2; ++k) acc[ai][bj][m][n] = __builtin_amdgcn_mfma_f32_16x16x32_f16(__builtin_bit_cast(f16x8_t, Bt[n][k]), __builtin_bit_cast(f16x8_t, At[m][k]), acc[ai][bj][m][n], 0, 0, 0); } \
        else { _Pragma("unroll") for (int k = 0; k < 2; ++k) acc[ai][bj][m][n] = __builtin_amdgcn_mfma_f32_16x16x32_bf16(Bt[n][k], At[m][k], acc[ai][bj][m][n], 0, 0, 0); } } PG8_SCHED; } while (0)
#define PG8_BLK1(At, B0, B1, buf, goff, voff) do { __builtin_amdgcn_s_setprio(1); PG8_MMQ(0, 0, 0, At, B0); PG8_MMQ(0, 0, 1, At, B0); PG8_ST1(buf, goff, voff, 0); PG8_MMQ(0, 0, 2, At, B0); PG8_MMQ(0, 0, 3, At, B0); PG8_ST1(buf, goff, voff, 1); \
        PG8_MMQ(0, 1, 0, At, B1); PG8_MMQ(0, 1, 1, At, B1); PG8_MMQ(0, 1, 2, At, B1); PG8_MMQ(0, 1, 3, At, B1); __builtin_amdgcn_s_setprio(0); } while (0)
#define PG8_BLK2(At, B0, B1, buf0, goff0, voff0, buf1, goff1, voff1, buf2, goff2, voff2) do { __builtin_amdgcn_s_setprio(1); PG8_MMQ(1, 0, 0, At, B0); PG8_ST1(buf0, goff0, voff0, 0); PG8_MMQ(1, 0, 1, At, B0); PG8_ST1(buf0, goff0, voff0, 1); \
        PG8_MMQ(1, 0, 2, At, B0); PG8_ST1(buf1, goff1, voff1, 0); PG8_MMQ(1, 0, 3, At, B0); PG8_ST1(buf1, goff1, voff1, 1); PG8_MMQ(1, 1, 0, At, B1); PG8_ST1(buf2, goff2, voff2, 0); PG8_MMQ(1, 1, 1, At, B1); PG8_ST1(buf2, goff2, voff2, 1); \
        PG8_MMQ(1, 1, 2, At, B1); PG8_MMQ(1, 1, 3, At, B1); __builtin_amdgcn_s_setprio(0); } while (0)
#define PG8_BLK2H(At, B0, B1, buf1, goff1, voff1, buf2, goff2, voff2) do { __builtin_amdgcn_s_setprio(1); PG8_MMQ(1, 0, 0, At, B0); PG8_MMQ(1, 0, 1, At, B0); PG8_ST1(buf1, goff1, voff1, 1); \
        PG8_MMQ(1, 0, 2, At, B0); PG8_MMQ(1, 0, 3, At, B0); PG8_ST1(buf2, goff2, voff2, 0); PG8_MMQ(1, 1, 0, At, B1); PG8_MMQ(1, 1, 1, At, B1); PG8_ST1(buf2, goff2, voff2, 1); \
        PG8_MMQ(1, 1, 2, At, B1); PG8_MMQ(1, 1, 3, At, B1); __builtin_amdgcn_s_setprio(0); } while (0)
#ifndef PG8_DMI
#define PG8_DMI 0
#endif
#define PG8_WAIT_V(n) asm volatile("s_waitcnt vmcnt(" #n ")" ::: "memory")
#define PG8_WAIT_L(n) asm volatile("s_waitcnt lgkmcnt(" #n ")" ::: "memory")
#define PG8_BAR __builtin_amdgcn_s_barrier()
#define PG8_SCHED __builtin_amdgcn_sched_barrier(0)
    Unit cur, nxt; int ui = 0;
    if (!S.next(0, cur)) return;
    f32x4 acc[2][2][4][2];
#pragma unroll
    for (int a = 0; a < 2; ++a)
#pragma unroll
        for (int b = 0; b < 2; ++b)
#pragma unroll
            for (int m = 0; m < 4; ++m)
#pragma unroll
                for (int n = 0; n < 2; ++n) acc[a][b][m][n] = (f32x4){0.f, 0.f, 0.f, 0.f};
    bf16x8 At[4][2], B0[2][2], B1[2][2];
    unsigned cA = (unsigned)((size_t)cur.pm * tstepA), cB = (unsigned)((size_t)cur.pn * tstep);
    S.a_ready(cur);
    if constexpr (Epi::PF) E.pf(cur, wid, lane, lds + 133120);
    if constexpr (SP2) {
        PG8_STAGE(PG8_SB(0, 0), cB, voffB); PG8_STAGE(PG8_SB(0, 1), cB + hstep, voffB); PG8_STAGE(PG8_SA(0, 0), cA, voffA); PG8_STAGE(PG8_SA(0, 1), cA + hstepA, voffA);
        if (wr == 1) PG8_BAR;
        PG8_WAIT_V(2); PG8_BAR;
        PG8_STAGE(PG8_SB(1, 0), cB + kstep, voffB); PG8_STAGE(PG8_SA(1, 0), cA + kstep, voffA); PG8_STAGE(PG8_SB(1, 1), cB + hstep + kstep, voffB);
        PG8_WAIT_V(6); PG8_BAR;
    } else {
        PG8_STAGE(PG8_SB(0, 0), cB, voffB); PG8_STAGE(PG8_SA(0, 0), cA, voffA); PG8_STAGE(PG8_SB(0, 1), cB + hstep, voffB); PG8_STAGE(PG8_SA(0, 1), cA + hstepA, voffA);
        if (wr == 1) PG8_BAR;
        PG8_WAIT_V(4); PG8_BAR;
        PG8_STAGE(PG8_SB(1, 0), cB + kstep, voffB); PG8_STAGE(PG8_SA(1, 0), cA + kstep, voffA); PG8_STAGE(PG8_SB(1, 1), cB + hstep + kstep, voffB);
        PG8_WAIT_V(6); PG8_BAR;
    }
    for (;;) {
        const bool has_next = S.next(ui + 1, nxt);
        const unsigned nA = has_next ? (unsigned)((size_t)nxt.pm * tstepA) : cA, nB = has_next ? (unsigned)((size_t)nxt.pn * tstep) : cB;
        for (int t = 0; t < nt; t += 2) {
            const bool last = (t == nt - 2);
            const unsigned a1 = cA + (unsigned)((t + 1) * kstep);
            const unsigned a2 = last ? nA : cA + (unsigned)((t + 2) * kstep), b2 = last ? nB : cB + (unsigned)((t + 2) * kstep);
            const unsigned a3 = a2 + (unsigned)kstep, b3 = b2 + (unsigned)kstep;
            if (last && has_next) S.a_ready(nxt);
            if constexpr (Epi::MIDK > 0) { if (t == Epi::MIDK) E.midk(acc, cur, wr, wc, lane & 15, lane >> 4); }
            if constexpr (SP2 && PG8_DMI == 2 && MREP == 1) {
            PG8_LDB(B0, 0, 0); PG8_LDB(B1, 0, 1); PG8_SCHED; PG8_LDA(At, 0, 0); PG8_STAGE(PG8_SA(1, 1), a1 + hstepA, voffA);
            PG8_WAIT_V(8); PG8_WAIT_L(0); PG8_BAR; PG8_MMA(0, 0, At, B0); PG8_MMA(0, 1, At, B1); PG8_BAR; PG8_SCHED;
            PG8_LDA(At, 0, 1); PG8_STAGE(PG8_SB(0, 0), b2, voffB); PG8_ST1(PG8_SB(0, 1), b2 + hstep, voffB, 0);
            PG8_WAIT_V(5); PG8_WAIT_L(0); PG8_BAR; PG8_BLK2H(At, B0, B1, PG8_SB(0, 1), b2 + hstep, voffB, PG8_SA(0, 0), a2, voffA); PG8_BAR; PG8_SCHED;
            PG8_LDB(B0, 1, 0); PG8_LDB(B1, 1, 1); PG8_SCHED; PG8_LDA(At, 1, 0); PG8_STAGE(PG8_SA(0, 1), a2 + hstepA, voffA);
            PG8_WAIT_V(8); PG8_WAIT_L(0); PG8_BAR; PG8_MMA(0, 0, At, B0); PG8_MMA(0, 1, At, B1); PG8_BAR; PG8_SCHED;
            PG8_LDA(At, 1, 1); PG8_STAGE(PG8_SB(1, 0), b3, voffB); PG8_ST1(PG8_SB(1, 1), b3 + hstep, voffB, 0);
            PG8_WAIT_V(5); PG8_WAIT_L(0); PG8_BAR; PG8_BLK2H(At, B0, B1, PG8_SB(1, 1), b3 + hstep, voffB, PG8_SA(1, 0), a3, voffA); PG8_BAR; PG8_SCHED;
            } else if constexpr (SP2 && PG8_DMI == 1 && MREP == 1) {
            PG8_LDB(B0, 0, 0); PG8_LDB(B1, 0, 1); PG8_SCHED; PG8_LDA(At, 0, 0);
            PG8_WAIT_V(6); PG8_WAIT_L(0); PG8_BAR; PG8_BLK1(At, B0, B1, PG8_SA(1, 1), a1 + hstepA, voffA); PG8_BAR; PG8_SCHED;
            PG8_LDA(At, 0, 1);
            PG8_WAIT_V(2); PG8_WAIT_L(0); PG8_BAR; PG8_BLK2(At, B0, B1, PG8_SB(0, 0), b2, voffB, PG8_SB(0, 1), b2 + hstep, voffB, PG8_SA(0, 0), a2, voffA); PG8_BAR; PG8_SCHED;
            PG8_LDB(B0, 1, 0); PG8_LDB(B1, 1, 1); PG8_SCHED; PG8_LDA(At, 1, 0);
            PG8_WAIT_V(6); PG8_WAIT_L(0); PG8_BAR; PG8_BLK1(At, B0, B1, PG8_SA(0, 1), a2 + hstepA, voffA); PG8_BAR; PG8_SCHED;
            PG8_LDA(At, 1, 1);
            PG8_WAIT_V(2); PG8_WAIT_L(0); PG8_BAR; PG8_BLK2(At, B0, B1, PG8_SB(1, 0), b3, voffB, PG8_SB(1, 1), b3 + hstep, voffB, PG8_SA(1, 0), a3, voffA); PG8_BAR; PG8_SCHED;
            } else if constexpr (SP2) {
            PG8_LDB(B0, 0, 0); PG8_LDB(B1, 0, 1); PG8_SCHED; PG8_LDA(At, 0, 0); PG8_STAGE(PG8_SA(1, 1), a1 + hstepA, voffA);
            PG8_WAIT_V(8); PG8_WAIT_L(0); PG8_BAR; PG8_MMA(0, 0, At, B0); PG8_MMA(0, 1, At, B1); PG8_BAR; PG8_SCHED;
            PG8_LDA(At, 0, 1); PG8_STAGE(PG8_SB(0, 0), b2, voffB); PG8_STAGE(PG8_SB(0, 1), b2 + hstep, voffB); PG8_STAGE(PG8_SA(0, 0), a2, voffA);
            PG8_WAIT_V(8); PG8_WAIT_L(0); PG8_BAR; PG8_MMA(1, 0, At, B0); PG8_MMA(1, 1, At, B1); PG8_BAR; PG8_SCHED;
            PG8_LDB(B0, 1, 0); PG8_LDB(B1, 1, 1); PG8_SCHED; PG8_LDA(At, 1, 0); PG8_STAGE(PG8_SA(0, 1), a2 + hstepA, voffA);
            PG8_WAIT_V(8); PG8_WAIT_L(0); PG8_BAR; PG8_MMA(0, 0, At, B0); PG8_MMA(0, 1, At, B1); PG8_BAR; PG8_SCHED;
            PG8_LDA(At, 1, 1); PG8_STAGE(PG8_SB(1, 0), b3, voffB); PG8_STAGE(PG8_SB(1, 1), b3 + hstep, voffB); PG8_STAGE(PG8_SA(1, 0), a3, voffA);
            PG8_WAIT_V(8); PG8_WAIT_L(0); PG8_BAR; PG8_MMA(1, 0, At, B0); PG8_MMA(1, 1, At, B1); PG8_BAR; PG8_SCHED;
            } else {
            PG8_LDB(B0, 0, 0); PG8_SCHED; PG8_LDA(At, 0, 0); PG8_STAGE(PG8_SA(1, 1), a1 + hstepA, voffA);
            PG8_WAIT_L(8); PG8_BAR; PG8_WAIT_L(0); PG8_MMA(0, 0, At, B0); PG8_BAR; PG8_SCHED;
            PG8_LDB(B1, 0, 1); PG8_STAGE(PG8_SB(0, 0), b2, voffB);
            PG8_BAR; PG8_WAIT_L(0); PG8_MMA(0, 1, At, B1); PG8_BAR;
            PG8_LDA(At, 0, 1); PG8_STAGE(PG8_SA(0, 0), a2, voffA);
            PG8_BAR; PG8_WAIT_L(0); PG8_MMA(1, 0, At, B0); PG8_BAR; PG8_SCHED;
            PG8_STAGE(PG8_SB(0, 1), b2 + hstep, voffB);
            PG8_WAIT_V(6); PG8_BAR; PG8_MMA(1, 1, At, B1); PG8_BAR;
            PG8_LDB(B0, 1, 0); PG8_SCHED; PG8_LDA(At, 1, 0); PG8_STAGE(PG8_SA(0, 1), a2 + hstepA, voffA);
            PG8_WAIT_L(8); PG8_BAR; PG8_WAIT_L(0); PG8_MMA(0, 0, At, B0); PG8_BAR; PG8_SCHED;
            PG8_LDB(B1, 1, 1); PG8_STAGE(PG8_SB(1, 0), b3, voffB);
            PG8_BAR; PG8_WAIT_L(0); PG8_MMA(0, 1, At, B1); PG8_BAR;
            PG8_LDA(At, 1, 1); PG8_STAGE(PG8_SA(1, 0), a3, voffA);
            PG8_BAR; PG8_WAIT_L(0); PG8_MMA(1, 0, At, B0); PG8_BAR; PG8_SCHED;
            PG8_STAGE(PG8_SB(1, 1), b3 + hstep, voffB);
            PG8_WAIT_V(6); PG8_BAR; PG8_MMA(1, 1, At, B1); PG8_BAR;
            }
        }
        if constexpr (ALIGN_EPI) { if (wr == 0) PG8_BAR; }
        if constexpr (!Epi::AFTER_DRAIN) { const int l2 = lane_now(); if constexpr (Epi::PF) { if (has_next) E.pf(nxt, wid, l2, lds + 133120); } E(acc, cur, wr, wc, l2 & 15, l2 >> 4); S.done(cur); }
        if (!has_next) break;
#pragma unroll
        for (int a = 0; a < 2; ++a)
#pragma unroll
            for (int b = 0; b < 2; ++b)
#pragma unroll
                for (int m = 0; m < 4; ++m)
#pragma unroll
                    for (int n = 0; n < 2; ++n) acc[a][b][m][n] = (f32x4){0.f, 0.f, 0.f, 0.f};
        cur = nxt; cA = nA; cB = nB; ++ui;
        if constexpr (ALIGN_EPI) { if (wr == 1) PG8_BAR; }
    }
    PG8_WAIT_V(0);
    if constexpr (!ALIGN_EPI) { if (wr == 0) PG8_BAR; }
    PG8_BAR;
    if constexpr (Epi::AFTER_DRAIN) { E.fused(acc, cur, wr, wc, fr, fq, lds, wid, lane); S.done(cur); }
#undef PG8_SA
#undef PG8_SB
#undef PG8_STAGE
#undef PG8_LD6
#undef PG8_CV6
#undef PG8_LDA
#undef PG8_LDB
#undef PG8_MMA
#undef PG8_ST1
#undef PG8_MMQ
#undef PG8_BLK1
#undef PG8_BLK2
#undef PG8_BLK2H
#undef PG8_WAIT_V
#undef PG8_WAIT_L
#undef PG8_BAR
#undef PG8_SCHED
}
}
#define LAS __attribute__((address_space(3)))
typedef unsigned short bf16;
typedef unsigned v4u __attribute__((ext_vector_type(4)));
typedef unsigned v2u __attribute__((ext_vector_type(2)));
typedef float f32x4 __attribute__((ext_vector_type(4)));
typedef float f32x2 __attribute__((ext_vector_type(2)));
typedef short bf16x8 __attribute__((ext_vector_type(8)));
using pg8::shx; using pg8::shl;
#define LDS_WAIT() asm volatile("s_waitcnt lgkmcnt(0)" ::: "memory")
__device__ __forceinline__ unsigned f2bf(float f) { unsigned u = __builtin_bit_cast(unsigned, f); return (u + 0x7fffu + ((u >> 16) & 1u)) >> 16; }
__device__ __forceinline__ unsigned pk2(float lo, float hi) { return pg8::cvt_pk_bf16(lo, hi); }
__device__ __forceinline__ float bf_lo(unsigned w) { return __uint_as_float(w << 16); }
__device__ __forceinline__ float bf_hi(unsigned w) { return __uint_as_float(w & 0xffff0000u); }
__device__ __forceinline__ float sigmoid_f(float v) { return __builtin_amdgcn_rcpf(1.0f + __builtin_amdgcn_exp2f(v * -1.4426950408889634f)); }
__device__ __forceinline__ float gelu_tanh(float x) { const float y = 0.7978845608028654f * (x + 0.044715f * x * x * x); const float th = 1.0f - 2.0f * __builtin_amdgcn_rcpf(1.0f + __builtin_amdgcn_exp2f(2.885390081777927f * y)); return 0.5f * x * (1.0f + th); }
#define XB_TMO      128
#define XB_XCNT(j)  (256  + 64 * (j))
#define XB_XSUB(j)  (1280 + 64 * (j))
#define XB_XGEN(j)  (2304 + 64 * (j))
#define XB_TOP      3328
#define XB_TOPGEN   3392
#define XCD_BAR_WORDS 3456
#define XB_SPIN_CAP (1u << 18)

__device__ __forceinline__ unsigned xb_ld(unsigned* p)              { return __hip_atomic_load(p, __ATOMIC_RELAXED, __HIP_MEMORY_SCOPE_AGENT); }
__device__ __forceinline__ unsigned xb_add(unsigned* p, unsigned v) { return __hip_atomic_fetch_add(p, v, __ATOMIC_RELAXED, __HIP_MEMORY_SCOPE_AGENT); }
__device__ __forceinline__ unsigned xb_xcc_id() { return (unsigned)__builtin_amdgcn_s_getreg((3 << 11) | 20) & 0xFu; }
#define XB_SPIN(cond, bar) do { unsigned _sp = 0; while (cond) { __builtin_amdgcn_s_sleep(1); \
    if ((++_sp & 255u) == 0u) { if (xb_ld(&(bar)[XB_TMO])) break; if (_sp > XB_SPIN_CAP) { atomicAdd(&(bar)[XB_TMO], 1u); break; } } } } while (0)

struct XcdBarrier {
    unsigned* bar; unsigned x;
    volatile LAS unsigned* st;
};

__device__ __forceinline__ XcdBarrier xcd_barrier_post(unsigned* bar, volatile LAS unsigned* st) {
    XcdBarrier b; b.bar = bar; b.x = xb_xcc_id(); b.st = st;
    if (threadIdx.x == 0) (void)xb_add(&bar[XB_XCNT(b.x)], 1u);
    return b;
}
__device__ __forceinline__ void xcd_barrier_complete(unsigned* bar, unsigned x, unsigned& nloc, unsigned& nx) {
    const unsigned G = gridDim.x * gridDim.y * gridDim.z;
    unsigned sum, cnt, mine, sp = 0u;
    for (;;) {
        sum = 0u; cnt = 0u; mine = 0u;
#pragma unroll
        for (unsigned j = 0; j < 16; ++j) { const unsigned c = xb_ld(&bar[XB_XCNT(j)]); sum += c; cnt += (c > 0u) ? 1u : 0u; mine = (j == x) ? c : mine; }
        if (sum == G) break;
        __builtin_amdgcn_s_sleep(1);
        if ((++sp & 255u) == 0u) { if (xb_ld(&bar[XB_TMO])) break; if (sp > XB_SPIN_CAP) { atomicAdd(&bar[XB_TMO], 1u); break; } }
    }
    nloc = mine > 0u ? mine : 1u; nx = cnt > 0u ? cnt : 1u;
}

__device__ __forceinline__ void xcd_barrier(const XcdBarrier& b) {
    asm volatile("s_waitcnt vmcnt(0)" ::: "memory");
    __syncthreads();
    if (threadIdx.x == 0) {
        unsigned* bar = b.bar;
        __builtin_amdgcn_s_waitcnt(0);
        unsigned nloc = b.st[0], nx = b.st[1];
        if (nloc == 0u) { xcd_barrier_complete(bar, b.x, nloc, nx); b.st[0] = nloc; b.st[1] = nx; }
        const unsigned old = xb_add(&bar[XB_XSUB(b.x)], 1u);
        const unsigned gen = old / nloc;
        if (old + 1u == (gen + 1u) * nloc) {
            __builtin_amdgcn_fence(__ATOMIC_RELEASE, "agent");
            asm volatile("s_waitcnt vmcnt(0)" ::: "memory");
            const unsigned og = xb_add(&bar[XB_TOP], 1u);
            const unsigned tg = og / nx;
            if (og + 1u == (tg + 1u) * nx) xb_add(&bar[XB_TOPGEN], 1u);
            else XB_SPIN(xb_ld(&bar[XB_TOPGEN]) == tg, bar);
            __builtin_amdgcn_fence(__ATOMIC_ACQUIRE, "agent");
            xb_add(&bar[XB_XGEN(b.x)], 1u);
            asm volatile("s_waitcnt vmcnt(0)" ::: "memory");
        } else {
            XB_SPIN(xb_ld(&bar[XB_XGEN(b.x)]) == gen, bar);
            __builtin_amdgcn_fence(__ATOMIC_ACQUIRE, "agent");
            asm volatile("s_waitcnt vmcnt(0)" ::: "memory");
        }
    }
    __syncthreads();
}

typedef short v4i16_t __attribute__((ext_vector_type(4)));
struct AttTile { int r, dsh, L, pq0, tq0, tq1; };
template <int NT> __device__ __forceinline__ void att_load_qk(const bf16* Z, const AttTile& t, int tok0, int s0, int h, int c, int g, bf16x8 (&Qn)[4], bf16x8 (&Kn)[10][2]) {
    { const unsigned zq = (unsigned)(tok0 + t.tq0) * (unsigned)(NIN * 2) + (unsigned)(ZQ + h * 64 + 8 * g) * 2u; Qn[0] = *(const bf16x8*)((const char*)Z + zq); Qn[1] = *(const bf16x8*)((const char*)Z + (zq + 64u)); }
    if (NT == 2) { const unsigned zq = (unsigned)(tok0 + t.tq1) * (unsigned)(NIN * 2) + (unsigned)(ZQ + h * 64 + 8 * g) * 2u; Qn[2] = *(const bf16x8*)((const char*)Z + zq); Qn[3] = *(const bf16x8*)((const char*)Z + (zq + 64u)); }
    if (t.pq0 >= 64 && t.pq0 + 96 <= t.L) {
        unsigned zk = (unsigned)(s0 + t.r + ((t.pq0 - 64 + c) << t.dsh)) * (unsigned)(NIN * 2) + (unsigned)(ZK + h * 64 + 8 * g) * 2u; const unsigned step = (16u << t.dsh) * (unsigned)(NIN * 2);
#pragma unroll
        for (int kt = 0; kt < 8 + NT; ++kt) { Kn[kt][0] = *(const bf16x8*)((const char*)Z + zk); Kn[kt][1] = *(const bf16x8*)((const char*)Z + (zk + 64u)); zk += step; }
    } else {
        const unsigned lb = (unsigned)(s0 + t.r + (c << t.dsh)) * (unsigned)(NIN * 2) + (unsigned)(ZK + h * 64 + 8 * g) * 2u;
#pragma unroll
        for (int kt = 0; kt < 8 + NT; ++kt) { int pb = t.pq0 - 64 + 16 * kt; pb = pb < 0 ? 0 : (pb > t.L - 16 ? t.L - 16 : pb); pb = __builtin_amdgcn_readfirstlane(pb);
            const unsigned zk = lb + (unsigned)(pb << t.dsh) * (unsigned)(NIN * 2); Kn[kt][0] = *(const bf16x8*)((const char*)Z + zk); Kn[kt][1] = *(const bf16x8*)((const char*)Z + (zk + 64u)); } }
}
template <int NT, int NTN> __device__ __forceinline__ void att_stage(const bf16* Z, const AttTile& t, const AttTile& tn, bool init, int tok0, int s0, int h, int lane_ph, LAS unsigned char* vb, LAS float* Os, LAS float* ms, LAS float* ls,
                                                                      bf16x8 (&Qn)[4], bf16x8 (&Kn)[10][2]) {
    int lane = lane_ph; asm volatile("" : "+v"(lane));
    const int c = lane & 15, g = lane >> 4;
    constexpr float SC = 0.125f * 1.4426950408889634f;
    f32x4 sc[NT][10];
#pragma unroll
    for (int kt = 0; kt < 9; ++kt) {
#pragma unroll
        for (int q = 0; q < NT; ++q) { f32x4 a = {0.f, 0.f, 0.f, 0.f};
            a = __builtin_amdgcn_mfma_f32_16x16x32_bf16(Kn[kt + q][0], Qn[2 * q], a, 0, 0, 0); a = __builtin_amdgcn_mfma_f32_16x16x32_bf16(Kn[kt + q][1], Qn[2 * q + 1], a, 0, 0, 0); sc[q][kt] = a; } }
#pragma unroll
    for (int q = 0; q < NT; ++q) sc[q][9] = (f32x4){-1e30f, -1e30f, -1e30f, -1e30f};
    __builtin_amdgcn_sched_barrier(0);
    v4u vv[5][4];
    if (t.pq0 >= 64 && t.pq0 + 96 <= t.L) {
        unsigned zv = (unsigned)(s0 + t.r + ((t.pq0 - 64 + (lane >> 3)) << t.dsh)) * (unsigned)(NIN * 2) + (unsigned)(ZV + h * 64 + 8 * (lane & 7)) * 2u; const unsigned step = (8u << t.dsh) * (unsigned)(NIN * 2);
#pragma unroll
        for (int s = 0; s < 5; ++s)
#pragma unroll
            for (int i = 0; i < 4; ++i) { vv[s][i] = *(const v4u*)((const char*)Z + zv); zv += step; }
    } else { const unsigned lb = (unsigned)(s0 + t.r + ((lane >> 3) << t.dsh)) * (unsigned)(NIN * 2) + (unsigned)(ZV + h * 64 + 8 * (lane & 7)) * 2u;
#pragma unroll
        for (int s = 0; s < 5; ++s)
#pragma unroll
            for (int i = 0; i < 4; ++i) { int pb = t.pq0 - 64 + 32 * s + 8 * i; pb = pb < 0 ? 0 : (pb > t.L - 8 ? t.L - 8 : pb); pb = __builtin_amdgcn_readfirstlane(pb);
                vv[s][i] = *(const v4u*)((const char*)Z + (lb + (unsigned)(pb << t.dsh) * (unsigned)(NIN * 2))); } }
    float mx[NT], lsum[NT];
#pragma unroll
    for (int q = 0; q < NT; ++q) { const int pq = t.pq0 + 16 * q; float m = -1e30f;
        if (pq >= 64 && pq + 80 <= t.L) {
#pragma unroll
            for (int kt = 0; kt < 9; ++kt)
#pragma unroll
                for (int rr = 0; rr < 4; ++rr) { const int kk = 16 * kt + 4 * g + rr;
                    if (kt == 0) sc[q][kt][rr] = kk >= c ? sc[q][kt][rr] : -1e30f;
                    if (kt == 8) sc[q][kt][rr] = kk <= c + 128 ? sc[q][kt][rr] : -1e30f;
                    m = fmaxf(m, sc[q][kt][rr]); }
        } else {
#pragma unroll
            for (int kt = 0; kt < 9; ++kt) { const int pb = pq - 64 + 16 * kt; const bool tin = __builtin_amdgcn_readfirstlane((int)(pb >= 0 && pb < t.L)) != 0;
#pragma unroll
                for (int rr = 0; rr < 4; ++rr) { const int kk = 16 * kt + 4 * g + rr;
                    if (kt == 0) sc[q][kt][rr] = kk >= c ? sc[q][kt][rr] : -1e30f;
                    if (kt == 8) sc[q][kt][rr] = kk <= c + 128 ? sc[q][kt][rr] : -1e30f;
                    sc[q][kt][rr] = tin ? sc[q][kt][rr] : -1e30f;
                    m = fmaxf(m, sc[q][kt][rr]); } } }
        m = fmaxf(m, shx(m, 16, lane)); m = fmaxf(m, shx(m, 32, lane)); mx[q] = m;
        const float nm = -m * SC; f32x4 l4 = {0.f, 0.f, 0.f, 0.f};
#pragma unroll
        for (int kt = 0; kt < 9; ++kt) { const f32x4 z = sc[q][kt] * SC + nm; f32x4 p4;
#pragma unroll
            for (int rr = 0; rr < 4; ++rr) p4[rr] = __builtin_amdgcn_exp2f(z[rr]);
            sc[q][kt] = p4; l4 = l4 + p4; }
        sc[q][9] = (f32x4){0.f, 0.f, 0.f, 0.f};
        float l = (l4[0] + l4[1]) + (l4[2] + l4[3]);
        l += shx(l, 16, lane); l += shx(l, 32, lane); lsum[q] = l; }
    f32x4 o[NT][4];
#pragma unroll
    for (int q = 0; q < NT; ++q)
#pragma unroll
        for (int dt = 0; dt < 4; ++dt) o[q][dt] = (f32x4){0.f, 0.f, 0.f, 0.f};
#pragma unroll
    for (int s = 0; s < 5; ++s) {
        asm volatile("s_waitcnt lgkmcnt(0)" ::: "memory");
#pragma unroll
        for (int i = 0; i < 4; ++i) *(LAS v4u*)(vb + ((lane >> 3) + 8 * i) * 144 + 16 * (lane & 7)) = vv[s][i];
        asm volatile("s_waitcnt lgkmcnt(0)" ::: "memory");
        if (s == 4 && NTN > 0) att_load_qk<NTN ? NTN : 1>(Z, tn, tok0, s0, h, c, g, Qn, Kn);
        bf16x8 af[4];
#pragma unroll
        for (int dt = 0; dt < 4; ++dt) {
            LAS unsigned char* p0 = vb + (4 * g + (c >> 2)) * 144 + (16 * dt + 4 * (c & 3)) * 2;
            const v4i16_t lo = __builtin_amdgcn_ds_read_tr16_b64_v4i16((LAS v4i16_t*)p0), hi = __builtin_amdgcn_ds_read_tr16_b64_v4i16((LAS v4i16_t*)(p0 + 16 * 144));
            af[dt][0] = lo[0]; af[dt][1] = lo[1]; af[dt][2] = lo[2]; af[dt][3] = lo[3]; af[dt][4] = hi[0]; af[dt][5] = hi[1]; af[dt][6] = hi[2]; af[dt][7] = hi[3]; }
#pragma unroll
        for (int q = 0; q < NT; ++q) {
            union { unsigned u[4]; bf16x8 v; } pf;
            if (q == 1 && s == 0) { pf.u[0] = 0u; pf.u[1] = 0u; } else { pf.u[0] = pg8::cvt_pk_bf16(sc[q][2 * s - q][0], sc[q][2 * s - q][1]); pf.u[1] = pg8::cvt_pk_bf16(sc[q][2 * s - q][2], sc[q][2 * s - q][3]); }
            pf.u[2] = pg8::cvt_pk_bf16(sc[q][2 * s + 1 - q][0], sc[q][2 * s + 1 - q][1]); pf.u[3] = pg8::cvt_pk_bf16(sc[q][2 * s + 1 - q][2], sc[q][2 * s + 1 - q][3]);
#pragma unroll
            for (int dt = 0; dt < 4; ++dt) o[q][dt] = __builtin_amdgcn_mfma_f32_16x16x32_bf16(af[dt], pf.v, o[q][dt], 0, 0, 0); }
    }
#pragma unroll
    for (int q = 0; q < NT; ++q) { const int tq = q ? t.tq1 : t.tq0; LAS float* orow = Os + tq * 68 + 4 * g;
        if (init) {
#pragma unroll
            for (int dt = 0; dt < 4; ++dt) *(LAS f32x4*)(orow + 16 * dt) = o[q][dt];
            if (g == 0) { ms[tq] = mx[q]; ls[tq] = lsum[q]; }
        } else {
            const float m_s = ms[tq], l_s = ls[tq]; const float mn = fmaxf(m_s, mx[q]); const float a = __builtin_amdgcn_exp2f((m_s - mn) * SC), b = __builtin_amdgcn_exp2f((mx[q] - mn) * SC);
#pragma unroll
            for (int dt = 0; dt < 4; ++dt) { const f32x4 os = *(const LAS f32x4*)(orow + 16 * dt); *(LAS f32x4*)(orow + 16 * dt) = os * a + o[q][dt] * b; }
            asm volatile("s_waitcnt lgkmcnt(0)" ::: "memory");
            if (g == 0) { ms[tq] = mn; ls[tq] = l_s * a + lsum[q] * b; }
        } }
}
__device__ __forceinline__ void attn_mfma_phase(LAS unsigned char* lds, bf16* Z, float* ssq, int blk, int G, int tid, int wave, int lane_ph, bf16* dummy = nullptr) {
    LAS float* Os = (LAS float*)lds;
    LAS float* ms = (LAS float*)(lds + 69632);
    LAS float* ls = (LAS float*)(lds + 70656);
    LAS unsigned char* vb = lds + 71680 + wave * 4608;
    const int c = lane_ph & 15, g = lane_ph >> 4;
    for (int unit = blk; unit < (T / 256) * 12; unit += G) {
        const int tb = unit / 12, h = unit % 12;
        const int tok0 = 256 * tb; const int s0 = tok0 < TPR ? (tok0 & ~4095) : TPR; const int S = tok0 < TPR ? 4096 : 16384; const int B0 = tok0 - s0;
        __syncthreads();
        const AttTile t0{0, 0, S, B0 + 32 * wave, 32 * wave + c, 32 * wave + 16 + c};
        const AttTile t1{wave & 3, 2, S >> 2, (B0 >> 2) + 32 * (wave >> 2), (wave & 3) + 128 * (wave >> 2) + 4 * c, (wave & 3) + 128 * (wave >> 2) + 64 + 4 * c};
        const AttTile t2{2 * wave, 4, S >> 4, B0 >> 4, 2 * wave + 16 * c, 0};
        const AttTile t3{2 * wave + 1, 4, S >> 4, B0 >> 4, 2 * wave + 1 + 16 * c, 0};
        bf16x8 Qn[4], Kn[10][2];
        att_load_qk<2>(Z, t0, tok0, s0, h, c, g, Qn, Kn);
        att_stage<2, 2>(Z, t0, t1, true, tok0, s0, h, lane_ph, vb, Os, ms, ls, Qn, Kn);
        __syncthreads();
        att_stage<2, 1>(Z, t1, t2, false, tok0, s0, h, lane_ph, vb, Os, ms, ls, Qn, Kn);
        __syncthreads();
        att_stage<1, 1>(Z, t2, t3, false, tok0, s0, h, lane_ph, vb, Os, ms, ls, Qn, Kn);
        att_stage<1, 0>(Z, t3, t3, false, tok0, s0, h, lane_ph, vb, Os, ms, ls, Qn, Kn);
        __syncthreads();
#pragma unroll
        for (int i = 0; i < 4; ++i) { const int item = tid + 512 * i, tk = item >> 3, ch = item & 7;
            const float inv = __builtin_amdgcn_rcpf(ls[tk]); const f32x4 a = *(const LAS f32x4*)(Os + tk * 68 + 8 * ch), b = *(const LAS f32x4*)(Os + tk * 68 + 8 * ch + 4);
            float v[8] = {a[0] * inv, a[1] * inv, a[2] * inv, a[3] * inv, b[0] * inv, b[1] * inv, b[2] * inv, b[3] * inv};
            float sq = 0.f;
#pragma unroll
            for (int e = 0; e < 8; ++e) sq += v[e] * v[e];
            sq += shx(sq, 1, lane_ph); sq += shx(sq, 2, lane_ph); sq += shx(sq, 4, lane_ph);
            v4u ov; ov.x = pk2(v[0], v[1]); ov.y = pk2(v[2], v[3]); ov.z = pk2(v[4], v[5]); ov.w = pk2(v[6], v[7]);
            if (dummy) *(v4u*)(dummy + (size_t)((tok0 + tk) & 1023) * 768 + h * 64 + 8 * ch) = ov;
            else { *(v4u*)(Z + (size_t)(tok0 + tk) * NIN + ZQ + h * 64 + 8 * ch) = ov;
            if (ch == 0) unsafeAtomicAdd(ssq + tok0 + tk, pg8::qgrid<9>(sq)); } }
    }
    __syncthreads();
}

__device__ __forceinline__ void conv_item(const float* W, int k_lo, int k_n, int Ktot, int ldw, int n0, bf16* WT, int drow0, const float* g, const float* g2, int ksplit, const float* b, float* cs, float* cb, LAS float* scr, int lane, const int f8, const float wsc = 1.0f) {
    float csa[4] = {0.f, 0.f, 0.f, 0.f}, cba[4] = {0.f, 0.f, 0.f, 0.f};
    const int c = lane & 7;
    float pre[32];
    { const float* wp = W + (size_t)(k_lo + (lane >> 5)) * ldw + n0 + (lane & 31);
#pragma unroll
      for (int i = 0; i < 32; ++i) pre[i] = wp[(size_t)(2 * i) * ldw]; }
    for (int k0 = k_lo; k0 < k_lo + k_n; k0 += 64) {
#pragma unroll
        for (int i = 0; i < 32; ++i) scr[(2 * i + (lane >> 5)) * 33 + (lane & 31)] = pre[i];
        LDS_WAIT(); asm volatile("" ::: "memory");
        if (k0 + 64 < k_lo + k_n) { const float* wp = W + (size_t)(k0 + 64 + (lane >> 5)) * ldw + n0 + (lane & 31);
#pragma unroll
            for (int i = 0; i < 32; ++i) pre[i] = wp[(size_t)(2 * i) * ldw]; }
        if (f8 == 3) {
            const int n = lane & 31, kq = k0 + 32 * (lane >> 5); const LAS float* sp = scr + (32 * (lane >> 5)) * 33 + n;
            pg8::f32x16 lo, hi; float sa = 0.f, sb = 0.f;
#pragma unroll
            for (int e4 = 0; e4 < 8; ++e4) { f32x4 g4 = {1.f, 1.f, 1.f, 1.f}, b4 = {0.f, 0.f, 0.f, 0.f};
                if (g) g4 = *(const f32x4*)((kq < ksplit ? g : g2 - ksplit) + kq + 4 * e4);
                if (b) b4 = *(const f32x4*)(b + kq + 4 * e4);
#pragma unroll
                for (int j = 0; j < 4; ++j) { const int e = 4 * e4 + j; const float w = sp[e * 33], wg = w * g4[j]; sa += wg; sb += b4[j] * w; if (e < 16) lo[e] = wg * wsc; else hi[e - 16] = wg * wsc; } }
            pg8::st_frag6((unsigned char*)WT + (size_t)(drow0 + n) * (size_t)(Ktot / 4 * 3) + 96 * (kq >> 7), (kq >> 5) & 3, ((drow0 + n) & 16) ? 2 : 0, lo, hi);
            csa[0] += sa; cba[0] += sb;
            LDS_WAIT(); asm volatile("" ::: "memory"); continue; }
        float gk[8], bk[8];
#pragma unroll
        for (int e = 0; e < 8; ++e) { const int k = k0 + 8 * c + e; gk[e] = g ? (k < ksplit ? g[k] : g2[k - ksplit]) : 1.f; bk[e] = b ? b[k] : 0.f; }
#pragma unroll
        for (int j = 0; j < 4; ++j) { const int n = (lane >> 3) + 8 * j; const LAS float* sp = scr + (8 * c) * 33 + n;
            float w[8], wg[8];
#pragma unroll
            for (int e = 0; e < 8; ++e) { w[e] = sp[e * 33]; wg[e] = w[e] * gk[e]; }
            if (f8 == 1) { v2u o; o.x = pg8::pk4_fp8(wg[0] * pg8::F8_WSC, wg[1] * pg8::F8_WSC, wg[2] * pg8::F8_WSC, wg[3] * pg8::F8_WSC); o.y = pg8::pk4_fp8(wg[4] * pg8::F8_WSC, wg[5] * pg8::F8_WSC, wg[6] * pg8::F8_WSC, wg[7] * pg8::F8_WSC);
                *(v2u*)((unsigned char*)WT + (size_t)(drow0 + n) * Ktot + k0 + 8 * c) = o;
                csa[j] += (((__builtin_amdgcn_cvt_f32_fp8((int)o.x, 0) + __builtin_amdgcn_cvt_f32_fp8((int)o.x, 1)) + (__builtin_amdgcn_cvt_f32_fp8((int)o.x, 2) + __builtin_amdgcn_cvt_f32_fp8((int)o.x, 3)))
                         + ((__builtin_amdgcn_cvt_f32_fp8((int)o.y, 0) + __builtin_amdgcn_cvt_f32_fp8((int)o.y, 1)) + (__builtin_amdgcn_cvt_f32_fp8((int)o.y, 2) + __builtin_amdgcn_cvt_f32_fp8((int)o.y, 3)))) * (1.0f / pg8::F8_WSC); }
            else if (f8 == 2) { v4u o; o.x = pg8::pk_f16(wg[0], wg[1]); o.y = pg8::pk_f16(wg[2], wg[3]); o.z = pg8::pk_f16(wg[4], wg[5]); o.w = pg8::pk_f16(wg[6], wg[7]);
                *(v4u*)(WT + (size_t)(drow0 + n) * Ktot + k0 + 8 * c) = o;
                csa[j] += ((pg8::f16_lo(o.x) + pg8::f16_hi(o.x)) + (pg8::f16_lo(o.y) + pg8::f16_hi(o.y))) + ((pg8::f16_lo(o.z) + pg8::f16_hi(o.z)) + (pg8::f16_lo(o.w) + pg8::f16_hi(o.w))); }
            else {
            v4u o; o.x = pk2(wg[0], wg[1]); o.y = pk2(wg[2], wg[3]); o.z = pk2(wg[4], wg[5]); o.w = pk2(wg[6], wg[7]);
            *(v4u*)(WT + (size_t)(drow0 + n) * Ktot + k0 + 8 * c) = o;
            csa[j] += ((bf_lo(o.x) + bf_hi(o.x)) + (bf_lo(o.y) + bf_hi(o.y))) + ((bf_lo(o.z) + bf_hi(o.z)) + (bf_lo(o.w) + bf_hi(o.w))); }
#pragma unroll
            for (int e = 0; e < 8; ++e) cba[j] += bk[e] * w[e]; }
        LDS_WAIT(); asm volatile("" ::: "memory");
    }
    if (cs && f8 == 3) { float a = csa[0], bb = cba[0]; a += shx(a, 32, lane); bb += shx(bb, 32, lane);
        if (lane < 32) { unsafeAtomicAdd(cs + drow0 + lane, a); unsafeAtomicAdd(cb + drow0 + lane, bb); } }
    else if (cs) {
#pragma unroll
        for (int j = 0; j < 4; ++j) { float a = csa[j], bb = cba[j];
            a += shx(a, 1, lane); a += shx(a, 2, lane); a += shx(a, 4, lane); bb += shx(bb, 1, lane); bb += shx(bb, 2, lane); bb += shx(bb, 4, lane);
            if (c == 0) { unsafeAtomicAdd(cs + drow0 + (lane >> 3) + 8 * j, a); unsafeAtomicAdd(cb + drow0 + (lane >> 3) + 8 * j, bb); } }
    }
}
#ifndef PHMASK
#define PHMASK 0xFFFF
#endif
#define PHON(k) ((PHMASK >> (k)) & 1)
__device__ __forceinline__ void convert_layer(CArgs P, int l, LAS unsigned char* lds, int gw, int NGW, int wave, int lane, float* csb_junk = nullptr) {
    LAS float* scr = (LAS float*)(lds + RING_OFF + wave * 16384);
    unsigned char* ws = P->ws;
    float* csb = csb_junk ? csb_junk : (float*)(ws + WS_CSB) + (size_t)l * 6 * 16384;
    constexpr int I_D = 64 * 6, I_GU = 352 * 2, I_IN = 152 * 2, I_OUT = 64 * 2, I_LRU = 160;
    constexpr int NITEMS = 2 * I_D + 2 * I_GU + I_IN + I_OUT + I_LRU;
    for (int it = gw; it < NITEMS; it += NGW) {
        int r = it;
        if (r < 2 * I_D) { const int second = r >= I_D, rr = second ? r - I_D : r, cg = rr / 6, kc = rr % 6;
            conv_item(P->in[second ? 24 : 6] + (size_t)l * FF * D, 1024 * kc, kc < 5 ? 1024 : 512, FF, D, 32 * cg, (bf16*)(ws + (second ? WS_WD2 : WS_WD1)), 32 * cg, nullptr, nullptr, 0, nullptr, nullptr, nullptr, scr, lane, FFN6_D ? 3 : 1, pg8::F6_WD); continue; } r -= 2 * I_D;
        if (r < I_GU) { const int kc = r & 1, r2 = r >> 1, up = r2 >= 176, rr = up ? r2 - 176 : r2, n0 = 32 * rr, dr = 256 * (n0 >> 7) + (n0 & 127) + 128 * up;
            const float* gg = l ? P->in[20] + (size_t)(l - 1) * D : nullptr; const float* bb = l ? P->in[21] + (size_t)(l - 1) * D : nullptr;
            conv_item(P->in[up ? 5 : 4] + (size_t)l * D * FF, 1024 * kc, 1024, D, FF, n0, (bf16*)(ws + WS_WGU1), dr, gg, gg, D, bb, csb, csb + 16384, scr, lane, FFN6_GU ? 3 : 1, pg8::F6_WGU); continue; } r -= I_GU;
        if (r < I_GU) { const int kc = r & 1, r2 = r >> 1, up = r2 >= 176, rr = up ? r2 - 176 : r2, n0 = 32 * rr, dr = 256 * (n0 >> 7) + (n0 & 127) + 128 * up;
            conv_item(P->in[up ? 23 : 22] + (size_t)l * D * FF, 1024 * kc, 1024, D, FF, n0, (bf16*)(ws + WS_WGU2), dr, P->in[7] + (size_t)l * D, P->in[7] + (size_t)l * D, D, P->in[8] + (size_t)l * D, csb + 4 * 16384, csb + 5 * 16384, scr, lane, FFN6_GU ? 3 : 1, pg8::F6_WGU); continue; } r -= I_GU;
        if (r < I_IN) { const int kc = r & 1, n0 = 32 * (r >> 1); int dr;
            if (n0 < 768) dr = n0; else if (n0 < 1536) dr = ZK + (n0 - 768); else if (n0 < 2304) dr = ZV + (n0 - 1536); else if (n0 < 3584) dr = ZXL + (n0 - 2304); else dr = ZGL + (n0 - 3584);
            conv_item(P->in[9] + (size_t)l * D * NIN, 1024 * kc, 1024, D, NIN, n0, (bf16*)(ws + WS_WIN), dr, P->in[2] + (size_t)l * D, P->in[2] + (size_t)l * D, D, P->in[3] + (size_t)l * D, csb + 2 * 16384, csb + 3 * 16384, scr, lane, 2); continue; } r -= I_IN;
        if (r < I_OUT) { const int kc = r & 1; conv_item(P->in[19] + (size_t)l * D * D, 1024 * kc, 1024, D, D, 32 * (r >> 1), (bf16*)(ws + WS_WOUT), 32 * (r >> 1), P->in[17] + (size_t)l * AW, P->in[18] + (size_t)l * LW, AW, nullptr, nullptr, nullptr, scr, lane, 0); continue; } r -= I_OUT;
        { const int mat = r >> 2, n0 = 32 * (r & 3), gate = mat / 20, rem = mat % 20;
          conv_item(P->in[gate ? 14 : 12] + ((size_t)l * 20 + rem) * 16384, 0, 128, 128, 128, n0, (bf16*)(ws + WS_LRUW) + (size_t)mat * 16384, n0, nullptr, nullptr, 0, nullptr, nullptr, nullptr, scr, lane, 0); }
    }
}
__device__ __forceinline__ void sincos_d(double r, double& s, double& c) {
    const double r2 = r * r; double ts = r, tc = 1.0; s = r; c = 1.0;
#pragma unroll
    for (int k = 1; k <= 14; ++k) { tc = -tc * r2 / (double)((2 * k - 1) * (2 * k)); ts = -ts * r2 / (double)((2 * k) * (2 * k + 1)); c += tc; s += ts; }
}
__device__ __forceinline__ void prologue(CArgs P, LAS unsigned char* lds, int gtid, int NGT, int gw, int NGW, int wave, int lane, const bool do_conv = true) {
    unsigned char* ws = P->ws;
    { f32x2* st0 = (f32x2*)(ws + WS_ST0); for (int i = gtid; i < T; i += NGT) st0[i] = (f32x2){0.f, 2048.0f * (1.0f - 1e-5f)}; }
    { float* v = (float*)(ws + WS_VEC); for (int i = gtid; i < 4096; i += NGT) v[i] = i < 2048 ? 1.f : 0.f; }
    { f32x2* rp = (f32x2*)(ws + WS_ROPE);
      for (int i = gtid; i < 16384 * 8; i += NGT) { const int pos = i >> 3, fi = i & 7;
          const double invf = fi == 0 ? 1.0 : fi == 1 ? 0.19392274474868576 : fi == 2 ? 0.03760603093086393 : fi == 3 ? 0.007292664737217109 : fi == 4 ? 0.001414213562373095 : fi == 5 ? 0.0002742481756762073 : fi == 6 ? 5.318295896944988e-05 : 1.031338537721246e-05;
          const double ang = (double)pos * invf; const double kq = __builtin_rint(ang * 0.15915494309189535); const double rr = ang - kq * 6.283185307179586;
          double s, c; sincos_d(rr, s, c); rp[i] = (f32x2){(float)c, (float)s}; } }
    { unsigned char* tb = (unsigned char*)(ws + WS_TB8);
#if FFN6_GU
      for (size_t i = (size_t)gtid; i < (size_t)T * D / 32; i += NGT) { const size_t e = i * 32; const float* src = e < (size_t)TPR * D ? P->in[0] + e : P->in[1] + (e - (size_t)TPR * D);
          pg8::f32x16 lo, hi;
#pragma unroll
          for (int j = 0; j < 4; ++j) { const f32x4 a = *(const f32x4*)(src + 4 * j), b2 = *(const f32x4*)(src + 16 + 4 * j);
#pragma unroll
              for (int q = 0; q < 4; ++q) { lo[4 * j + q] = a[q]; hi[4 * j + q] = b2[q]; } }
          const int row = (int)(e >> 11), cc = (int)(e & 2047);
          pg8::st_frag6(tb + (size_t)row * 1536 + 96 * (cc >> 7), (cc >> 5) & 3, (row & 8) ? 2 : 0, lo, hi); } }
#else
      size_t i = (size_t)gtid;
      for (; i + 3 * (size_t)NGT < (size_t)T * D / 8; i += 4 * (size_t)NGT) { f32x4 a[4], b2[4];
#pragma unroll
          for (int q = 0; q < 4; ++q) { const size_t e = (i + (size_t)q * NGT) * 8; const float* src = e < (size_t)TPR * D ? P->in[0] + e : P->in[1] + (e - (size_t)TPR * D); a[q] = *(const f32x4*)src; b2[q] = *(const f32x4*)(src + 4); }
#pragma unroll
          for (int q = 0; q < 4; ++q) { const size_t e = (i + (size_t)q * NGT) * 8; v2u o; o.x = pg8::pk4_fp8(a[q][0], a[q][1], a[q][2], a[q][3]); o.y = pg8::pk4_fp8(b2[q][0], b2[q][1], b2[q][2], b2[q][3]); *(v2u*)(tb + e) = o; } }
      for (; i < (size_t)T * D / 8; i += NGT) { const size_t e = i * 8; const float* src = e < (size_t)TPR * D ? P->in[0] + e : P->in[1] + (e - (size_t)TPR * D);
          const f32x4 a = *(const f32x4*)src, b2 = *(const f32x4*)(src + 4); v2u o; o.x = pg8::pk4_fp8(a[0], a[1], a[2], a[3]); o.y = pg8::pk4_fp8(b2[0], b2[1], b2[2], b2[3]); *(v2u*)(tb + e) = o; } }
#endif
    if (do_conv) convert_layer(P, 0, lds, gw, NGW, wave, lane);
}

__device__ __forceinline__ void attn_valu_phase(LAS unsigned char* lds, bf16* Z, float* ssq, int blk, int G, int wave, int lane) {
    LAS float* sbuf = (LAS float*)lds + wave * 400;
    const int ks = lane >> 3, dp = lane & 7;
    for (int unit = blk; unit < (T / 64) * 12; unit += G) {
        const int tb = unit / 12, h = unit % 12;
        for (int qi = 0; qi < 8; ++qi) {
            const int tok = 64 * tb + 8 * wave + qi;
            const int s0 = tok < TPR ? (tok & ~4095) : TPR, S = tok < TPR ? 4096 : 16384, pos = tok - s0;
            float q8[8];
            { const v4u w = *(const v4u*)(Z + (size_t)tok * NIN + ZQ + h * 64 + 8 * dp);
              q8[0] = bf_lo(w.x) * 0.125f; q8[1] = bf_hi(w.x) * 0.125f; q8[2] = bf_lo(w.y) * 0.125f; q8[3] = bf_hi(w.y) * 0.125f; q8[4] = bf_lo(w.z) * 0.125f; q8[5] = bf_hi(w.z) * 0.125f; q8[6] = bf_lo(w.w) * 0.125f; q8[7] = bf_hi(w.w) * 0.125f; }
            for (int t = 0; t < 49; ++t) {
                const int kk = 8 * t + ks; const int gq = kk >= 258 ? 2 : (kk >= 129 ? 1 : 0); const int j = kk - 129 * gq - 64; const int kp = pos + j * (1 << (2 * gq));
                const bool valid = kk < 387 && kp >= 0 && kp < S; const int row = s0 + (valid ? kp : pos);
                const v4u w = *(const v4u*)(Z + (size_t)row * NIN + ZK + h * 64 + 8 * dp);
                float d = q8[0] * bf_lo(w.x) + q8[1] * bf_hi(w.x) + q8[2] * bf_lo(w.y) + q8[3] * bf_hi(w.y) + q8[4] * bf_lo(w.z) + q8[5] * bf_hi(w.z) + q8[6] * bf_lo(w.w) + q8[7] * bf_hi(w.w);
                d += shx(d, 1, lane); d += shx(d, 2, lane); d += shx(d, 4, lane);
                if (dp == 0) sbuf[kk] = valid ? d : -1e30f;
            }
            LDS_WAIT(); asm volatile("" ::: "memory");
            float sv[7]; float mx = -1e30f;
#pragma unroll
            for (int p = 0; p < 7; ++p) { const int idx = lane + 64 * p; sv[p] = idx < 392 ? sbuf[idx] : -1e30f; mx = fmaxf(mx, sv[p]); }
#pragma unroll
            for (int o = 1; o < 64; o <<= 1) mx = fmaxf(mx, shx(mx, o, lane));
            float sum = 0.f;
#pragma unroll
            for (int p = 0; p < 7; ++p) { const int idx = lane + 64 * p; const float e = sv[p] > -1e29f ? __expf(sv[p] - mx) : 0.f; sum += e; if (idx < 392) sbuf[idx] = e; }
#pragma unroll
            for (int o = 1; o < 64; o <<= 1) sum += shx(sum, o, lane);
            LDS_WAIT(); asm volatile("" ::: "memory");
            float a8[8] = {0.f, 0.f, 0.f, 0.f, 0.f, 0.f, 0.f, 0.f};
            for (int t = 0; t < 49; ++t) {
                const int kk = 8 * t + ks; const int gq = kk >= 258 ? 2 : (kk >= 129 ? 1 : 0); const int j = kk - 129 * gq - 64; const int kp = pos + j * (1 << (2 * gq));
                const bool valid = kk < 387 && kp >= 0 && kp < S; const int row = s0 + (valid ? kp : pos);
                const float p = sbuf[kk];
                const v4u w = *(const v4u*)(Z + (size_t)row * NIN + ZV + h * 64 + 8 * dp);
                a8[0] += p * bf_lo(w.x); a8[1] += p * bf_hi(w.x); a8[2] += p * bf_lo(w.y); a8[3] += p * bf_hi(w.y); a8[4] += p * bf_lo(w.z); a8[5] += p * bf_hi(w.z); a8[6] += p * bf_lo(w.w); a8[7] += p * bf_hi(w.w);
            }
            const float inv = 1.0f / sum; float sq = 0.f;
#pragma unroll
            for (int e = 0; e < 8; ++e) { float v = a8[e]; v += shx(v, 8, lane); v += shx(v, 16, lane); v += shx(v, 32, lane); a8[e] = v * inv; sq += a8[e] * a8[e]; }
            sq += shx(sq, 1, lane); sq += shx(sq, 2, lane); sq += shx(sq, 4, lane);
            if (ks == 0) { v4u o; o.x = pk2(a8[0], a8[1]); o.y = pk2(a8[2], a8[3]); o.z = pk2(a8[4], a8[5]); o.w = pk2(a8[6], a8[7]); *(v4u*)(Z + (size_t)tok * NIN + ZQ + h * 64 + 8 * dp) = o; }
            if (lane == 0) unsafeAtomicAdd(ssq + tok, sq);
            LDS_WAIT(); asm volatile("" ::: "memory");
        }
    }
}

__device__ __forceinline__ float neg_expm1_small(float x) {
    const float ser = -x * (1.0f + x * (0.5f + x * (0.16666667f + x * (0.041666668f + x * (0.0083333338f + x * 0.0013888889f)))));
    return x < -0.25f ? 1.0f - __expf(x) : ser; }
template <int MODE>
__device__ __forceinline__ void lru_phase(LAS unsigned char* lds, int blk, int G, int tid, int lane, int wave, bf16* Z, const bf16* LWT, const float* convw, const float* convb, const float* ba, const float* bx, const float* lam, float* tot, float* ssq) {
    LAS bf16* xcb = (LAS bf16*)lds;
    LAS float* hb = (LAS float*)(lds + 34816);
    const int c = lane & 15, g = lane >> 4, dl = 16 * wave + c;
    constexpr int UPB = NCHUNK * 10 / 256;
    const int u_lo = (G == 256) ? blk * UPB : blk, u_step = (G == 256) ? 1 : G, u_n = (G == 256) ? UPB : (NCHUNK * 10 - blk + G - 1) / G;
    int nb_cur = -1; float sp8[2] = {0.f, 0.f}, bav[2] = {0.f, 0.f}, bxv[2] = {0.f, 0.f}; bf16x8 Bfa[2][4], Bfx[2][4];
#pragma unroll
    for (int d = 0; d < 2; ++d)
#pragma unroll
        for (int ks = 0; ks < 4; ++ks) { Bfa[d][ks] = (bf16x8){0, 0, 0, 0, 0, 0, 0, 0}; Bfx[d][ks] = Bfa[d][ks]; }
    unsigned xw[19];
#define LRU_LOAD_XW(unit_) do { const int nb_ = (unit_) / NCHUNK, pu_ = (unit_) % NCHUNK, ck_ = (pu_ % 3 == 2) ? 256 + pu_ / 3 : 2 * (pu_ / 3) + pu_ % 3, tok0_ = LCH * ck_; const int s0_ = tok0_ < TPR ? (tok0_ & ~4095) : TPR, send_ = tok0_ < TPR ? s0_ + 4096 : T; \
        const int ch_ = 128 * nb_ + 2 * (tid & 63), tg_ = tid >> 6; \
        _Pragma("unroll") for (int i = 0; i < 19; ++i) { const int row_ = tok0_ + 16 * tg_ + i - 2; unsigned w_ = 0u; if (row_ >= s0_ && row_ < send_) w_ = *(const unsigned*)(Z + (size_t)row_ * NIN + ZXL + ch_); xw[i] = w_; } } while (0)
    if (u_n > 0) LRU_LOAD_XW(u_lo);
    for (int ui = 0; ui < u_n; ++ui) {
        const int unit = u_lo + ui * u_step; const int nb = unit / NCHUNK, pu = unit % NCHUNK; const int ck = (pu % 3 == 2) ? 256 + pu / 3 : 2 * (pu / 3) + pu % 3;
        const int tok0 = LCH * ck; const int s0 = tok0 < TPR ? (tok0 & ~4095) : TPR; const int send = tok0 < TPR ? s0 + 4096 : T;
        __syncthreads();
        { const int cp = tid & 63, ch = 128 * nb + 2 * cp, tg = tid >> 6;
          float w0[4], w1[4];
#pragma unroll
          for (int j = 0; j < 4; ++j) { w0[j] = convw[j * LW + ch]; w1[j] = convw[j * LW + ch + 1]; }
          const float b0 = convb[ch], b1 = convb[ch + 1];
          float x0[19], x1[19];
#pragma unroll
          for (int i = 0; i < 19; ++i) { x0[i] = bf_lo(xw[i]); x1[i] = bf_hi(xw[i]); }
#pragma unroll
          for (int i = 0; i < 16; ++i) { const float a0 = ((x0[i] * w0[0] + x0[i + 1] * w0[1]) + (x0[i + 2] * w0[2] + x0[i + 3] * w0[3])) + b0, a1 = ((x1[i] * w1[0] + x1[i + 1] * w1[1]) + (x1[i + 2] * w1[2] + x1[i + 3] * w1[3])) + b1;
              *(LAS unsigned*)(xcb + (16 * tg + i) * 136 + 2 * cp) = pk2(a0, a1); } }
        if (nb != nb_cur) { nb_cur = nb; const int ch = 128 * nb + dl;
#pragma unroll
            for (int d = 0; d < 2; ++d) { sp8[d] = 8.0f * 1.4426950408889634f * log1pf(expf(-lam[d * LW + ch])); bav[d] = ba[d * LW + ch]; bxv[d] = bx[d * LW + ch];
                const bf16* wa = LWT + ((size_t)((0 * 2 + d) * 10 + nb) * 128 + dl) * 128; const bf16* wx = LWT + ((size_t)((1 * 2 + d) * 10 + nb) * 128 + dl) * 128;
#pragma unroll
                for (int ks = 0; ks < 4; ++ks) { Bfa[d][ks] = *(const bf16x8*)(wa + 32 * ks + 8 * g); Bfx[d][ks] = *(const bf16x8*)(wx + 32 * ks + 8 * g); } } }
        float C[2] = {0.f, 0.f};
        if (MODE == 1) {
            const int cfirst = s0 / LCH, clast = send / LCH - 1; const int ch = 128 * nb + dl;
#pragma unroll
            for (int d = 0; d < 2; ++d) { const int n = d ? (clast - ck) : (ck - cfirst); const int q = (n + 3) >> 2, i0 = g * q, i1 = (i0 + q) < n ? (i0 + q) : n; float FA = 1.f, FH = 0.f;
                for (int i = i0; i < i1; i += 8) { f32x2 v[8];
#pragma unroll
                    for (int e = 0; e < 8; ++e) { const int ii = (i + e) < i1 ? (i + e) : (i1 - 1); const int kc = d ? clast - ii : cfirst + ii; v[e] = *(const f32x2*)(tot + (((size_t)kc * 2 + d) * LW + ch) * 2); }
#pragma unroll
                    for (int e = 0; e < 8; ++e) if ((i + e) < i1) { FH = v[e].x * FH + v[e].y; FA = v[e].x * FA; } }
                float Cc = 0.f;
#pragma unroll
                for (int gg = 0; gg < 4; ++gg) { const float A_g = shl(FA, c + 16 * gg), H_g = shl(FH, c + 16 * gg); Cc = A_g * Cc + H_g; }
                C[d] = Cc; }
        }
        __syncthreads();
        if (ui + 1 < u_n) LRU_LOAD_XW(u_lo + (ui + 1) * u_step);
        v4u gwp[4];
        if (MODE == 1) {
#pragma unroll
            for (int i = 0; i < 4; ++i) { const int itx = tid + 512 * i, tt = itx >> 4, cg = itx & 15; gwp[i] = *(const v4u*)(Z + (size_t)(tok0 + tt) * NIN + ZGL + 128 * nb + 8 * cg); } }
        float Cdv[2] = {C[0], C[1]}, Atv[2] = {1.f, 1.f}; f32x4 aaNv[2], axNv[2];
#define LRU_GATES(dd_, mt_, aa_, ax_) do { bf16x8 Af_[4]; _Pragma("unroll") for (int ks = 0; ks < 4; ++ks) Af_[ks] = *(const LAS bf16x8*)(xcb + (16 * (mt_) + c) * 136 + 32 * ks + 8 * g); \
                aa_ = (f32x4){0.f, 0.f, 0.f, 0.f}; ax_ = (f32x4){0.f, 0.f, 0.f, 0.f}; \
                _Pragma("unroll") for (int ks = 0; ks < 4; ++ks) { aa_ = __builtin_amdgcn_mfma_f32_16x16x32_bf16(Af_[ks], Bfa[dd_][ks], aa_, 0, 0, 0); ax_ = __builtin_amdgcn_mfma_f32_16x16x32_bf16(Af_[ks], Bfx[dd_][ks], ax_, 0, 0, 0); } } while (0)
        LRU_GATES(0, 0, aaNv[0], axNv[0]); LRU_GATES(1, LCH / 16 - 1, aaNv[1], axNv[1]);
#pragma unroll 2
        for (int it = 0; it < LCH / 16; ++it) {
#pragma unroll
            for (int d = 0; d < 2; ++d) { const int mt = d ? (LCH / 16 - 1 - it) : it;
                const f32x4 aa = aaNv[d], ax = axNv[d];
                if (it + 1 < LCH / 16) { const int mtn = d ? (LCH / 16 - 2 - it) : it + 1; LRU_GATES(d, mtn, aaNv[d], axNv[d]); }
                float av[4], uv[4];
#pragma unroll
                for (int jp = 0; jp < 2; ++jp) {
                    constexpr float NL2E = -1.4426950408889634f;
                    const f32x2 za = (f32x2){aa[2 * jp], aa[2 * jp + 1]} * NL2E + NL2E * bav[d], zx = (f32x2){ax[2 * jp], ax[2 * jp + 1]} * NL2E + NL2E * bxv[d];
                    const f32x2 da = (f32x2){__builtin_amdgcn_exp2f(za.x), __builtin_amdgcn_exp2f(za.y)} + 1.0f, dx = (f32x2){__builtin_amdgcn_exp2f(zx.x), __builtin_amdgcn_exp2f(zx.y)} + 1.0f;
                    const f32x2 r = {__builtin_amdgcn_rcpf(da.x), __builtin_amdgcn_rcpf(da.y)}, ig = {__builtin_amdgcn_rcpf(dx.x), __builtin_amdgcn_rcpf(dx.y)};
                    const f32x2 la2 = r * (-sp8[d]);
                    const f32x2 a2 = {__builtin_amdgcn_exp2f(la2.x), __builtin_amdgcn_exp2f(la2.y)};
                    const f32x2 om = (f32x2){1.0f, 1.0f} - a2 * a2;
                    const int tl = 16 * mt + 4 * g + 2 * jp;
                    const f32x2 xv = {__uint_as_float((unsigned)xcb[tl * 136 + dl] << 16), __uint_as_float((unsigned)xcb[(tl + 1) * 136 + dl] << 16)};
                    const f32x2 u2 = (f32x2){__builtin_amdgcn_sqrtf(om.x), __builtin_amdgcn_sqrtf(om.y)} * (ig * xv);
                    av[2 * jp] = a2.x; av[2 * jp + 1] = a2.y; uv[2 * jp] = u2.x; uv[2 * jp + 1] = u2.y; }
                float Pp = 1.f, Hh = 0.f, pj[4], hj[4];
#pragma unroll
                for (int jj = 0; jj < 4; ++jj) { const int j = d ? 3 - jj : jj; Hh = av[j] * Hh + uv[j]; Pp *= av[j]; pj[j] = Pp; hj[j] = Hh; }
                float tA = Pp, tH = Hh, eA = 1.f, eH = 0.f;
#pragma unroll
                for (int dim = 0; dim < 2; ++dim) { float aA = tA, bA = tA, aH = tH, bH = tH;
                    if (dim == 0) { pg8::swap16(aA, bA); pg8::swap16(aH, bH); } else { pg8::swap32(aA, bA); pg8::swap32(aH, bH); }
                    const float loA = d ? bA : aA, loH = d ? bH : aH, hiA = d ? aA : bA, hiH = d ? aH : bH;
                    const bool later = (((g >> dim) & 1) != 0) != (d != 0);
                    const float LA = later ? loA : 1.f, LH = later ? loH : 0.f;
                    eH = eA * LH + eH; eA = eA * LA;
                    tH = hiA * loH + hiH; tA = loA * hiA; }
                const float Xin = eA * Cdv[d] + eH;
                if (MODE == 0) Atv[d] *= tA;
                Cdv[d] = tA * Cdv[d] + tH;
                if (MODE == 1) {
#pragma unroll
                    for (int j = 0; j < 4; ++j) { LAS float* hp = hb + (16 * mt + 4 * g + j) * 132 + dl; const float hv = pj[j] * Xin + hj[j]; if (it < LCH / 32) *hp = hv; else *hp = *hp + hv; } }
            }
        }
        if (MODE == 0) { if (g == 0) {
#pragma unroll
            for (int d = 0; d < 2; ++d) *(f32x2*)(tot + (((size_t)ck * 2 + d) * LW + 128 * nb + dl) * 2) = (f32x2){Atv[d], Cdv[d]}; } }
        if (MODE == 1) {
            __syncthreads();
#pragma unroll
            for (int i = 0; i < 4; ++i) { const int itx = tid + 512 * i, tt = itx >> 4, cg = itx & 15;
                const f32x4 f0 = *(const LAS f32x4*)(hb + tt * 132 + 8 * cg), f1 = *(const LAS f32x4*)(hb + tt * 132 + 8 * cg + 4);
                bf16* gp = Z + (size_t)(tok0 + tt) * NIN + ZGL + 128 * nb + 8 * cg; const v4u gw = gwp[i];
                float rv[8];
                rv[0] = f0[0] * gelu_tanh(bf_lo(gw.x)); rv[1] = f0[1] * gelu_tanh(bf_hi(gw.x)); rv[2] = f0[2] * gelu_tanh(bf_lo(gw.y)); rv[3] = f0[3] * gelu_tanh(bf_hi(gw.y));
                rv[4] = f1[0] * gelu_tanh(bf_lo(gw.z)); rv[5] = f1[1] * gelu_tanh(bf_hi(gw.z)); rv[6] = f1[2] * gelu_tanh(bf_lo(gw.w)); rv[7] = f1[3] * gelu_tanh(bf_hi(gw.w));
                float sq = 0.f;
#pragma unroll
                for (int e = 0; e < 8; ++e) sq += rv[e] * rv[e];
                sq += shx(sq, 1, lane); sq += shx(sq, 2, lane); sq += shx(sq, 4, lane); sq += shx(sq, 8, lane);
                v4u o; o.x = pk2(rv[0], rv[1]); o.y = pk2(rv[2], rv[3]); o.z = pk2(rv[4], rv[5]); o.w = pk2(rv[6], rv[7]); *(v4u*)gp = o;
                if (cg == 0) unsafeAtomicAdd(ssq + tok0 + tt, pg8::qgrid<6>(sq)); }
        }
    }
#undef LRU_LOAD_XW
#undef LRU_GATES
    __syncthreads();
}

__device__ __forceinline__ void rmsnorm_phase(bf16* Z, const float* ssq_att, const float* ssq_rec, int gw, int NGW, int lane) {
    for (int r = gw; r < T; r += NGW) {
        const float ra = rsqrtf(ssq_att[r] * (1.0f / AW) + 1e-5f), rr = rsqrtf(ssq_rec[r] * (1.0f / LW) + 1e-5f);
#pragma unroll
        for (int i = 0; i < 4; ++i) { const int col = 8 * (lane + 64 * i); const float sc = col < AW ? ra : rr; bf16* p = Z + (size_t)r * NIN + col; const v4u w = *(const v4u*)p;
            v4u o; o.x = pk2(bf_lo(w.x) * sc, bf_hi(w.x) * sc); o.y = pk2(bf_lo(w.y) * sc, bf_hi(w.y) * sc); o.z = pk2(bf_lo(w.z) * sc, bf_hi(w.z) * sc); o.w = pk2(bf_lo(w.w) * sc, bf_hi(w.w) * sc); *(v4u*)p = o; }
    }
}
__device__ __forceinline__ void final_ln_phase(float* out, const unsigned char* res, const float* st, const float* g, const float* b, int gw, int NGW, int lane, const float* tpv) {
    for (int r0 = gw; r0 < T; r0 += 2 * NGW) {
      v4u wv[2][4]; f32x2 sv2[2];
#pragma unroll
      for (int h = 0; h < 2; ++h) { const int r = r0 + h * NGW; if (r < T) { sv2[h] = *(const f32x2*)(st + 2 * (size_t)r);
#pragma unroll
          for (int i = 0; i < 4; ++i) wv[h][i] = __builtin_nontemporal_load((const v4u*)(res + ((size_t)r * D + 8 * (lane + 64 * i)) * 2)); } }
#pragma unroll
      for (int h = 0; h < 2; ++h) { const int r = r0 + h * NGW; if (r >= T) break;
        const f32x2 s = sv2[h]; const float mu = s.x * (1.0f / 2048.0f); const float rstd = rsqrtf(fmaxf(s.y * (1.0f / 2048.0f) - mu * mu, 0.f) + 1e-5f);
#pragma unroll
        for (int i = 0; i < 4; ++i) { const int col = 8 * (lane + 64 * i); const v4u w = wv[h][i]; float* p = out + (size_t)r * D + col;
            const f32x4 t0 = {pg8::f16_lo(w.x), pg8::f16_hi(w.x), pg8::f16_lo(w.y), pg8::f16_hi(w.y)}, t1 = {pg8::f16_lo(w.z), pg8::f16_hi(w.z), pg8::f16_lo(w.w), pg8::f16_hi(w.w)};
            f32x4 y0 = (t0 - mu) * rstd * *(const f32x4*)(g + col) + *(const f32x4*)(b + col), y1 = (t1 - mu) * rstd * *(const f32x4*)(g + col + 4) + *(const f32x4*)(b + col + 4);
#if defined(TPROBE)
            y0 = y0 * (1.0f + tpv[0]); y1 = y1 * (1.0f + tpv[0]);
#endif
            __builtin_nontemporal_store(y0, (f32x4*)p); __builtin_nontemporal_store(y1, (f32x4*)(p + 4)); }
      }
    }
}

#ifndef STAGGER_DOWN
#define STAGGER_DOWN 0
#endif
#ifndef STAGGER_OUT
#define STAGGER_OUT 0
#endif
__device__ __forceinline__ void stagger_start(int blk, unsigned ticks_per_group) {
    const unsigned long long t0 = __builtin_amdgcn_s_memrealtime(); const unsigned long long wait = (unsigned long long)(blk & 3) * ticks_per_group;
    while (__builtin_amdgcn_s_memrealtime() - t0 < wait) __builtin_amdgcn_s_sleep(16);
}
#ifndef FUSE_FIN
#define FUSE_FIN 0
#endif
#ifndef MK_N_LAUNCHES
#define MK_N_LAUNCHES 1
#endif
#if defined(XDUP) && (XDUP < 3 || XDUP == 6 || XDUP == 7 || XDUP == 8 || XDUP == 10 || XDUP == 11 || XDUP == 12 || (XDUP >= 13 && XDUP <= 19))
constexpr int N_PHASES_C = 1 + 9 + 1 + 9 + 1 + (XDUP == 19 ? 6 : 0);
#else
constexpr int N_PHASES_C = 1 + 8 + 1 + 8 + (FUSE_FIN ? 0 : 1);
#endif
__global__ void __launch_bounds__(NWAVES * 64, 2) enc_fwd(Args args) {
    __builtin_amdgcn_s_setreg(1473, 1);
    extern __shared__ __attribute__((aligned(16))) unsigned char lds_raw[];
    LAS unsigned char* lds = (LAS unsigned char*)lds_raw;
    volatile LAS unsigned* MISC = (volatile LAS unsigned*)(lds + MISC_OFF);
    const int tid = threadIdx.x, lane = tid & 63, wave = __builtin_amdgcn_readfirstlane(tid >> 6);
    const int G = gridDim.x, blk = blockIdx.x;
    (void)lane; (void)wave;
    GAS unsigned char* ws = (GAS unsigned char*)args.ws;
    for (int u = tid; u < (LDS_BYTES - LDSCTL_OFF) / 4; u += NWAVES * 64) ((LAS unsigned*)(lds + LDSCTL_OFF))[u] = 0u;
    __syncthreads();
    unsigned bar_x; { const XcdBarrier b0 = xcd_barrier_post((unsigned*)(args.ws + WS_CTL) + CW_BAR, MISC + 8); bar_x = b0.x; }
#define GRID_BAR() do { unsigned xx_ = bar_x; asm volatile("" : "+s"(xx_)); XcdBarrier b_; b_.bar = (unsigned*)(ws + WS_CTL) + CW_BAR; b_.x = xx_; b_.st = MISC + 8; xcd_barrier(b_); } while (0)
    int ph = 0;
    const int lo = args.ph_lo, hi = args.ph_hi; (void)lo; (void)hi;
#if defined(TPROBE)
    unsigned long long tp_acc0 = 0, tp_acc1 = 0, tp_all = 0, tp_t0 = 0, tp_c0 = 0; int tp_cls = 2;
#if TPROBE == 1
#define TP_BEGIN(k) tp_cls = ((k) == 1 || (k) == 2 || (k) == 3 || (k) == 8) ? 0 : (((k) == 4 || (k) == 6) ? 1 : 2); tp_t0 = __builtin_amdgcn_s_memrealtime();
#define TP_MID()
#elif TPROBE == 3
#define TP_BEGIN(k) tp_cls = ((k) == 1 || (k) == 2) ? 0 : (((k) == 3 || (k) == 8) ? 1 : 2); tp_t0 = __builtin_amdgcn_s_memrealtime();
#define TP_MID()
#elif TPROBE == 5
#define TP_BEGIN(k) tp_cls = ((k) == 1) ? 0 : 2; tp_t0 = __builtin_amdgcn_s_memrealtime(); tp_c0 = __builtin_amdgcn_s_memtime();
#define TP_MID()
#elif TPROBE == 4
#define TP_BEGIN(k) tp_cls = ((k) == 1) ? 0 : (((k) == 0 || (k) == 9) ? 1 : 2); tp_t0 = __builtin_amdgcn_s_memrealtime();
#define TP_MID()
#else
#define TP_BEGIN(k) tp_cls = ((k) == 4) ? 0 : (((k) == 6) ? 1 : 2); tp_t0 = __builtin_amdgcn_s_memrealtime();
#define TP_MID() { __syncthreads(); const unsigned long long n_ = __builtin_amdgcn_s_memrealtime(); tp_all += n_ - tp_t0; tp_acc0 += n_ - tp_t0; tp_t0 = n_; tp_cls = 2; }
#endif
#if TPROBE == 5
#define TP_END() { const unsigned long long d_ = __builtin_amdgcn_s_memrealtime() - tp_t0, dc_ = __builtin_amdgcn_s_memtime() - tp_c0; if (tp_cls == 0) { tp_acc0 += d_; tp_acc1 += dc_; } \
        if (blk == 0 && tid == 0) { float* tpw = (float*)(args.ws + WS_VEC + 32768); const float ghz = 0.1f * (float)tp_acc1 / (float)(tp_acc0 ? tp_acc0 : 1); tpw[0] = 0.01f * floorf(ghz * 10.0f + 0.5f); tpw[1] = 0.0f; } }
#else
#define TP_END() { const unsigned long long d_ = __builtin_amdgcn_s_memrealtime() - tp_t0; tp_all += d_; if (tp_cls == 0) tp_acc0 += d_; if (tp_cls == 1) tp_acc1 += d_; \
        if (blk == 0 && tid == 0) { float* tpw = (float*)(args.ws + WS_VEC + 32768); tpw[0] = 0.02f + 0.08f * (floorf(40.0f * (float)tp_acc0 / (float)tp_all + 0.5f) / 40.0f); tpw[1] = 2.0f + 8.0f * (floorf(40.0f * (float)tp_acc1 / (float)tp_all + 0.5f) / 40.0f);     } }
#endif
#else
#define TP_BEGIN(k)
#define TP_END()
#define TP_MID()
#endif
#if MK_N_LAUNCHES == 1
#define PH_IN_RANGE true
#define PH_BAR_AFTER (ph + 1 < N_PHASES_C)
#else
#define PH_IN_RANGE (ph >= lo && ph < hi)
#define PH_BAR_AFTER (ph + 1 < hi)
#endif
#define PHASE_BEGIN(k) if (PH_IN_RANGE) { TP_BEGIN(k) if (PHON(k)) { int tidx = wave * 64 + pg8::lane_now(), blkx = blk, Gx = G; CArgs P = (CArgs)__builtin_amdgcn_kernarg_segment_ptr(); asm volatile("" : "+s"(ws), "+s"(outg), "+v"(tidx), "+s"(blkx), "+s"(Gx), "+s"(P)); const int NGW = Gx * NWAVES, NGT = Gx * NWAVES * 64; (void)NGW; (void)NGT; const int lanex = tidx & 63, wavex = __builtin_amdgcn_readfirstlane(tidx >> 6), gwx = blkx * NWAVES + wavex, gtidx = blkx * (NWAVES * 64) + tidx; (void)lanex; (void)gwx; (void)gtidx;
#define PHASE_END   } if (PH_BAR_AFTER) { TP_END() GRID_BAR(); } } ++ph;

    GAS float* outg = (GAS float*)args.out;
#define out ((float*)outg)

#if defined(XDUP) && XDUP == 19
    PHASE_BEGIN(0) PHASE_END PHASE_BEGIN(0) PHASE_END PHASE_BEGIN(0) PHASE_END PHASE_BEGIN(0) PHASE_END PHASE_BEGIN(0) PHASE_END PHASE_BEGIN(0) PHASE_END PHASE_BEGIN(0) PHASE_END PHASE_BEGIN(0) PHASE_END
#endif
#if defined(XDUP) && XDUP == 18
    PHASE_BEGIN(0) prologue(P, lds, gtidx, NGT, gwx, NGW, wavex, lanex, false); PHASE_END
#endif
    PHASE_BEGIN(0) prologue(P, lds, gtidx, NGT, gwx, NGW, wavex, lanex); PHASE_END

    { constexpr int l = 0;
    {
#define TB ((bf16*)(ws + WS_TB))
#define HB ((bf16*)(ws + WS_BIG))
#define Z ((bf16*)(ws + WS_BIG))
#define csb ((float*)(ws + WS_CSB) + (size_t)l * 6 * 16384)
#define ones ((const float*)(ws + WS_VEC))
#define zeros (ones + 2048)
#define st_prev (l ? (const float*)(ws + WS_ST + 2 * STAT_BYTES) : (const float*)(ws + WS_ST0))
#define g_prev (l ? P->in[20] : ones)
#define b_prev (l ? P->in[21] : zeros)
#define st1 ((float*)(ws + WS_ST + (size_t)(3 * l + 0) * STAT_BYTES))
#define st2 ((float*)(ws + WS_ST + (size_t)(3 * l + 1) * STAT_BYTES))
#define st3 ((float*)(ws + WS_ST + (size_t)(3 * l + 2) * STAT_BYTES))
#ifndef F8TO6
#define F8TO6 0
#endif
#if FFN6_D
#define GU_EPI pg8::EpiGU6
#ifndef F6_FIX
#define F6_FIX 1.0f
#endif
#define DOWN_SC (0.5f / (pg8::F6_WD * pg8::F6_HSC) * F6_FIX)
#else
#define GU_EPI pg8::EpiGU
#define DOWN_SC (0.5f / (pg8::F8_WSC * pg8::F8_HSC) * (F8TO6 ? 8.0f : 1.0f))
#endif
#ifndef WGM_GU
#define WGM_GU PG8_WGM
#endif
#ifndef WGM_D
#define WGM_D PG8_WGM
#endif
#ifndef WGM_IN
#define WGM_IN PG8_WGM
#endif
#ifndef WGM_OUT
#define WGM_OUT PG8_WGM
#endif
#define ssq_att ((float*)(ws + WS_SSQ + (size_t)(2 * l) * SSQ_BYTES))
#define ssq_rec ((float*)(ws + WS_SSQ + (size_t)(2 * l + 1) * SSQ_BYTES))
        PHASE_BEGIN(1) { pg8::Gemm gm{(const bf16*)(ws + WS_TB8), (const bf16*)(ws + WS_WGU1), T, 2 * FF, D / 2, D / 2}; pg8::StaticOrder S; S.init(T, 2 * FF, Gx, blkx);
            pg8::EpiGU E{(unsigned char*)HB, st_prev, csb, csb + 16384};
            pg8::gemm_phase<pg8::EpiGU, pg8::StaticOrder, PG8_ALIGN, PG8_SP2, true>(lds + RING_OFF, gm, S, E, tidx); } PHASE_END
#if defined(XDUP) && XDUP == 11
        PHASE_BEGIN(1) { pg8::Gemm gm{(const bf16*)(ws + WS_TB8), (const bf16*)(ws + WS_WGU1), T, 2 * FF, D / 2, D / 2}; pg8::FixedOrder S; S.init(T, 2 * FF, Gx, blkx);
            pg8::EpiNull E{(float*)(ws + WS_VEC + 65536)};
            pg8::gemm_phase<pg8::EpiNull, pg8::FixedOrder, PG8_ALIGN, PG8_SP2, true, false, 2>(lds + RING_OFF, gm, S, E, tidx); } PHASE_END
#endif
#if defined(XDUP) && XDUP >= 13 && XDUP <= 16
        PHASE_BEGIN(1) { pg8::Gemm gm{(const bf16*)(ws + WS_TB8), (const bf16*)(ws + WS_WGU1), T, 2 * FF, D / 2, D / 2}; pg8::StaticOrder S; S.init(T, 2 * FF, Gx, blkx);
            pg8::EpiNull E{(float*)(ws + WS_VEC + 65536)};
            pg8::gemm_phase<pg8::EpiNull, pg8::StaticOrder, PG8_ALIGN, PG8_SP2, true, false, 1, false, false, XDUP - 13>(lds + RING_OFF, gm, S, E, tidx); } PHASE_END
#endif
#if defined(XDUP) && XDUP == 12
        PHASE_BEGIN(1) { pg8::Gemm gm{(const bf16*)(ws + WS_TB8), (const bf16*)(ws + WS_WGU1), T, 2 * FF, D / 2, D / 2}; pg8::StaticOrder S; S.init(T, 2 * FF, Gx, blkx);
            pg8::EpiNull E{(float*)(ws + WS_VEC + 65536)};
            pg8::gemm_phase<pg8::EpiNull, pg8::StaticOrder, PG8_ALIGN, PG8_SP2, false, false, 1, true>(lds + RING_OFF, gm, S, E, tidx); } PHASE_END
#endif
#if defined(XDUP) && XDUP == 9
        for (int xb = 0; xb < 10; ++xb) { GRID_BAR(); }
#endif
#if defined(XDUP) && XDUP == 10
        PHASE_BEGIN(1) { pg8::Gemm gm{(const bf16*)(ws + WS_TB8), (const bf16*)(ws + WS_WGU1), T, 2 * FF, D / 2, D / 2}; pg8::FixedOrder S; S.init(T, 2 * FF, Gx, blkx);
            pg8::EpiNull E{(float*)(ws + WS_VEC + 65536)};
            pg8::gemm_phase<pg8::EpiNull, pg8::FixedOrder, PG8_ALIGN, PG8_SP2, true>(lds + RING_OFF, gm, S, E, tidx); } PHASE_END
#endif
#if defined(XDUP) && XDUP == 1
        PHASE_BEGIN(1) { pg8::Gemm gm{(const bf16*)(ws + WS_TB8), (const bf16*)(ws + WS_WGU1), T, 2 * FF, D / 2, D / 2}; pg8::StaticOrder S; S.init(T, 2 * FF, Gx, blkx);
            pg8::EpiNull E{(float*)(ws + WS_VEC + 65536)};
            pg8::gemm_phase<pg8::EpiNull, pg8::StaticOrder, PG8_ALIGN, PG8_SP2, true>(lds + RING_OFF, gm, S, E, tidx); } PHASE_END
#elif defined(XDUP) && XDUP == 2
        PHASE_BEGIN(1) { pg8::Gemm gm{(const bf16*)(ws + WS_TB8), (const bf16*)(ws + WS_WGU1), T, 2 * FF, D / 2, D / 2}; pg8::StaticOrder S; S.init(T, 2 * FF, Gx, blkx, WGM_GU);
            GU_EPI E{(unsigned char*)HB, st_prev, csb, csb + 16384};
            pg8::gemm_phase<GU_EPI, pg8::StaticOrder, PG8_ALIGN, PG8_SP2, !FFN6_GU, false, 1, FFN6_GU>(lds + RING_OFF, gm, S, E, tidx); } PHASE_END
#endif
        PHASE_BEGIN(2) { if (STAGGER_DOWN) stagger_start(blkx, STAGGER_DOWN); pg8::Gemm gm{HB, (const bf16*)(ws + WS_WD1), T, D, FF / 2, FF / 2}; pg8::StaticOrder S; S.init(T, D, Gx, blkx, WGM_D);
            pg8::EpiRes<false> E{P, ws, l == 0, (unsigned)(l ? WS_ST + 2 * STAT_BYTES : WS_ST0), (unsigned)(WS_ST + (size_t)(3 * l + 0) * STAT_BYTES), l ? 20 : -1, 21, 0, DOWN_SC, 0u};
            pg8::gemm_phase<pg8::EpiRes<false>, pg8::StaticOrder, PG8_ALIGN, PG8_SP2, !FFN6_D, false, 1, FFN6_D, F8TO6>(lds + RING_OFF, gm, S, E, tidx); } PHASE_END
        PHASE_BEGIN(3) { pg8::Gemm gm{TB, (const bf16*)(ws + WS_WIN), T, NIN, D, D}; pg8::StaticOrder S; S.init(T, NIN, Gx, blkx, WGM_IN);
            pg8::EpiIn E{Z, st1, csb + 2 * 16384, csb + 3 * 16384, (const float*)(ws + WS_ROPE)};
            pg8::gemm_phase<pg8::EpiIn, pg8::StaticOrder, PG8_ALIGN, PG8_SP2, false, true>(lds + RING_OFF, gm, S, E, tidx); } PHASE_END
#if defined(XDUP) && XDUP == 7
        PHASE_BEGIN(3) { pg8::Gemm gm{TB, (const bf16*)(ws + WS_WIN), T, NIN, D, D}; pg8::StaticOrder S; S.init(T, NIN, Gx, blkx);
            pg8::EpiIn E{Z, st1, csb + 2 * 16384, csb + 3 * 16384, (const float*)(ws + WS_ROPE)};
            pg8::gemm_phase<pg8::EpiIn, pg8::StaticOrder, PG8_ALIGN, PG8_SP2, false, true>(lds + RING_OFF, gm, S, E, tidx); } PHASE_END
#endif
        PHASE_BEGIN(4)
#if defined(ATTN_VALU)
            attn_valu_phase(lds, Z, ssq_att, blkx, Gx, wavex, lanex);
#else
#if defined(XDUP) && XDUP == 4
            attn_mfma_phase(lds, Z, ssq_att, blkx, Gx, tidx, wavex, lanex, (bf16*)(ws + WS_TB));
#endif
            attn_mfma_phase(lds, Z, ssq_att, blkx, Gx, tidx, wavex, lanex);
#endif
            TP_MID()
            if (PHON(5)) lru_phase<0>(lds, blkx, Gx, tidx, lanex, wavex, Z, (const bf16*)(ws + WS_LRUW), P->in[10] + (size_t)l * 4 * LW, P->in[11] + (size_t)l * LW, P->in[13] + (size_t)l * 2 * LW, P->in[15] + (size_t)l * 2 * LW, P->in[16] + (size_t)l * 2 * LW, (float*)(ws + WS_TOT), ssq_rec);
#if defined(XDUP) && XDUP == 3
            lru_phase<0>(lds, blkx, Gx, tidx, lanex, wavex, Z, (const bf16*)(ws + WS_LRUW), P->in[10] + (size_t)l * 4 * LW, P->in[11] + (size_t)l * LW, P->in[13] + (size_t)l * 2 * LW, P->in[15] + (size_t)l * 2 * LW, P->in[16] + (size_t)l * 2 * LW, (float*)(ws + WS_TOT), ssq_rec);
#endif
            PHASE_END
        PHASE_BEGIN(6) lru_phase<1>(lds, blkx, Gx, tidx, lanex, wavex, Z, (const bf16*)(ws + WS_LRUW), P->in[10] + (size_t)l * 4 * LW, P->in[11] + (size_t)l * LW, P->in[13] + (size_t)l * 2 * LW, P->in[15] + (size_t)l * 2 * LW, P->in[16] + (size_t)l * 2 * LW, (float*)(ws + WS_TOT), ssq_rec); PHASE_END
        PHASE_BEGIN(8) { if (STAGGER_OUT) stagger_start(blkx, STAGGER_OUT); pg8::Gemm gm{Z, (const bf16*)(ws + WS_WOUT), T, D, D, NIN}; pg8::StaticOrder S; S.init(T, D, Gx, blkx, WGM_OUT);
            pg8::EpiRes<true, false, 12> E{P, ws, 0, (unsigned)(WS_ST + (size_t)(3 * l + 0) * STAT_BYTES), (unsigned)(WS_ST + (size_t)(3 * l + 1) * STAT_BYTES), 2, 3, l * D, 1.0f, (unsigned)(WS_SSQ + (size_t)(2 * l) * SSQ_BYTES)};
            pg8::gemm_phase<pg8::EpiRes<true, false, 12>, pg8::StaticOrder, PG8_ALIGN, PG8_SP2>(lds + RING_OFF, gm, S, E, tidx); } PHASE_END
        PHASE_BEGIN(1) { pg8::Gemm gm{(const bf16*)(ws + WS_TB8), (const bf16*)(ws + WS_WGU2), T, 2 * FF, D / 2, D / 2}; pg8::StaticOrder S; S.init(T, 2 * FF, Gx, blkx, WGM_GU);
            GU_EPI E{(unsigned char*)HB, st2, csb + 4 * 16384, csb + 5 * 16384};
            pg8::gemm_phase<GU_EPI, pg8::StaticOrder, PG8_ALIGN, PG8_SP2, !FFN6_GU, false, 1, FFN6_GU>(lds + RING_OFF, gm, S, E, tidx); } PHASE_END
#if defined(XDUP) && XDUP == 8
        PHASE_BEGIN(2) { pg8::Gemm gm{HB, (const bf16*)(ws + WS_WD2), T, D, FF / 2, FF / 2}; pg8::StaticOrder S; S.init(T, D, Gx, blkx);
            pg8::EpiRes<true, true> E{P, ws, 0, (unsigned)(WS_ST + (size_t)(3 * l + 1) * STAT_BYTES), (unsigned)(WS_ST + (size_t)(3 * l + 2) * STAT_BYTES), 7, 8, l * D, 0.5f / (pg8::F8_WSC * pg8::F8_HSC), 0u};
            pg8::gemm_phase<pg8::EpiRes<true, true>, pg8::StaticOrder, PG8_ALIGN, PG8_SP2, true>(lds + RING_OFF, gm, S, E, tidx); } PHASE_END
#endif
#if defined(XDUP) && XDUP == 6
        PHASE_BEGIN(2) { pg8::Gemm gm{HB, (const bf16*)(ws + WS_WD2), T, D, FF / 2, FF / 2}; pg8::StaticOrder S; S.init(T, D, Gx, blkx);
            pg8::EpiNull E{(float*)(ws + WS_VEC + 65536)};
            pg8::gemm_phase<pg8::EpiNull, pg8::StaticOrder, PG8_ALIGN, PG8_SP2, true>(lds + RING_OFF, gm, S, E, tidx); } PHASE_END
#endif
        PHASE_BEGIN(2) { if (STAGGER_DOWN) stagger_start(blkx, STAGGER_DOWN); pg8::Gemm gm{HB, (const bf16*)(ws + WS_WD2), T, D, FF / 2, FF / 2}; pg8::StaticOrder S; S.init(T, D, Gx, blkx, WGM_D);
            using EpiD2 = pg8::EpiRes<(l == 1) ? false : true, false, 0, (FUSE_FIN && l == 1)>;
            EpiD2 E{P, ws, 0, (unsigned)(WS_ST + (size_t)(3 * l + 1) * STAT_BYTES), (unsigned)(WS_ST + (size_t)(3 * l + 2) * STAT_BYTES), 7, 8, l * D, DOWN_SC, 0u};
            pg8::gemm_phase<EpiD2, pg8::StaticOrder, PG8_ALIGN, PG8_SP2, !FFN6_D, false, 1, FFN6_D, F8TO6>(lds + RING_OFF, gm, S, E, tidx); } PHASE_END
        if (l == 0) { PHASE_BEGIN(9) convert_layer(P, 1, lds, gwx, NGW, wavex, lanex);
#if defined(XDUP) && XDUP == 5
            convert_layer(P, 1, lds, gwx, NGW, wavex, lanex, (float*)(ws + WS_TOT));
#endif
            PHASE_END }
    }
    }
    { constexpr int l = 1;
    {
#define TB ((bf16*)(ws + WS_TB))
#define HB ((bf16*)(ws + WS_BIG))
#define Z ((bf16*)(ws + WS_BIG))
#define csb ((float*)(ws + WS_CSB) + (size_t)l * 6 * 16384)
#define ones ((const float*)(ws + WS_VEC))
#define zeros (ones + 2048)
#define st_prev (l ? (const float*)(ws + WS_ST + 2 * STAT_BYTES) : (const float*)(ws + WS_ST0))
#define g_prev (l ? P->in[20] : ones)
#define b_prev (l ? P->in[21] : zeros)
#define st1 ((float*)(ws + WS_ST + (size_t)(3 * l + 0) * STAT_BYTES))
#define st2 ((float*)(ws + WS_ST + (size_t)(3 * l + 1) * STAT_BYTES))
#define st3 ((float*)(ws + WS_ST + (size_t)(3 * l + 2) * STAT_BYTES))
#ifndef F8TO6
#define F8TO6 0
#endif
#if FFN6_D
#define GU_EPI pg8::EpiGU6
#ifndef F6_FIX
#define F6_FIX 1.0f
#endif
#define DOWN_SC (0.5f / (pg8::F6_WD * pg8::F6_HSC) * F6_FIX)
#else
#define GU_EPI pg8::EpiGU
#define DOWN_SC (0.5f / (pg8::F8_WSC * pg8::F8_HSC) * (F8TO6 ? 8.0f : 1.0f))
#endif
#ifndef WGM_GU
#define WGM_GU PG8_WGM
#endif
#ifndef WGM_D
#define WGM_D PG8_WGM
#endif
#ifndef WGM_IN
#define WGM_IN PG8_WGM
#endif
#ifndef WGM_OUT
#define WGM_OUT PG8_WGM
#endif
#define ssq_att ((float*)(ws + WS_SSQ + (size_t)(2 * l) * SSQ_BYTES))
#define ssq_rec ((float*)(ws + WS_SSQ + (size_t)(2 * l + 1) * SSQ_BYTES))
        PHASE_BEGIN(1) { pg8::Gemm gm{(const bf16*)(ws + WS_TB8), (const bf16*)(ws + WS_WGU1), T, 2 * FF, D / 2, D / 2}; pg8::StaticOrder S; S.init(T, 2 * FF, Gx, blkx);
            pg8::EpiGU E{(unsigned char*)HB, st_prev, csb, csb + 16384};
            pg8::gemm_phase<pg8::EpiGU, pg8::StaticOrder, PG8_ALIGN, PG8_SP2, true>(lds + RING_OFF, gm, S, E, tidx); } PHASE_END
#if defined(XDUP) && XDUP == 11
        PHASE_BEGIN(1) { pg8::Gemm gm{(const bf16*)(ws + WS_TB8), (const bf16*)(ws + WS_WGU1), T, 2 * FF, D / 2, D / 2}; pg8::FixedOrder S; S.init(T, 2 * FF, Gx, blkx);
            pg8::EpiNull E{(float*)(ws + WS_VEC + 65536)};
            pg8::gemm_phase<pg8::EpiNull, pg8::FixedOrder, PG8_ALIGN, PG8_SP2, true, false, 2>(lds + RING_OFF, gm, S, E, tidx); } PHASE_END
#endif
#if defined(XDUP) && XDUP >= 13 && XDUP <= 16
        PHASE_BEGIN(1) { pg8::Gemm gm{(const bf16*)(ws + WS_TB8), (const bf16*)(ws + WS_WGU1), T, 2 * FF, D / 2, D / 2}; pg8::StaticOrder S; S.init(T, 2 * FF, Gx, blkx);
            pg8::EpiNull E{(float*)(ws + WS_VEC + 65536)};
            pg8::gemm_phase<pg8::EpiNull, pg8::StaticOrder, PG8_ALIGN, PG8_SP2, true, false, 1, false, false, XDUP - 13>(lds + RING_OFF, gm, S, E, tidx); } PHASE_END
#endif
#if defined(XDUP) && XDUP == 12
        PHASE_BEGIN(1) { pg8::Gemm gm{(const bf16*)(ws + WS_TB8), (const bf16*)(ws + WS_WGU1), T, 2 * FF, D / 2, D / 2}; pg8::StaticOrder S; S.init(T, 2 * FF, Gx, blkx);
            pg8::EpiNull E{(float*)(ws + WS_VEC + 65536)};
            pg8::gemm_phase<pg8::EpiNull, pg8::StaticOrder, PG8_ALIGN, PG8_SP2, false, false, 1, true>(lds + RING_OFF, gm, S, E, tidx); } PHASE_END
#endif
#if defined(XDUP) && XDUP == 9
        for (int xb = 0; xb < 10; ++xb) { GRID_BAR(); }
#endif
#if defined(XDUP) && XDUP == 10
        PHASE_BEGIN(1) { pg8::Gemm gm{(const bf16*)(ws + WS_TB8), (const bf16*)(ws + WS_WGU1), T, 2 * FF, D / 2, D / 2}; pg8::FixedOrder S; S.init(T, 2 * FF, Gx, blkx);
            pg8::EpiNull E{(float*)(ws + WS_VEC + 65536)};
            pg8::gemm_phase<pg8::EpiNull, pg8::FixedOrder, PG8_ALIGN, PG8_SP2, true>(lds + RING_OFF, gm, S, E, tidx); } PHASE_END
#endif
#if defined(XDUP) && XDUP == 1
        PHASE_BEGIN(1) { pg8::Gemm gm{(const bf16*)(ws + WS_TB8), (const bf16*)(ws + WS_WGU1), T, 2 * FF, D / 2, D / 2}; pg8::StaticOrder S; S.init(T, 2 * FF, Gx, blkx);
            pg8::EpiNull E{(float*)(ws + WS_VEC + 65536)};
            pg8::gemm_phase<pg8::EpiNull, pg8::StaticOrder, PG8_ALIGN, PG8_SP2, true>(lds + RING_OFF, gm, S, E, tidx); } PHASE_END
#elif defined(XDUP) && XDUP == 2
        PHASE_BEGIN(1) { pg8::Gemm gm{(const bf16*)(ws + WS_TB8), (const bf16*)(ws + WS_WGU1), T, 2 * FF, D / 2, D / 2}; pg8::StaticOrder S; S.init(T, 2 * FF, Gx, blkx, WGM_GU);
            GU_EPI E{(unsigned char*)HB, st_prev, csb, csb + 16384};
            pg8::gemm_phase<GU_EPI, pg8::StaticOrder, PG8_ALIGN, PG8_SP2, !FFN6_GU, false, 1, FFN6_GU>(lds + RING_OFF, gm, S, E, tidx); } PHASE_END
#endif
        PHASE_BEGIN(2) { if (STAGGER_DOWN) stagger_start(blkx, STAGGER_DOWN); pg8::Gemm gm{HB, (const bf16*)(ws + WS_WD1), T, D, FF / 2, FF / 2}; pg8::StaticOrder S; S.init(T, D, Gx, blkx, WGM_D);
            pg8::EpiRes<false> E{P, ws, l == 0, (unsigned)(l ? WS_ST + 2 * STAT_BYTES : WS_ST0), (unsigned)(WS_ST + (size_t)(3 * l + 0) * STAT_BYTES), l ? 20 : -1, 21, 0, DOWN_SC, 0u};
            pg8::gemm_phase<pg8::EpiRes<false>, pg8::StaticOrder, PG8_ALIGN, PG8_SP2, !FFN6_D, false, 1, FFN6_D, F8TO6>(lds + RING_OFF, gm, S, E, tidx); } PHASE_END
        PHASE_BEGIN(3) { pg8::Gemm gm{TB, (const bf16*)(ws + WS_WIN), T, NIN, D, D}; pg8::StaticOrder S; S.init(T, NIN, Gx, blkx, WGM_IN);
            pg8::EpiIn E{Z, st1, csb + 2 * 16384, csb + 3 * 16384, (const float*)(ws + WS_ROPE)};
            pg8::gemm_phase<pg8::EpiIn, pg8::StaticOrder, PG8_ALIGN, PG8_SP2, false, true>(lds + RING_OFF, gm, S, E, tidx); } PHASE_END
#if defined(XDUP) && XDUP == 7
        PHASE_BEGIN(3) { pg8::Gemm gm{TB, (const bf16*)(ws + WS_WIN), T, NIN, D, D}; pg8::StaticOrder S; S.init(T, NIN, Gx, blkx);
            pg8::EpiIn E{Z, st1, csb + 2 * 16384, csb + 3 * 16384, (const float*)(ws + WS_ROPE)};
            pg8::gemm_phase<pg8::EpiIn, pg8::StaticOrder, PG8_ALIGN, PG8_SP2, false, true>(lds + RING_OFF, gm, S, E, tidx); } PHASE_END
#endif
        PHASE_BEGIN(4)
#if defined(ATTN_VALU)
            attn_valu_phase(lds, Z, ssq_att, blkx, Gx, wavex, lanex);
#else
#if defined(XDUP) && XDUP == 4
            attn_mfma_phase(lds, Z, ssq_att, blkx, Gx, tidx, wavex, lanex, (bf16*)(ws + WS_TB));
#endif
            attn_mfma_phase(lds, Z, ssq_att, blkx, Gx, tidx, wavex, lanex);
#endif
            TP_MID()
            if (PHON(5)) lru_phase<0>(lds, blkx, Gx, tidx, lanex, wavex, Z, (const bf16*)(ws + WS_LRUW), P->in[10] + (size_t)l * 4 * LW, P->in[11] + (size_t)l * LW, P->in[13] + (size_t)l * 2 * LW, P->in[15] + (size_t)l * 2 * LW, P->in[16] + (size_t)l * 2 * LW, (float*)(ws + WS_TOT), ssq_rec);
#if defined(XDUP) && XDUP == 3
            lru_phase<0>(lds, blkx, Gx, tidx, lanex, wavex, Z, (const bf16*)(ws + WS_LRUW), P->in[10] + (size_t)l * 4 * LW, P->in[11] + (size_t)l * LW, P->in[13] + (size_t)l * 2 * LW, P->in[15] + (size_t)l * 2 * LW, P->in[16] + (size_t)l * 2 * LW, (float*)(ws + WS_TOT), ssq_rec);
#endif
            PHASE_END
        PHASE_BEGIN(6) lru_phase<1>(lds, blkx, Gx, tidx, lanex, wavex, Z, (const bf16*)(ws + WS_LRUW), P->in[10] + (size_t)l * 4 * LW, P->in[11] + (size_t)l * LW, P->in[13] + (size_t)l * 2 * LW, P->in[15] + (size_t)l * 2 * LW, P->in[16] + (size_t)l * 2 * LW, (float*)(ws + WS_TOT), ssq_rec); PHASE_END
        PHASE_BEGIN(8) { if (STAGGER_OUT) stagger_start(blkx, STAGGER_OUT); pg8::Gemm gm{Z, (const bf16*)(ws + WS_WOUT), T, D, D, NIN}; pg8::StaticOrder S; S.init(T, D, Gx, blkx, WGM_OUT);
            pg8::EpiRes<true, false, 12> E{P, ws, 0, (unsigned)(WS_ST + (size_t)(3 * l + 0) * STAT_BYTES), (unsigned)(WS_ST + (size_t)(3 * l + 1) * STAT_BYTES), 2, 3, l * D, 1.0f, (unsigned)(WS_SSQ + (size_t)(2 * l) * SSQ_BYTES)};
            pg8::gemm_phase<pg8::EpiRes<true, false, 12>, pg8::StaticOrder, PG8_ALIGN, PG8_SP2>(lds + RING_OFF, gm, S, E, tidx); } PHASE_END
        PHASE_BEGIN(1) { pg8::Gemm gm{(const bf16*)(ws + WS_TB8), (const bf16*)(ws + WS_WGU2), T, 2 * FF, D / 2, D / 2}; pg8::StaticOrder S; S.init(T, 2 * FF, Gx, blkx, WGM_GU);
            GU_EPI E{(unsigned char*)HB, st2, csb + 4 * 16384, csb + 5 * 16384};
            pg8::gemm_phase<GU_EPI, pg8::StaticOrder, PG8_ALIGN, PG8_SP2, !FFN6_GU, false, 1, FFN6_GU>(lds + RING_OFF, gm, S, E, tidx); } PHASE_END
#if defined(XDUP) && XDUP == 8
        PHASE_BEGIN(2) { pg8::Gemm gm{HB, (const bf16*)(ws + WS_WD2), T, D, FF / 2, FF / 2}; pg8::StaticOrder S; S.init(T, D, Gx, blkx);
            pg8::EpiRes<true, true> E{P, ws, 0, (unsigned)(WS_ST + (size_t)(3 * l + 1) * STAT_BYTES), (unsigned)(WS_ST + (size_t)(3 * l + 2) * STAT_BYTES), 7, 8, l * D, 0.5f / (pg8::F8_WSC * pg8::F8_HSC), 0u};
            pg8::gemm_phase<pg8::EpiRes<true, true>, pg8::StaticOrder, PG8_ALIGN, PG8_SP2, true>(lds + RING_OFF, gm, S, E, tidx); } PHASE_END
#endif
#if defined(XDUP) && XDUP == 6
        PHASE_BEGIN(2) { pg8::Gemm gm{HB, (const bf16*)(ws + WS_WD2), T, D, FF / 2, FF / 2}; pg8::StaticOrder S; S.init(T, D, Gx, blkx);
            pg8::EpiNull E{(float*)(ws + WS_VEC + 65536)};
            pg8::gemm_phase<pg8::EpiNull, pg8::StaticOrder, PG8_ALIGN, PG8_SP2, true>(lds + RING_OFF, gm, S, E, tidx); } PHASE_END
#endif
        PHASE_BEGIN(2) { if (STAGGER_DOWN) stagger_start(blkx, STAGGER_DOWN); pg8::Gemm gm{HB, (const bf16*)(ws + WS_WD2), T, D, FF / 2, FF / 2}; pg8::StaticOrder S; S.init(T, D, Gx, blkx, WGM_D);
            using EpiD2 = pg8::EpiRes<(l == 1) ? false : true, false, 0, (FUSE_FIN && l == 1)>;
            EpiD2 E{P, ws, 0, (unsigned)(WS_ST + (size_t)(3 * l + 1) * STAT_BYTES), (unsigned)(WS_ST + (size_t)(3 * l + 2) * STAT_BYTES), 7, 8, l * D, DOWN_SC, 0u};
            pg8::gemm_phase<EpiD2, pg8::StaticOrder, PG8_ALIGN, PG8_SP2, !FFN6_D, false, 1, FFN6_D, F8TO6>(lds + RING_OFF, gm, S, E, tidx); } PHASE_END
        if (l == 0) { PHASE_BEGIN(9) convert_layer(P, 1, lds, gwx, NGW, wavex, lanex);
#if defined(XDUP) && XDUP == 5
            convert_layer(P, 1, lds, gwx, NGW, wavex, lanex, (float*)(ws + WS_TOT));
#endif
            PHASE_END }
    }
    }

#if !FUSE_FIN
#if defined(XDUP) && XDUP == 17
    PHASE_BEGIN(10) final_ln_phase(out, (const unsigned char*)(ws + WS_TB), (const float*)(ws + WS_ST + 5 * STAT_BYTES), P->in[20] + D, P->in[21] + D, gwx, NGW, lanex, (const float*)(ws + WS_VEC + 32768)); PHASE_END
#endif
    PHASE_BEGIN(10) final_ln_phase(out, (const unsigned char*)(ws + WS_TB), (const float*)(ws + WS_ST + 5 * STAT_BYTES), P->in[20] + D, P->in[21] + D, gwx, NGW, lanex, (const float*)(ws + WS_VEC + 32768)); PHASE_END
#endif
#undef PHASE_BEGIN
#undef PH_IN_RANGE
#undef PH_BAR_AFTER
#undef GRID_BAR
#undef PHASE_END
#undef TB
#undef HB
#undef Z
#undef csb
#undef ones
#undef zeros
#undef st_prev
#undef g_prev
#undef b_prev
#undef st1
#undef st2
#undef st3
#undef ssq_att
#undef ssq_rec
#undef out
}
constexpr int N_PHASES = N_PHASES_C;

#ifndef MK_N_LAUNCHES
#define MK_N_LAUNCHES 1
#endif
extern "C" void kernel_launch(void* const* d_in, const int* in_sizes, int n_in, void* d_out, int out_size, void* d_ws, size_t ws_size, hipStream_t stream) {
    static int grid = 0;
    if (grid == 0) {
        if (n_in != 25 || out_size != T * D || ws_size < WS_END) { fprintf(stderr, "kernel_launch: unexpected shapes (n_in %d, out %d, ws %zu)\n", n_in, out_size, ws_size); grid = -1; return; }
        int dev = 0, cus = 0, per_cu = 0;
        if (hipGetDevice(&dev) != hipSuccess || hipDeviceGetAttribute(&cus, hipDeviceAttributeMultiprocessorCount, dev) != hipSuccess) { grid = -1; return; }
        if (hipFuncSetAttribute((const void*)enc_fwd, hipFuncAttributeMaxDynamicSharedMemorySize, LDS_BYTES) != hipSuccess) { grid = -1; return; }
        if (hipOccupancyMaxActiveBlocksPerMultiprocessor(&per_cu, (const void*)enc_fwd, NWAVES * 64, LDS_BYTES) != hipSuccess || per_cu < 1) fprintf(stderr, "kernel_launch: occupancy query reports %d\n", per_cu);
        (void)hipGetLastError();
        grid = cus;
    }
    if (grid < 0) return;
    if (hipMemsetAsync((char*)d_ws + WS_CTL, 0, CTL_ZERO_BYTES, stream) != hipSuccess) return;
    Args a{};
    for (int i = 0; i < 25; ++i) a.in[i] = (const float*)d_in[i];
    a.out = (float*)d_out; a.ws = (unsigned char*)d_ws;
#if MK_N_LAUNCHES == 1
    a.ph_lo = 0; a.ph_hi = N_PHASES;
    hipLaunchKernelGGL(enc_fwd, dim3(grid), dim3(NWAVES * 64), LDS_BYTES, stream, a);
#else
    for (int p = 0; p < N_PHASES; ++p) { a.ph_lo = p; a.ph_hi = p + 1; hipLaunchKernelGGL(enc_fwd, dim3(grid), dim3(NWAVES * 64), LDS_BYTES, stream, a); }
#endif
}
```

```cpp
#include <hip/hip_runtime.h>
#include <cstdio>
#include <cstdint>

#ifndef PG8_SP2
#define PG8_SP2 true
#endif
#ifndef PG8_ALIGN
#define PG8_ALIGN true
#endif
constexpr int NWAVES = 8;
constexpr int T = 49152, TPR = 32768, D = 2048, FF = 5632, NIN = 4864, AW = 768, LW = 1280;
constexpr int ZQ = 0, ZGL = 768, ZK = 2048, ZV = 2816, ZXL = 3584;
constexpr int LCH = 128, NCHUNK = T / LCH;
constexpr size_t MiB = 1u << 20;
constexpr size_t WS_CTL = 0, CTL_ZERO_BYTES = 5 * MiB;
constexpr size_t STAT_BYTES = (size_t)T * 8, SSQ_BYTES = (size_t)T * 4;
constexpr size_t WS_ST = 1 * MiB;
constexpr size_t WS_SSQ = WS_ST + 6 * STAT_BYTES;
constexpr size_t WS_CSB = 4 * MiB;
static_assert(WS_SSQ + 4 * SSQ_BYTES <= WS_CSB && WS_CSB + 2 * 6 * 65536 <= CTL_ZERO_BYTES, "zero region");
constexpr size_t WS_ST0 = 5 * MiB;
constexpr size_t WS_VEC = 5 * MiB + 512 * 1024;
constexpr size_t WS_ROPE = 6 * MiB;
constexpr size_t WS_LRUW = 7 * MiB;
constexpr size_t WS_TOT = 10 * MiB;
constexpr size_t WS_WGU1 = 26 * MiB, WS_WD1 = 70 * MiB, WS_WIN = 92 * MiB, WS_WOUT = 111 * MiB, WS_WGU2 = 119 * MiB, WS_WD2 = 163 * MiB;
constexpr size_t WS_TB = 185 * MiB;
constexpr size_t WS_BIG = 377 * MiB;
constexpr size_t WS_TB8 = 905 * MiB;
constexpr size_t WS_END = 1001 * MiB;
static_assert(WS_TOT + (size_t)NCHUNK * 2 * 1280 * 8 <= WS_WGU1 && WS_WD2 + (size_t)D * FF * 2 <= WS_TB && WS_TB + (size_t)T * D * 2 <= WS_BIG && WS_BIG + (size_t)T * FF * 2 <= WS_TB8 && WS_TB8 + (size_t)T * D <= WS_END, "d_ws map");
constexpr int CW_BAR = 4096;
constexpr int RING_OFF = 0, RING_BYTES = 131072;
constexpr int LDSCTL_OFF = RING_BYTES, MISC_OFF = LDSCTL_OFF + 320;
constexpr int LDS_BYTES = 147456;
struct Args { const float* in[25]; float* out; unsigned char* ws; int ph_lo, ph_hi; };
#define GAS __attribute__((address_space(1)))
typedef const __attribute__((address_space(4))) Args* CArgs;
namespace pg8 {
#define PG8_LAS __attribute__((address_space(3)))
typedef unsigned short bf16_t;
typedef short bf16x8 __attribute__((ext_vector_type(8)));
typedef float f32x4 __attribute__((ext_vector_type(4)));
typedef unsigned u32x4 __attribute__((ext_vector_type(4)));
constexpr int BM = 256, BK = 64, HALF = 128, HTB = HALF * BK * 2  , STAGE_BYTES = 8 * HTB, NXCD = 8;
#ifndef PG8_WGM
#define PG8_WGM 4
#endif
constexpr int WGM = PG8_WGM;

__host__ __device__ __forceinline__ int lds_byte(int r, int c) { const int st = (r >> 4) * 2 + (c >> 5), rr = r & 15, cc = c & 31, ob = rr * 64 + cc * 2; return st * 1024 + (ob ^ (((ob >> 9) & 1) << 5)); }
__host__ __device__ __forceinline__ void stage_rc(int b, int& R, int& C) { const int st = b / 1024, sb = b % 1024, swz = sb ^ (((sb >> 9) & 1) << 5); R = (st >> 1) * 16 + swz / 64; C = (st & 1) * 32 + (swz % 64) / 2; }
__host__ __device__ __forceinline__ int perm32(int rho) { const int n = rho >> 4, i = rho & 15; return 8 * (i >> 2) + 4 * n + (i & 3); }

struct Unit { int pm, pn; };
struct Gemm { const bf16_t* A; const bf16_t* Bt; int M, N, K, lda; };

struct StaticOrder {
    int nM, nN, nwg, G, c, wgm;
    __host__ __device__ void init(int M, int N, int G_, int c_, int wgm_ = WGM) { nM = M / BM; nN = N / BM; nwg = nM * nN; G = G_; c = c_; wgm = wgm_; }
    __host__ __device__ bool next(int i, Unit& u) const {
        const long L = (long)i * G + c; if (L >= nwg) return false;
        int wgid = (int)L; { const int q = nwg / NXCD, r = nwg % NXCD, xcd = wgid % NXCD, off = wgid / NXCD; wgid = (xcd < r ? xcd * (q + 1) : r * (q + 1) + (xcd - r) * q) + off; }
        const int nig = wgm * nN, gid = wgid / nig, fm = gid * wgm, gsz = (nM - fm) < wgm ? (nM - fm) : wgm;
        u.pm = fm + ((wgid % nig) % gsz); u.pn = (wgid % nig) / gsz; return true;
    }
    __device__ __forceinline__ void a_ready(const Unit&) const {}
    __device__ __forceinline__ void done(const Unit&) const {}
};


struct FixedOrder : StaticOrder {
    __host__ __device__ bool next(int i, Unit& u) const { const long L = (long)i * G + c; if (L >= nwg) return false; u.pm = 0; u.pn = 0; return true; }
};

__device__ __forceinline__ unsigned cvt_pk_bf16(float lo, float hi) { unsigned r; asm volatile("v_cvt_pk_bf16_f32 %0, %1, %2" : "=v"(r) : "v"(lo), "v"(hi)); return r; }
__device__ __forceinline__ float shx(float v, int m, int lane) { return __builtin_bit_cast(float, __builtin_amdgcn_ds_bpermute((lane ^ m) << 2, __builtin_bit_cast(int, v))); }
__device__ __forceinline__ float shl(float v, int src) { return __builtin_bit_cast(float, __builtin_amdgcn_ds_bpermute(src << 2, __builtin_bit_cast(int, v))); }
__device__ __forceinline__ int lane_now() { int l; asm volatile("v_mbcnt_lo_u32_b32 %0, -1, 0\n\tv_mbcnt_hi_u32_b32 %0, -1, %0" : "=v"(l)); return l; }
template <int SH> __device__ __forceinline__ float qgrid(float x) { return __builtin_rintf(x * (float)(1 << SH)) * (1.0f / (float)(1 << SH)); }
typedef float f32x2 __attribute__((ext_vector_type(2)));
typedef unsigned u32x2 __attribute__((ext_vector_type(2)));
constexpr float ALPHA_RES = 1.41421356237309515f;
__device__ __forceinline__ void row_stats(const float* st, int r, float& mu, float& rstd) {
    const f32x2 s = *(const f32x2*)(st + 2 * (size_t)r);
    mu = s.x * (1.0f / 2048.0f); const float var = s.y * (1.0f / 2048.0f) - mu * mu;
    rstd = __builtin_amdgcn_rsqf(fmaxf(var, 0.0f) + 1e-5f);
}
__device__ __forceinline__ unsigned pk_f16(float lo, float hi) { unsigned r; asm("v_cvt_pk_f16_f32 %0, %1, %2" : "=v"(r) : "v"(lo), "v"(hi)); return r; }
__device__ __forceinline__ float f16_lo(unsigned w) { return (float)__builtin_bit_cast(_Float16, (unsigned short)(w & 0xffffu)); }
__device__ __forceinline__ float f16_hi(unsigned w) { return (float)__builtin_bit_cast(_Float16, (unsigned short)(w >> 16)); }
__device__ __forceinline__ unsigned pk4_fp8(float a, float b, float c, float d) {
    int w = __builtin_amdgcn_cvt_pk_fp8_f32(a, b, 0, false); w = __builtin_amdgcn_cvt_pk_fp8_f32(c, d, w, true); return (unsigned)w; }
constexpr float F8_WSC = 512.0f, F8_HSC = 32.0f;
#ifndef FFN6_GU
#define FFN6_GU 0
#endif
#ifndef FFN6_D
#define FFN6_D 0
#endif
constexpr float GU_WSC = FFN6_GU ? 128.0f : 512.0f;
typedef float f32x16 __attribute__((ext_vector_type(16)));
typedef unsigned u32x6 __attribute__((ext_vector_type(6)));
constexpr float F6_WGU = 128.0f, F6_WD = 224.0f, F6_HSC = 6.0f;
__device__ __forceinline__ void swap32(float& a, float& b) { asm volatile("s_nop 1\n\tv_permlane32_swap_b32 %0, %1" : "+v"(a), "+v"(b)); }
__device__ __forceinline__ void swap16(float& a, float& b) { asm volatile("s_nop 1\n\tv_permlane16_swap_b32 %0, %1" : "+v"(a), "+v"(b)); }
__device__ __forceinline__ void tr4(float& x0, float& x1, float& x2, float& x3) { swap32(x0, x2); swap32(x1, x3); swap16(x0, x1); swap16(x2, x3); }
__device__ __forceinline__ void st_frag6(unsigned char* rowkt, int kb, int sw, const f32x16 lo, const f32x16 hi) {
    const u32x6 w = __builtin_amdgcn_cvt_scalef32_2xpk16_fp6_f32(lo, hi, 1.0f);
    *(u32x4*)(rowkt + 16 * kb) = (u32x4){w[0], w[1], w[2], w[3]}; *(u32x2*)(rowkt + 64 + 8 * (kb ^ sw)) = (u32x2){w[4], w[5]}; }
__device__ __forceinline__ float silu_f(float v) { return v * __builtin_amdgcn_rcpf(1.0f + __builtin_amdgcn_exp2f(v * -1.4426950408889634f)); }

struct EpiGU {
    static constexpr bool PERM = true, AFTER_DRAIN = false, PF = false; static constexpr int MIDK = 0;
    unsigned char* H; const float* st; const float* cs; const float* cb;
    __device__ __forceinline__ void operator()(const f32x4 (&acc)[2][2][4][2], const Unit& u, int wr, int wc, int fr, int fq) const {
        const int row0 = u.pm * BM + wr * 64 + fr, rb = u.pn * BM + wc * 32 + 8 * fq, hc = u.pn * 128 + wc * 32 + 8 * fq; constexpr float dsc = 1.0f / GU_WSC;
        f32x4 csg[2], cbg[2], csu[2], cbu[2]; f32x2 sv[8];
#pragma unroll
        for (int i = 0; i < 8; ++i) sv[i] = *(const f32x2*)(st + 2 * (size_t)(row0 + (i >> 2) * HALF + (i & 3) * 16));
        constexpr float NL2E = -1.4426950408889634f, NLN2 = -0.6931471805599453f;
#pragma unroll
        for (int n = 0; n < 2; ++n) { csg[n] = *(const f32x4*)(cs + rb + 4 * n) * NL2E; cbg[n] = *(const f32x4*)(cb + rb + 4 * n) * NL2E; csu[n] = *(const f32x4*)(cs + rb + HALF + 4 * n) * (F8_HSC * NLN2); cbu[n] = *(const f32x4*)(cb + rb + HALF + 4 * n) * (F8_HSC * NLN2); }
#pragma unroll
        for (int ai = 0; ai < 2; ++ai)
#pragma unroll
            for (int m = 0; m < 4; ++m) { const int r = row0 + ai * HALF + m * 16; const f32x2 s2 = sv[ai * 4 + m];
                const float mu = s2.x * (1.0f / 2048.0f), rstd = __builtin_amdgcn_rsqf(fmaxf(s2.y * (1.0f / 2048.0f) - mu * mu, 0.0f) + 1e-5f);
                const float ag = dsc * rstd * NL2E, au = dsc * rstd * (F8_HSC * NLN2), mr = mu * rstd;
                f32x4 hv[2];
#pragma unroll
                for (int n = 0; n < 2; ++n) { const f32x4 z = acc[ai][0][m][n] * ag + (cbg[n] - csg[n] * mr), up = acc[ai][1][m][n] * au + (cbu[n] - csu[n] * mr);
                    const f32x4 gt = z; f32x4 e, r;
#pragma unroll
                    for (int j = 0; j < 4; ++j) e[j] = __builtin_amdgcn_exp2f(z[j]);
                    const f32x4 den = e + 1.0f;
#pragma unroll
                    for (int j = 0; j < 4; ++j) r[j] = __builtin_amdgcn_rcpf(den[j]);
                    hv[n] = (gt * up) * r; }
                u32x2 w; w.x = pk4_fp8(hv[0][0], hv[0][1], hv[0][2], hv[0][3]); w.y = pk4_fp8(hv[1][0], hv[1][1], hv[1][2], hv[1][3]);
                *(u32x2*)(H + (size_t)r * 5632 + hc) = w; }
    }
};
struct EpiGU6 {
    static constexpr bool PERM = true, AFTER_DRAIN = false, PF = false; static constexpr int MIDK = 0;
    unsigned char* H; const float* st; const float* cs; const float* cb;
    __device__ __forceinline__ void operator()(const f32x4 (&acc)[2][2][4][2], const Unit& u, int wr, int wc, int fr, int fq) const {
        const int row0 = u.pm * BM + wr * 64 + fr, rb = u.pn * BM + wc * 32 + 8 * fq; constexpr float dsc = 1.0f / GU_WSC;
        f32x4 csg[2], cbg[2], csu[2], cbu[2]; f32x2 sv[8];
#pragma unroll
        for (int i = 0; i < 8; ++i) sv[i] = *(const f32x2*)(st + 2 * (size_t)(row0 + (i >> 2) * HALF + (i & 3) * 16));
#pragma unroll
        for (int n = 0; n < 2; ++n) { csg[n] = *(const f32x4*)(cs + rb + 4 * n); cbg[n] = *(const f32x4*)(cb + rb + 4 * n); csu[n] = *(const f32x4*)(cs + rb + HALF + 4 * n) * F6_HSC; cbu[n] = *(const f32x4*)(cb + rb + HALF + 4 * n) * F6_HSC; }
#pragma unroll
        for (int ai = 0; ai < 2; ++ai) { float hv[4][8];
#pragma unroll
            for (int m = 0; m < 4; ++m) { const f32x2 s2 = sv[ai * 4 + m];
                const float mu = s2.x * (1.0f / 2048.0f), rstd = __builtin_amdgcn_rsqf(fmaxf(s2.y * (1.0f / 2048.0f) - mu * mu, 0.0f) + 1e-5f);
                const float ag = dsc * rstd, au = ag * F6_HSC, mr = mu * rstd;
#pragma unroll
                for (int n = 0; n < 2; ++n) { const f32x4 gt = acc[ai][0][m][n] * ag + (cbg[n] - csg[n] * mr), up = acc[ai][1][m][n] * au + (cbu[n] - csu[n] * mr);
#pragma unroll
                    for (int j = 0; j < 4; ++j) hv[m][4 * n + j] = gt[j] * __builtin_amdgcn_rcpf(1.0f + __builtin_amdgcn_exp2f(gt[j] * -1.4426950408889634f)) * up[j]; } }
#pragma unroll
            for (int d = 0; d < 8; ++d) tr4(hv[0][d], hv[1][d], hv[2][d], hv[3][d]);
            f32x16 lo, hi;
#pragma unroll
            for (int d = 0; d < 8; ++d) { lo[d] = hv[0][d]; lo[8 + d] = hv[1][d]; hi[d] = hv[2][d]; hi[8 + d] = hv[3][d]; }
            const int r = u.pm * BM + wr * 64 + ai * HALF + fq * 16 + fr;
            st_frag6(H + (size_t)r * 4224 + 96 * u.pn, wc, (fr & 8) ? 2 : 0, lo, hi); }
    }
};
struct EpiIn {
    static constexpr bool PERM = true, AFTER_DRAIN = false, PF = false; static constexpr int MIDK = 0;
    bf16_t* Z; const float* st; const float* cs; const float* cb; const float* rope;
    __device__ __forceinline__ void operator()(const f32x4 (&acc)[2][2][4][2], const Unit& u, int wr, int wc, int fr, int fq) const {
        const int row0 = u.pm * BM + wr * 64 + fr, rb = u.pn * BM + wc * 32 + 8 * fq;
        const bool rot = (u.pn < 3 || (u.pn >= 8 && u.pn < 11)) && ((wc & 1) == 0);
        f32x4 csv[2][2], cbv[2][2];
#pragma unroll
        for (int bj = 0; bj < 2; ++bj)
#pragma unroll
            for (int n = 0; n < 2; ++n) { csv[bj][n] = *(const f32x4*)(cs + rb + bj * HALF + 4 * n); cbv[bj][n] = *(const f32x4*)(cb + rb + bj * HALF + 4 * n); }
        f32x2 sv[8];
#pragma unroll
        for (int i = 0; i < 8; ++i) sv[i] = *(const f32x2*)(st + 2 * (size_t)(row0 + (i >> 2) * HALF + (i & 3) * 16));
#pragma unroll
        for (int ai = 0; ai < 2; ++ai)
#pragma unroll
            for (int m = 0; m < 4; ++m) { const int r = row0 + ai * HALF + m * 16; const f32x2 s2 = sv[ai * 4 + m];
                const float mu = s2.x * (1.0f / 2048.0f), rstd = __builtin_amdgcn_rsqf(fmaxf(s2.y * (1.0f / 2048.0f) - mu * mu, 0.0f) + 1e-5f);
                f32x4 cs0 = {1.f, 0.f, 1.f, 0.f}, cs1 = cs0, cs2 = cs0, cs3 = cs0;
                if (rot && fq < 2) { const int pos = r < 32768 ? (r & 4095) : (r - 32768); const f32x4* rp = (const f32x4*)(rope + (size_t)pos * 16); cs0 = rp[0]; cs1 = rp[1]; cs2 = rp[2]; cs3 = rp[3]; }
                const float sg = (fq == 0) ? -1.f : 1.f;
#pragma unroll
                for (int bj = 0; bj < 2; ++bj) { f32x4 v0 = (acc[ai][bj][m][0] - csv[bj][0] * mu) * rstd + cbv[bj][0], v1 = (acc[ai][bj][m][1] - csv[bj][1] * mu) * rstd + cbv[bj][1];
                    if (rot) { f32x4 p0, p1;
#pragma unroll
                        for (int j = 0; j < 4; ++j) { p0[j] = shx(v0[j], 16, (fr + 16 * fq)); p1[j] = shx(v1[j], 16, (fr + 16 * fq)); }
                        if (fq < 2) {
                            v0[0] = v0[0] * cs0[0] + sg * p0[0] * cs0[1]; v0[1] = v0[1] * cs0[2] + sg * p0[1] * cs0[3]; v0[2] = v0[2] * cs1[0] + sg * p0[2] * cs1[1]; v0[3] = v0[3] * cs1[2] + sg * p0[3] * cs1[3];
                            v1[0] = v1[0] * cs2[0] + sg * p1[0] * cs2[1]; v1[1] = v1[1] * cs2[2] + sg * p1[1] * cs2[3]; v1[2] = v1[2] * cs3[0] + sg * p1[2] * cs3[1]; v1[3] = v1[3] * cs3[2] + sg * p1[3] * cs3[3]; } }
                    u32x4 w; w.x = cvt_pk_bf16(v0[0], v0[1]); w.y = cvt_pk_bf16(v0[2], v0[3]); w.z = cvt_pk_bf16(v1[0], v1[1]); w.w = cvt_pk_bf16(v1[2], v1[3]);
                    *(u32x4*)(Z + (size_t)r * 4864 + rb + bj * HALF) = w; } }
    }
};
template <bool TB8, bool DUMMY = false, int MK = 0, bool FIN = false> struct EpiRes {
#ifndef RES_PF
#define RES_PF 0
#endif
    static constexpr bool PERM = true, AFTER_DRAIN = false, PF = (RES_PF != 0); static constexpr int MIDK = MK;
    CArgs a; GAS unsigned char* ws; int x_in;
    unsigned st_off, stout_off; int gi, bi, goff; float sc; unsigned ssq_off;
    __device__ __forceinline__ void pf(const Unit& u, int wid, int lane, PG8_LAS unsigned char* junk) const {
        if (x_in) return;
#pragma unroll
        for (int j = 0; j < 4; ++j) { const int sidx = (wid * 4 + j) * 64 + lane, row = sidx >> 3, sec = sidx & 7;
            GAS const unsigned char* p = ws + WS_TB + (size_t)(u.pm * BM + row) * 4096 + (size_t)(u.pn * 512 + sec * 64);
            __builtin_amdgcn_global_load_lds((GAS void*)p, (PG8_LAS void*)(junk + wid * 1024 + j * 256), 4, 0, 0); }
    }
    __device__ __forceinline__ void midk(f32x4 (&acc)[2][2][4][2], const Unit& u, int wr, int wc, int fr, int fq) const {
        const int row0 = u.pm * BM + wr * 64 + fr; const float* sa = (const float*)(ws + ssq_off); const float* sr = sa + T;
        float ra[8];
#pragma unroll
        for (int i = 0; i < 8; ++i) { const int r = row0 + (i >> 2) * HALF + (i & 3) * 16; ra[i] = __builtin_amdgcn_rsqf(sa[r] * (1.0f / 768.0f) + 1e-5f) * __builtin_amdgcn_sqrtf(sr[r] * (1.0f / 1280.0f) + 1e-5f); }
#pragma unroll
        for (int i = 0; i < 8; ++i)
#pragma unroll
            for (int bj = 0; bj < 2; ++bj)
#pragma unroll
                for (int n = 0; n < 2; ++n) acc[i >> 2][bj][i & 3][n] *= ra[i];
    }
    __device__ __forceinline__ void operator()(const f32x4 (&acc)[2][2][4][2], const Unit& u, int wr, int wc, int fr, int fq) const {
        const int row0 = u.pm * BM + wr * 64 + fr, col0 = u.pn * BM + wc * 32 + 8 * fq;
        unsigned char* RES = (unsigned char*)(ws + WS_TB); unsigned char* T8 = (unsigned char*)(ws + WS_TB8);
        f32x4 (&am)[2][2][4][2] = const_cast<f32x4 (&)[2][2][4][2]>(acc);
        const float* X = (u.pm < 128) ? a->in[0] : a->in[1] - (size_t)TPR * D;
        const float* st = (const float*)(ws + st_off); float* st_out = (float*)(ws + stout_off);
        const float* g = gi < 0 ? (const float*)(ws + WS_VEC) : a->in[gi] + goff; const float* b = gi < 0 ? (const float*)(ws + WS_VEC) + 2048 : a->in[bi] + goff;
        const unsigned rbase = (unsigned)row0 * 8192u + (unsigned)col0 * 4u;
#define RES_ROWOFF(i) ((unsigned)(((i) >> 2) * HALF + ((i) & 3) * 16) * 8192u)
#define RES_LOAD(dst, sdst, i) do { const unsigned ob_ = rbase + RES_ROWOFF(i); sdst = *(const f32x2*)((const char*)st + (size_t)(row0 + ((i) >> 2) * HALF + ((i) & 3) * 16) * 8); \
        if (x_in) { _Pragma("unroll") for (int bj = 0; bj < 2; ++bj) _Pragma("unroll") for (int n = 0; n < 2; ++n) dst[bj][n] = *(const f32x4*)((const char*)X + (ob_ + (unsigned)(bj * HALF + 4 * n) * 4u)); } \
        else { _Pragma("unroll") for (int bj = 0; bj < 2; ++bj) { const u32x4 w_ = *(const u32x4*)(RES + ((ob_ + (unsigned)(bj * HALF) * 4u) >> 1)); \
            dst[bj][0] = (f32x4){f16_lo(w_.x), f16_hi(w_.x), f16_lo(w_.y), f16_hi(w_.y)}; dst[bj][1] = (f32x4){f16_lo(w_.z), f16_hi(w_.z), f16_lo(w_.w), f16_hi(w_.w)}; } } } while (0)
        f32x4 gv[2][2], bv[2][2];
#pragma unroll
        for (int bj = 0; bj < 2; ++bj)
#pragma unroll
            for (int n = 0; n < 2; ++n) { gv[bj][n] = *(const f32x4*)(g + col0 + bj * HALF + 4 * n); bv[bj][n] = *(const f32x4*)(b + col0 + bj * HALF + 4 * n); }
#pragma unroll
        for (int bj = 0; bj < 2; ++bj)
#pragma unroll
            for (int n = 0; n < 2; ++n) { gv[bj][n] = gv[bj][n] * ALPHA_RES; bv[bj][n] = bv[bj][n] * ALPHA_RES; }
        const bool dmy_ = DUMMY && (sc == 12345.678f);
        f32x4 oo[2][2], oe[2][2];
        f32x4 t0[2][2], t1[2][2], t2[2][2]; f32x2 s0, s1, s2;
#ifndef RES_LA
#define RES_LA 2
#endif
        u32x4 rw[8][2]; f32x2 sw_[8];
#define RES_RAW(i) do { const unsigned ob_ = rbase + RES_ROWOFF(i); sw_[i] = *(const f32x2*)((const char*)st + (size_t)(row0 + ((i) >> 2) * HALF + ((i) & 3) * 16) * 8); \
        _Pragma("unroll") for (int bj = 0; bj < 2; ++bj) rw[i][bj] = *(const u32x4*)(RES + ((ob_ + (unsigned)(bj * HALF) * 4u) >> 1)); } while (0)
        if (x_in) { RES_LOAD(t0, s0, 0); RES_LOAD(t1, s1, 1); }
        else {
#pragma unroll
            for (int i = 0; i < RES_LA; ++i) RES_RAW(i); }
#pragma unroll
        for (int i = 0; i < 8; ++i) { const int r = row0 + (i >> 2) * HALF + (i & 3) * 16;
                if (x_in) { if (i < 6) RES_LOAD(t2, s2, i + 2); }
                else { if (i + RES_LA < 8) RES_RAW(i + RES_LA);
                    s0 = sw_[i];
#pragma unroll
                    for (int bj = 0; bj < 2; ++bj) { const u32x4 w_ = rw[i][bj]; t0[bj][0] = (f32x4){f16_lo(w_.x), f16_hi(w_.x), f16_lo(w_.y), f16_hi(w_.y)}; t0[bj][1] = (f32x4){f16_lo(w_.z), f16_hi(w_.z), f16_lo(w_.w), f16_hi(w_.w)}; } }
                const float mu = s0.x * (1.0f / 2048.0f), rstd = __builtin_amdgcn_rsqf(fmaxf(s0.y * (1.0f / 2048.0f) - mu * mu, 0.0f) + 1e-5f);
                float scr = sc; if constexpr (MK > 0) scr = sc * __builtin_amdgcn_rsqf(((const float*)(ws + ssq_off))[T + r] * (1.0f / 1280.0f) + 1e-5f);
                const unsigned ob = rbase + RES_ROWOFF(i); const float nmr = -mu * rstd; f32x4 sv4 = {0.f, 0.f, 0.f, 0.f}, qv4 = {0.f, 0.f, 0.f, 0.f};
#pragma unroll
                for (int bj = 0; bj < 2; ++bj) { f32x4 (&o)[2] = oo[bj];
#pragma unroll
                    for (int n = 0; n < 2; ++n) {
                        const f32x4 A_ = gv[bj][n] * rstd, C_ = gv[bj][n] * nmr + bv[bj][n];
                        o[n] = acc[i >> 2][bj][i & 3][n] * scr + (t0[bj][n] * A_ + C_);
                        sv4 = sv4 + o[n]; qv4 = o[n] * o[n] + qv4; }
                    const unsigned cb_ = ob + (unsigned)(bj * HALF) * 4u;
                    if constexpr (FIN) { am[i >> 2][bj][i & 3][0] = o[0]; am[i >> 2][bj][i & 3][1] = o[1]; }
                    else { u32x4 w; w.x = pk_f16(o[0][0], o[0][1]); w.y = pk_f16(o[0][2], o[0][3]); w.z = pk_f16(o[1][0], o[1][1]); w.w = pk_f16(o[1][2], o[1][3]); if (!DUMMY || dmy_) *(u32x4*)(RES + (cb_ >> 1)) = w; }
                    if constexpr (TB8 && !FFN6_GU) { u32x2 w; w.x = pk4_fp8(o[0][0], o[0][1], o[0][2], o[0][3]); w.y = pk4_fp8(o[1][0], o[1][1], o[1][2], o[1][3]); if (!DUMMY || dmy_) *(u32x2*)(T8 + (cb_ >> 2)) = w; } }
                if constexpr (TB8 && FFN6_GU) {
                    if ((i & 1) == 0) {
#pragma unroll
                        for (int bj = 0; bj < 2; ++bj)
#pragma unroll
                            for (int n = 0; n < 2; ++n) oe[bj][n] = oo[bj][n]; }
                    else { f32x16 lo, hi;
#pragma unroll
                        for (int d = 0; d < 8; ++d) { float x0 = oe[0][d >> 2][d & 3], x1 = oe[1][d >> 2][d & 3], x2 = oo[0][d >> 2][d & 3], x3 = oo[1][d >> 2][d & 3]; tr4(x0, x1, x2, x3); lo[d] = x0; lo[8 + d] = x1; hi[d] = x2; hi[8 + d] = x3; }
                        const int ri = row0 + ((i - 1 + (fq >> 1)) >> 2) * HALF + ((i - 1 + (fq >> 1)) & 3) * 16;
                        st_frag6(T8 + (size_t)ri * 1536 + 96 * (2 * u.pn + (fq & 1)), wc, (fr & 8) ? 2 : 0, lo, hi); } }
                float s = (sv4[0] + sv4[1]) + (sv4[2] + sv4[3]), q = (qv4[0] + qv4[1]) + (qv4[2] + qv4[3]);
                s += shx(s, 16, (fr + 16 * fq)); s += shx(s, 32, (fr + 16 * fq)); q += shx(q, 16, (fr + 16 * fq)); q += shx(q, 32, (fr + 16 * fq));
                if (fq == 0 && (!DUMMY || dmy_)) { unsafeAtomicAdd(st_out + 2 * (size_t)r, qgrid<8>(s)); unsafeAtomicAdd(st_out + 2 * (size_t)r + 1, qgrid<6>(q)); }
                if (x_in) {
#pragma unroll
                for (int bj = 0; bj < 2; ++bj)
#pragma unroll
                    for (int n = 0; n < 2; ++n) { t0[bj][n] = t1[bj][n]; t1[bj][n] = t2[bj][n]; }
                s0 = s1; s1 = s2; }
                asm volatile("" ::: "memory"); }
        if constexpr (FIN) {
            unsigned* cnt = (unsigned*)(ws + WS_CTL + 524288) + u.pm * 16;
            __builtin_amdgcn_fence(__ATOMIC_RELEASE, "agent");
            if (fr + 16 * fq == 0) __hip_atomic_fetch_add(cnt, 1u, __ATOMIC_RELAXED, __HIP_MEMORY_SCOPE_AGENT);
            { const unsigned long long t0_ = __builtin_amdgcn_s_memrealtime();
              while ((unsigned)__builtin_amdgcn_readfirstlane((int)__hip_atomic_load(cnt, __ATOMIC_RELAXED, __HIP_MEMORY_SCOPE_AGENT)) < 64u) { if (__builtin_amdgcn_s_memrealtime() - t0_ > 2000000ull) break; __builtin_amdgcn_s_sleep(2); } }
            __builtin_amdgcn_fence(__ATOMIC_ACQUIRE, "agent");
            const float* g3 = a->in[20] + D; const float* b3 = a->in[21] + D; float* OUT = a->out;
#pragma unroll
            for (int bj = 0; bj < 2; ++bj)
#pragma unroll
                for (int n = 0; n < 2; ++n) { gv[bj][n] = *(const f32x4*)(g3 + col0 + bj * HALF + 4 * n); bv[bj][n] = *(const f32x4*)(b3 + col0 + bj * HALF + 4 * n); }
#pragma unroll
            for (int i = 0; i < 8; ++i) { const int r = row0 + (i >> 2) * HALF + (i & 3) * 16;
                const float sx = __hip_atomic_load(st_out + 2 * (size_t)r, __ATOMIC_RELAXED, __HIP_MEMORY_SCOPE_AGENT), sy = __hip_atomic_load(st_out + 2 * (size_t)r + 1, __ATOMIC_RELAXED, __HIP_MEMORY_SCOPE_AGENT);
                const float mu = sx * (1.0f / 2048.0f), rstd = __builtin_amdgcn_rsqf(fmaxf(sy * (1.0f / 2048.0f) - mu * mu, 0.0f) + 1e-5f);
#pragma unroll
                for (int bj = 0; bj < 2; ++bj)
#pragma unroll
                    for (int n = 0; n < 2; ++n) *(f32x4*)(OUT + (size_t)r * 2048 + col0 + bj * HALF + 4 * n) = (am[i >> 2][bj][i & 3][n] - mu) * rstd * gv[bj][n] + bv[bj][n]; }
        }
#undef RES_LOAD
#undef RES_RAW
#undef RES_ROWOFF
    }
};

struct EpiNull {
    static constexpr bool PERM = true, AFTER_DRAIN = false, PF = false; static constexpr int MIDK = 0;
    float* sink;
    __device__ __forceinline__ void operator()(const f32x4 (&acc)[2][2][4][2], const Unit& u, int wr, int wc, int fr, int fq) const {
        float s = 0.f;
#pragma unroll
        for (int ai = 0; ai < 2; ++ai)
#pragma unroll
            for (int bj = 0; bj < 2; ++bj)
#pragma unroll
                for (int m = 0; m < 4; ++m)
#pragma unroll
                    for (int n = 0; n < 2; ++n) s += acc[ai][bj][m][n][0] + acc[ai][bj][m][n][1] + acc[ai][bj][m][n][2] + acc[ai][bj][m][n][3];
        if (s == 12345.678f) sink[0] = s;
    }
};
typedef int v4i_t __attribute__((ext_vector_type(4)));
typedef int v8i_t __attribute__((ext_vector_type(8)));
typedef int v2i_t __attribute__((ext_vector_type(2)));
__device__ __forceinline__ v8i_t cat8(bf16x8 lo, bf16x8 hi) { const v4i_t a = __builtin_bit_cast(v4i_t, lo), b = __builtin_bit_cast(v4i_t, hi); return __builtin_shufflevector(a, b, 0, 1, 2, 3, 4, 5, 6, 7); }
typedef _Float16 f16x8_t __attribute__((ext_vector_type(8)));
template <class Epi, class Sched, bool ALIGN_EPI = false, bool SP2 = false, bool F8 = false, bool F16 = false, int MREP = 1, bool F6 = false, bool CV6 = false, int BMASK = 0>
__device__ __forceinline__ void gemm_phase(PG8_LAS unsigned char* lds, const Gemm g, const Sched& S, const Epi& E, const int tid) {
    const int wid = __builtin_amdgcn_readfirstlane(tid >> 6), lane = tid & 63, wr = wid >> 2, wc = wid & 3, fr = lane & 15, fq = lane >> 4;
    const int K = g.K, nt = K / BK;
    static_assert(!F6 || SP2, "F6 is written for the SP2 loop");
    unsigned voffA[2], voffB[2];
#pragma unroll
    for (int i = 0; i < 2; ++i) {
        if constexpr (F6) { const int p0 = tid + 512 * i, p = p0 >= 768 ? p0 - 256 : p0, R = p / 6, Rb = Epi::PERM ? ((R & ~31) + perm32(R & 31)) : R;
            voffA[i] = (unsigned)(R * (g.lda * 3 / 2) + (p % 6) * 16); voffB[i] = (unsigned)(Rb * (K * 3 / 2) + (p % 6) * 16); }
        else { int R, C; stage_rc(tid * 16 + i * 8192, R, C); const int Rb = Epi::PERM ? ((R & ~31) + perm32(R & 31)) : R;
            voffA[i] = (unsigned)(R * g.lda + C) * 2u; voffB[i] = (unsigned)(Rb * K + C) * 2u; } }
    const size_t kstep = F6 ? (size_t)96 : (size_t)(BK * 2);
    const size_t hstep = F6 ? (size_t)HALF * K * 3 / 2 : (size_t)HALF * K * 2;
    const size_t tstep = 2 * hstep; const size_t hstepA = F6 ? (size_t)HALF * g.lda * 3 / 2 : (size_t)HALF * g.lda * 2, tstepA = 2 * hstepA;
    const unsigned ldsw = (unsigned)wid * 1024u;
    const int sw6 = (fr & 8) ? 2 : 0;
    const int aoff = F6 ? (wr * 64 + fr) * 96 + 16 * fq : lds_byte(wr * 64 + fr, fq * 8), boff = F6 ? (wc * 32 + fr) * 96 + 16 * fq : lds_byte(wc * 32 + fr, fq * 8); constexpr int KOFF = 1024;
    const int atl = (wr * 64 + fr) * 96 + 64 + 8 * (fq ^ sw6), btl = (wc * 32 + fr) * 96 + 64 + 8 * (fq ^ sw6);
#define PG8_SA(b, h) (((b) * 2 + (h)) * HTB)
#define PG8_SB(b, h) ((4 + (b) * 2 + (h)) * HTB)
    const __amdgpu_buffer_rsrc_t rsrcA = __builtin_amdgcn_make_buffer_rsrc((void*)g.A, 0, 0x7fffffff, 0x00020000), rsrcB = __builtin_amdgcn_make_buffer_rsrc((void*)g.Bt, 0, 0x7fffffff, 0x00020000);
#define PG8_STAGE(bufoff, goff, voff) do { if constexpr (BMASK != 0) { if ((BMASK == 3) || ((voff) == voffB && (BMASK & 1)) || ((voff) == voffA && (BMASK & 2))) asm volatile("s_mov_b64 exec, 0xffff" ::: "memory"); } _Pragma("unroll") for (int _i = 0; _i < 2; ++_i) { \
        __builtin_amdgcn_raw_ptr_buffer_load_lds(((voff) == voffA) ? rsrcA : rsrcB, (PG8_LAS void*)(lds + (bufoff) + ldsw + _i * 8192), 16, (int)(voff)[_i], (int)(goff), 0, 0); } if constexpr (BMASK != 0) asm volatile("s_mov_b64 exec, -1" ::: "memory"); } while (0)
#define PG8_LD6(dst, base, mainoff, tailoff) do { dst[0] = *(const PG8_LAS bf16x8*)(lds + (base) + (mainoff)); const v2i_t t_ = *(const PG8_LAS v2i_t*)(lds + (base) + (tailoff)); \
        dst[1] = __builtin_bit_cast(bf16x8, __builtin_shufflevector(t_, t_, 0, 1, -1, -1)); } while (0)
#define PG8_LDA(dst, b, h) do { _Pragma("unroll") for (int m = 0; m < 4; ++m) { if constexpr (F6) PG8_LD6(dst[m], PG8_SA(b, h) + m * 1536, aoff, atl); \
        else { _Pragma("unroll") for (int k = 0; k < 2; ++k) dst[m][k] = *(const PG8_LAS bf16x8*)(lds + PG8_SA(b, h) + aoff + m * 2048 + k * KOFF); if constexpr (CV6) { PG8_WAIT_L(0); PG8_CV6(dst[m], 4.0f); } } } } while (0)
#define PG8_LDB(dst, b, h) do { _Pragma("unroll") for (int n = 0; n < 2; ++n) { if constexpr (F6) PG8_LD6(dst[n], PG8_SB(b, h) + n * 1536, boff, btl); \
        else { _Pragma("unroll") for (int k = 0; k < 2; ++k) dst[n][k] = *(const PG8_LAS bf16x8*)(lds + PG8_SB(b, h) + boff + n * 2048 + k * KOFF); if constexpr (CV6) { PG8_WAIT_L(0); PG8_CV6(dst[n], 2.0f); } } } } while (0)
#define PG8_CV6(fr_, dv) do { const v4i_t a_ = __builtin_bit_cast(v4i_t, fr_[0]), b_ = __builtin_bit_cast(v4i_t, fr_[1]); f32x16 lo_, hi_; \
        _Pragma("unroll") for (int q_ = 0; q_ < 4; ++q_) { lo_[4 * q_] = __builtin_amdgcn_cvt_f32_fp8(a_[q_], 0); lo_[4 * q_ + 1] = __builtin_amdgcn_cvt_f32_fp8(a_[q_], 1); lo_[4 * q_ + 2] = __builtin_amdgcn_cvt_f32_fp8(a_[q_], 2); lo_[4 * q_ + 3] = __builtin_amdgcn_cvt_f32_fp8(a_[q_], 3); \
            hi_[4 * q_] = __builtin_amdgcn_cvt_f32_fp8(b_[q_], 0); hi_[4 * q_ + 1] = __builtin_amdgcn_cvt_f32_fp8(b_[q_], 1); hi_[4 * q_ + 2] = __builtin_amdgcn_cvt_f32_fp8(b_[q_], 2); hi_[4 * q_ + 3] = __builtin_amdgcn_cvt_f32_fp8(b_[q_], 3); } \
        const u32x6 w_ = __builtin_amdgcn_cvt_scalef32_2xpk16_fp6_f32(lo_, hi_, dv); fr_[0] = __builtin_bit_cast(bf16x8, (u32x4){w_[0], w_[1], w_[2], w_[3]}); fr_[1] = __builtin_bit_cast(bf16x8, (u32x4){w_[4], w_[5], 0u, 0u}); } while (0)
#define PG8_MMA(ai, bj, At, Bt) do { __builtin_amdgcn_s_setprio(1); _Pragma("unroll") for (int rep_ = 0; rep_ < MREP; ++rep_) _Pragma("unroll") for (int m = 0; m < 4; ++m) _Pragma("unroll") for (int n = 0; n < 2; ++n) { \
        if constexpr (F6 || CV6) acc[ai][bj][m][n] = __builtin_amdgcn_mfma_scale_f32_16x16x128_f8f6f4(cat8(Bt[n][0], Bt[n][1]), cat8(At[m][0], At[m][1]), acc[ai][bj][m][n], 2, 2, 0, 0x7f7f7f7f, 0, 0x7f7f7f7f); \
        else if constexpr (F8) acc[ai][bj][m][n] = __builtin_amdgcn_mfma_scale_f32_16x16x128_f8f6f4(cat8(Bt[n][0], Bt[n][1]), cat8(At[m][0], At[m][1]), acc[ai][bj][m][n], 0, 0, 0, 0x7f7f7f7f, 0, 0x7f7f7f7f); \
        else if constexpr (F16) { _Pragma("unroll") for (int k = 0; k < 2; ++k) acc[ai][bj][m][n] = __builtin_amdgcn_mfma_f32_16x16x32_f16(__builtin_bit_cast(f16x8_t, Bt[n][k]), __builtin_bit_cast(f16x8_t, At[m][k]), acc[ai][bj][m][n], 0, 0, 0); } \
        else { _Pragma("unroll") for (int k = 0; k < 2; ++k) acc[ai][bj][m][n] = __builtin_amdgcn_mfma_f32_16x16x32_bf16(Bt[n][k], At[m][k], acc[ai][bj][m][n], 0, 0, 0); } } __builtin_amdgcn_s_setprio(0); } while (0)
#define PG8_ST1(bufoff, goff, voff, _i) do { __builtin_amdgcn_raw_ptr_buffer_load_lds(((voff) == voffA) ? rsrcA : rsrcB, (PG8_LAS void*)(lds + (bufoff) + ldsw + (_i) * 8192), 16, (int)(voff)[_i], (int)(goff), 0, 0); PG8_SCHED; } while (0)
#define PG8_MMQ(ai, bj, m, At, Bt) do { _Pragma("unroll") for (int n = 0; n < 2; ++n) { \
        if constexpr (F6 || CV6) acc[ai][bj][m][n] = __builtin_amdgcn_mfma_scale_f32_16x16x128_f8f6f4(cat8(Bt[n][0], Bt[n][1]), cat8(At[m][0], At[m][1]), acc[ai][bj][m][n], 2, 2, 0, 0x7f7f7f7f, 0, 0x7f7f7f7f); \
        else if constexpr (F8) acc[ai][bj][m][n] = __builtin_amdgcn_mfma_scale_f32_16x16x128_f8f6f4(cat8(Bt[n][0], Bt[n][1]), cat8(At[m][0], At[m][1]), acc[ai][bj][m][n], 0, 0, 0, 0x7f7f7f7f, 0, 0x7f7f7f7f); \
        else if constexpr (F16) { _Pragma("unroll") for (int k = 0; k < 2; ++k) acc[ai][bj][m][n] = __builtin_amdgcn_mfma_f32_16x16x32_f16(__builtin_bit_cast(f16x8_t, Bt[n][k]), __builtin_bit_cast(f16x8_t, At[m][k]), acc[ai][bj][m][n], 0, 0, 0); } \
        else { _Pragma("unroll") for (int k = 0; k < 2; ++k) acc[ai][bj][m][n] = __builtin_amdgcn_mfma_f32_16x16x32_bf16(Bt[n][k], At[m][k], acc[ai][bj][m][n], 0, 0, 0); } } PG8_SCHED; } while (0)
#define PG8_BLK1(At, B0, B1, buf, goff, voff) do { __builtin_amdgcn_s_setprio(1); PG8_MMQ(0, 0, 0, At, B0); PG8_MMQ(0, 0, 1, At, B0); PG8_ST1(buf, goff, voff, 0); PG8_MMQ(0, 0, 2, At, B0); PG8_MMQ(0, 0, 3, At, B0); PG8_ST1(buf, goff, voff, 1); \
        PG8_MMQ(0, 1, 0, At, B1); PG8_MMQ(0, 1, 1, At, B1); PG8_MMQ(0, 1, 2, At, B1); PG8_MMQ(0, 1, 3, At, B1); __builtin_amdgcn_s_setprio(0); } while (0)
#define PG8_BLK2(At, B0, B1, buf0, goff0, voff0, buf1, goff1, voff1, buf2, goff2, voff2) do { __builtin_amdgcn_s_setprio(1); PG8_MMQ(1, 0, 0, At, B0); PG8_ST1(buf0, goff0, voff0, 0); PG8_MMQ(1, 0, 1, At, B0); PG8_ST1(buf0, goff0, voff0, 1); \
        PG8_MMQ(1, 0, 2, At, B0); PG8_ST1(buf1, goff1, voff1, 0); PG8_MMQ(1, 0, 3, At, B0); PG8_ST1(buf1, goff1, voff1, 1); PG8_MMQ(1, 1, 0, At, B1); PG8_ST1(buf2, goff2, voff2, 0); PG8_MMQ(1, 1, 1, At, B1); PG8_ST1(buf2, goff2, voff2, 1); \
        PG8_MMQ(1, 1, 2, At, B1); PG8_MMQ(1, 1, 3, At, B1); __builtin_amdgcn_s_setprio(0); } while (0)
#define PG8_BLK2H(At, B0, B1, buf1, goff1, voff1, buf2, goff2, voff2) do { __builtin_amdgcn_s_setprio(1); PG8_MMQ(1, 0, 0, At, B0); PG8_MMQ(1, 0, 1, At, B0); PG8_ST1(buf1, goff1, voff1, 1); \
        PG8_MMQ(1, 0, 2, At, B0); PG8_MMQ(1, 0, 3, At, B0); PG8_ST1(buf2, goff2, voff2, 0); PG8_MMQ(1, 1, 0, At, B1); PG8_MMQ(1, 1, 1, At, B1); PG8_ST1(buf2, goff2, voff2, 1); \
        PG8_MMQ(1, 1, 2, At, B1); PG8_MMQ(1, 1, 3, At, B1); __builtin_amdgcn_s_setprio(0); } while (0)
#ifndef PG8_DMI
#define PG8_DMI 0
#endif
#define PG8_WAIT_V(n) asm volatile("s_waitcnt vmcnt(" #n ")" ::: "memory")
#define PG8_WAIT_L(n) asm volatile("s_waitcnt lgkmcnt(" #n ")" ::: "memory")
#define PG8_BAR __builtin_amdgcn_s_barrier()
#define PG8_SCHED __builtin_amdgcn_sched_barrier(0)
    Unit cur, nxt; int ui = 0;
    if (!S.next(0, cur)) return;
    f32x4 acc[2][2][4][2];
#pragma unroll
    for (int a = 0; a < 2; ++a)
#pragma unroll
        for (int b = 0; b < 2; ++b)
#pragma unroll
            for (int m = 0; m < 4; ++m)
#pragma unroll
                for (int n = 0; n < 2; ++n) acc[a][b][m][n] = (f32x4){0.f, 0.f, 0.f, 0.f};
    bf16x8 At[4][2], B0[2][2], B1[2][2];
    unsigned cA = (unsigned)((size_t)cur.pm * tstepA), cB = (unsigned)((size_t)cur.pn * tstep);
    S.a_ready(cur);
    if constexpr (Epi::PF) E.pf(cur, wid, lane, lds + 133120);
    if constexpr (SP2) {
        PG8_STAGE(PG8_SB(0, 0), cB, voffB); PG8_STAGE(PG8_SB(0, 1), cB + hstep, voffB); PG8_STAGE(PG8_SA(0, 0), cA, voffA); PG8_STAGE(PG8_SA(0, 1), cA + hstepA, voffA);
        if (wr == 1) PG8_BAR;
        PG8_WAIT_V(2); PG8_BAR;
        PG8_STAGE(PG8_SB(1, 0), cB + kstep, voffB); PG8_STAGE(PG8_SA(1, 0), cA + kstep, voffA); PG8_STAGE(PG8_SB(1, 1), cB + hstep + kstep, voffB);
        PG8_WAIT_V(6); PG8_BAR;
    } else {
        PG8_STAGE(PG8_SB(0, 0), cB, voffB); PG8_STAGE(PG8_SA(0, 0), cA, voffA); PG8_STAGE(PG8_SB(0, 1), cB + hstep, voffB); PG8_STAGE(PG8_SA(0, 1), cA + hstepA, voffA);
        if (wr == 1) PG8_BAR;
        PG8_WAIT_V(4); PG8_BAR;
        PG8_STAGE(PG8_SB(1, 0), cB + kstep, voffB); PG8_STAGE(PG8_SA(1, 0), cA + kstep, voffA); PG8_STAGE(PG8_SB(1, 1), cB + hstep + kstep, voffB);
        PG8_WAIT_V(6); PG8_BAR;
    }
    for (;;) {
        const bool has_next = S.next(ui + 1, nxt);
        const unsigned nA = has_next ? (unsigned)((size_t)nxt.pm * tstepA) : cA, nB = has_next ? (unsigned)((size_t)nxt.pn * tstep) : cB;
        for (int t = 0; t < nt; t += 2) {
            const bool last = (t == nt - 2);
            const unsigned a1 = cA + (unsigned)((t + 1) * kstep);
            const unsigned a2 = last ? nA : cA + (unsigned)((t + 2) * kstep), b2 = last ? nB : cB + (unsigned)((t + 2) * kstep);
            const unsigned a3 = a2 + (unsigned)kstep, b3 = b2 + (unsigned)kstep;
            if (last && has_next) S.a_ready(nxt);
            if constexpr (Epi::MIDK > 0) { if (t == Epi::MIDK) E.midk(acc, cur, wr, wc, lane & 15, lane >> 4); }
            if constexpr (SP2 && PG8_DMI == 2 && MREP == 1) {
            PG8_LDB(B0, 0, 0); PG8_LDB(B1, 0, 1); PG8_SCHED; PG8_LDA(At, 0, 0); PG8_STAGE(PG8_SA(1, 1), a1 + hstepA, voffA);
            PG8_WAIT_V(8); PG8_WAIT_L(0); PG8_BAR; PG8_MMA(0, 0, At, B0); PG8_MMA(0, 1, At, B1); PG8_BAR; PG8_SCHED;
            PG8_LDA(At, 0, 1); PG8_STAGE(PG8_SB(0, 0), b2, voffB); PG8_ST1(PG8_SB(0, 1), b2 + hstep, voffB, 0);
            PG8_WAIT_V(5); PG8_WAIT_L(0); PG8_BAR; PG8_BLK2H(At, B0, B1, PG8_SB(0, 1), b2 + hstep, voffB, PG8_SA(0, 0), a2, voffA); PG8_BAR; PG8_SCHED;
            PG8_LDB(B0, 1, 0); PG8_LDB(B1, 1, 1); PG8_SCHED; PG8_LDA(At, 1, 0); PG8_STAGE(PG8_SA(0, 1), a2 + hstepA, voffA);
            PG8_WAIT_V(8); PG8_WAIT_L(0); PG8_BAR; PG8_MMA(0, 0, At, B0); PG8_MMA(0, 1, At, B1); PG8_BAR; PG8_SCHED;
            PG8_LDA(At, 1, 1); PG8_STAGE(PG8_SB(1, 0), b3, voffB); PG8_ST1(PG8_SB(1, 1), b3 + hstep, voffB, 0);
            PG8_WAIT_V(5); PG8_WAIT_L(0); PG8_BAR; PG8_BLK2H(At, B0, B1, PG8_SB(1, 1), b3 + hstep, voffB, PG8_SA(1, 0), a3, voffA); PG8_BAR; PG8_SCHED;
            } else if constexpr (SP2 && PG8_DMI == 1 && MREP == 1) {
            PG8_LDB(B0, 0, 0); PG8_LDB(B1, 0, 1); PG8_SCHED; PG8_LDA(At, 0, 0);
            PG8_WAIT_V(6); PG8_WAIT_L(0); PG8_BAR; PG8_BLK1(At, B0, B1, PG8_SA(1, 1), a1 + hstepA, voffA); PG8_BAR; PG8_SCHED;
            PG8_LDA(At, 0, 1);
            PG8_WAIT_V(2); PG8_WAIT_L(0); PG8_BAR; PG8_BLK2(At, B0, B1, PG8_SB(0, 0), b2, voffB, PG8_SB(0, 1), b2 + hstep, voffB, PG8_SA(0, 0), a2, voffA); PG8_BAR; PG8_SCHED;
            PG8_LDB(B0, 1, 0); PG8_LDB(B1, 1, 1); PG8_SCHED; PG8_LDA(At, 1, 0);
            PG8_WAIT_V(6); PG8_WAIT_L(0); PG8_BAR; PG8_BLK1(At, B0, B1, PG8_SA(0, 1), a2 + hstepA, voffA); PG8_BAR; PG8_SCHED;
            PG8_LDA(At, 1, 1);
            PG8_WAIT_V(2); PG8_WAIT_L(0); PG8_BAR; PG8_BLK2(At, B0, B1, PG8_SB(1, 0), b3, voffB, PG8_SB(1, 1), b3 + hstep, voffB, PG8_SA(1, 0), a3, voffA); PG8_BAR; PG8_SCHED;
            } else if constexpr (SP2) {
            PG8_LDB(B0, 0, 0); PG8_LDB(B1, 0, 1); PG8_SCHED; PG8_LDA(At, 0, 0); PG8_STAGE(PG8_SA(1, 1), a1 + hstepA, voffA);
            PG8_WAIT_V(8); PG8_WAIT_L(0); PG8_BAR; PG8_MMA(0, 0, At, B0); PG8_MMA(0, 1, At, B1); PG8_BAR; PG8_SCHED;
            PG8_LDA(At, 0, 1); PG8_STAGE(PG8_SB(0, 0), b2, voffB); PG8_STAGE(PG8_SB(0, 1), b2 + hstep, voffB); PG8_STAGE(PG8_SA(0, 0), a2, voffA);
            PG8_WAIT_V(8); PG8_WAIT_L(0); PG8_BAR; PG8_MMA(1, 0, At, B0); PG8_MMA(1, 1, At, B1); PG8_BAR; PG8_SCHED;
            PG8_LDB(B0, 1, 0); PG8_LDB(B1, 1, 1); PG8_SCHED; PG8_LDA(At, 1, 0); PG8_STAGE(PG8_SA(0, 1), a2 + hstepA, voffA);
            PG8_WAIT_V(8); PG8_WAIT_L(0); PG8_BAR; PG8_MMA(0, 0, At, B0); PG8_MMA(0, 1, At, B1); PG8_BAR; PG8_SCHED;
            PG8_LDA(At, 1, 1); PG8_STAGE(PG8_SB(1, 0), b3, voffB); PG8_STAGE(PG8_SB(1, 1), b3 + hstep, voffB); PG8_STAGE(PG8_SA(1, 0), a3, voffA);
            PG8_WAIT_V(8); PG8_WAIT_L(0); PG8_BAR; PG8_MMA(1, 0, At, B0); PG8_MMA(1, 1, At, B1); PG8_BAR; PG8_SCHED;
            } else {
            PG8_LDB(B0, 0, 0); PG8_SCHED; PG8_LDA(At, 0, 0); PG8_STAGE(PG8_SA(1, 1), a1 + hstepA, voffA);
            PG8_WAIT_L(8); PG8_BAR; PG8_WAIT_L(0); PG8_MMA(0, 0, At, B0); PG8_BAR; PG8_SCHED;
            PG8_LDB(B1, 0, 1); PG8_STAGE(PG8_SB(0, 0), b2, voffB);
            PG8_BAR; PG8_WAIT_L(0); PG8_MMA(0, 1, At, B1); PG8_BAR;
            PG8_LDA(At, 0, 1); PG8_STAGE(PG8_SA(0, 0), a2, voffA);
            PG8_BAR; PG8_WAIT_L(0); PG8_MMA(1, 0, At, B0); PG8_BAR; PG8_SCHED;
            PG8_STAGE(PG8_SB(0, 1), b2 + hstep, voffB);
            PG8_WAIT_V(6); PG8_BAR; PG8_MMA(1, 1, At, B1); PG8_BAR;
            PG8_LDB(B0, 1, 0); PG8_SCHED; PG8_LDA(At, 1, 0); PG8_STAGE(PG8_SA(0, 1), a2 + hstepA, voffA);
            PG8_WAIT_L(8); PG8_BAR; PG8_WAIT_L(0); PG8_MMA(0, 0, At, B0); PG8_BAR; PG8_SCHED;
            PG8_LDB(B1, 1, 1); PG8_STAGE(PG8_SB(1, 0), b3, voffB);
            PG8_BAR; PG8_WAIT_L(0); PG8_MMA(0, 1, At, B1); PG8_BAR;
            PG8_LDA(At, 1, 1); PG8_STAGE(PG8_SA(1, 0), a3, voffA);
            PG8_BAR; PG8_WAIT_L(0); PG8_MMA(1, 0, At, B0); PG8_BAR; PG8_SCHED;
            PG8_STAGE(PG8_SB(1, 1), b3 + hstep, voffB);
            PG8_WAIT_V(6); PG8_BAR; PG8_MMA(1, 1, At, B1); PG8_BAR;
            }
        }
        if constexpr (ALIGN_EPI) { if (wr == 0) PG8_BAR; }
        if constexpr (!Epi::AFTER_DRAIN) { const int l2 = lane_now(); if constexpr (Epi::PF) { if (has_next) E.pf(nxt, wid, l2, lds + 133120); } E(acc, cur, wr, wc, l2 & 15, l2 >> 4); S.done(cur); }
        if (!has_next) break;
#pragma unroll
        for (int a = 0; a < 2; ++a)
#pragma unroll
            for (int b = 0; b < 2; ++b)
#pragma unroll
                for (int m = 0; m < 4; ++m)
#pragma unroll
                    for (int n = 0; n < 2; ++n) acc[a][b][m][n] = (f32x4){0.f, 0.f, 0.f, 0.f};
        cur = nxt; cA = nA; cB = nB; ++ui;
        if constexpr (ALIGN_EPI) { if (wr == 1) PG8_BAR; }
    }
    PG8_WAIT_V(0);
    if constexpr (!ALIGN_EPI) { if (wr == 0) PG8_BAR; }
    PG8_BAR;
    if constexpr (Epi::AFTER_DRAIN) { E.fused(acc, cur, wr, wc, fr, fq, lds, wid, lane); S.done(cur); }
#undef PG8_SA
#undef PG8_SB
#undef PG8_STAGE
#undef PG8_LD6
#undef PG8_CV6
#undef PG8_LDA
#undef PG8_LDB
#undef PG8_MMA
#undef PG8_ST1
#undef PG8_MMQ
#undef PG8_BLK1
#undef PG8_BLK2
#undef PG8_BLK2H
#undef PG8_WAIT_V
#undef PG8_WAIT_L
#undef PG8_BAR
#undef PG8_SCHED
}
}
#define LAS __attribute__((address_space(3)))
typedef unsigned short bf16;
typedef unsigned v4u __attribute__((ext_vector_type(4)));
typedef unsigned v2u __attribute__((ext_vector_type(2)));
typedef float f32x4 __attribute__((ext_vector_type(4)));
typedef float f32x2 __attribute__((ext_vector_type(2)));
typedef short bf16x8 __attribute__((ext_vector_type(8)));
using pg8::shx; using pg8::shl;
#define LDS_WAIT() asm volatile("s_waitcnt lgkmcnt(0)" ::: "memory")
__device__ __forceinline__ unsigned f2bf(float f) { unsigned u = __builtin_bit_cast(unsigned, f); return (u + 0x7fffu + ((u >> 16) & 1u)) >> 16; }
__device__ __forceinline__ unsigned pk2(float lo, float hi) { return pg8::cvt_pk_bf16(lo, hi); }
__device__ __forceinline__ float bf_lo(unsigned w) { return __uint_as_float(w << 16); }
__device__ __forceinline__ float bf_hi(unsigned w) { return __uint_as_float(w & 0xffff0000u); }
__device__ __forceinline__ float sigmoid_f(float v) { return __builtin_amdgcn_rcpf(1.0f + __builtin_amdgcn_exp2f(v * -1.4426950408889634f)); }
__device__ __forceinline__ float gelu_tanh(float x) { const float y = 0.7978845608028654f * (x + 0.044715f * x * x * x); const float th = 1.0f - 2.0f * __builtin_amdgcn_rcpf(1.0f + __builtin_amdgcn_exp2f(2.885390081777927f * y)); return 0.5f * x * (1.0f + th); }
#define XB_TMO      128
#define XB_XCNT(j)  (256  + 64 * (j))
#define XB_XSUB(j)  (1280 + 64 * (j))
#define XB_XGEN(j)  (2304 + 64 * (j))
#define XB_TOP      3328
#define XB_TOPGEN   3392
#define XCD_BAR_WORDS 3456
#define XB_SPIN_CAP (1u << 18)

__device__ __forceinline__ unsigned xb_ld(unsigned* p)              { return __hip_atomic_load(p, __ATOMIC_RELAXED, __HIP_MEMORY_SCOPE_AGENT); }
__device__ __forceinline__ unsigned xb_add(unsigned* p, unsigned v) { return __hip_atomic_fetch_add(p, v, __ATOMIC_RELAXED, __HIP_MEMORY_SCOPE_AGENT); }
__device__ __forceinline__ unsigned xb_xcc_id() { return (unsigned)__builtin_amdgcn_s_getreg((3 << 11) | 20) & 0xFu; }
#define XB_SPIN(cond, bar) do { unsigned _sp = 0; while (cond) { __builtin_amdgcn_s_sleep(1); \
    if ((++_sp & 255u) == 0u) { if (xb_ld(&(bar)[XB_TMO])) break; if (_sp > XB_SPIN_CAP) { atomicAdd(&(bar)[XB_TMO], 1u); break; } } } } while (0)

struct XcdBarrier {
    unsigned* bar; unsigned x;
    volatile LAS unsigned* st;
};

__device__ __forceinline__ XcdBarrier xcd_barrier_post(unsigned* bar, volatile LAS unsigned* st) {
    XcdBarrier b; b.bar = bar; b.x = xb_xcc_id(); b.st = st;
    if (threadIdx.x == 0) (void)xb_add(&bar[XB_XCNT(b.x)], 1u);
    return b;
}
__device__ __forceinline__ void xcd_barrier_complete(unsigned* bar, unsigned x, unsigned& nloc, unsigned& nx) {
    const unsigned G = gridDim.x * gridDim.y * gridDim.z;
    unsigned sum, cnt, mine, sp = 0u;
    for (;;) {
        sum = 0u; cnt = 0u; mine = 0u;
#pragma unroll
        for (unsigned j = 0; j < 16; ++j) { const unsigned c = xb_ld(&bar[XB_XCNT(j)]); sum += c; cnt += (c > 0u) ? 1u : 0u; mine = (j == x) ? c : mine; }
        if (sum == G) break;
        __builtin_amdgcn_s_sleep(1);
        if ((++sp & 255u) == 0u) { if (xb_ld(&bar[XB_TMO])) break; if (sp > XB_SPIN_CAP) { atomicAdd(&bar[XB_TMO], 1u); break; } }
    }
    nloc = mine > 0u ? mine : 1u; nx = cnt > 0u ? cnt : 1u;
}

__device__ __forceinline__ void xcd_barrier(const XcdBarrier& b) {
    asm volatile("s_waitcnt vmcnt(0)" ::: "memory");
    __syncthreads();
    if (threadIdx.x == 0) {
        unsigned* bar = b.bar;
        __builtin_amdgcn_s_waitcnt(0);
        unsigned nloc = b.st[0], nx = b.st[1];
        if (nloc == 0u) { xcd_barrier_complete(bar, b.x, nloc, nx); b.st[0] = nloc; b.st[1] = nx; }
        const unsigned old = xb_add(&bar[XB_XSUB(b.x)], 1u);
        const unsigned gen = old / nloc;
        if (old + 1u == (gen + 1u) * nloc) {
            __builtin_amdgcn_fence(__ATOMIC_RELEASE, "agent");
            asm volatile("s_waitcnt vmcnt(0)" ::: "memory");
            const unsigned og = xb_add(&bar[XB_TOP], 1u);
            const unsigned tg = og / nx;
            if (og + 1u == (tg + 1u) * nx) xb_add(&bar[XB_TOPGEN], 1u);
            else XB_SPIN(xb_ld(&bar[XB_TOPGEN]) == tg, bar);
            __builtin_amdgcn_fence(__ATOMIC_ACQUIRE, "agent");
            xb_add(&bar[XB_XGEN(b.x)], 1u);
            asm volatile("s_waitcnt vmcnt(0)" ::: "memory");
        } else {
            XB_SPIN(xb_ld(&bar[XB_XGEN(b.x)]) == gen, bar);
            __builtin_amdgcn_fence(__ATOMIC_ACQUIRE, "agent");
            asm volatile("s_waitcnt vmcnt(0)" ::: "memory");
        }
    }
    __syncthreads();
}

typedef short v4i16_t __attribute__((ext_vector_type(4)));
struct AttTile { int r, dsh, L, pq0, tq0, tq1; };
template <int NT> __device__ __forceinline__ void att_load_qk(const bf16* Z, const AttTile& t, int tok0, int s0, int h, int c, int g, bf16x8 (&Qn)[4], bf16x8 (&Kn)[10][2]) {
    { const unsigned zq = (unsigned)(tok0 + t.tq0) * (unsigned)(NIN * 2) + (unsigned)(ZQ + h * 64 + 8 * g) * 2u; Qn[0] = *(const bf16x8*)((const char*)Z + zq); Qn[1] = *(const bf16x8*)((const char*)Z + (zq + 64u)); }
    if (NT == 2) { const unsigned zq = (unsigned)(tok0 + t.tq1) * (unsigned)(NIN * 2) + (unsigned)(ZQ + h * 64 + 8 * g) * 2u; Qn[2] = *(const bf16x8*)((const char*)Z + zq); Qn[3] = *(const bf16x8*)((const char*)Z + (zq + 64u)); }
    if (t.pq0 >= 64 && t.pq0 + 96 <= t.L) {
        unsigned zk = (unsigned)(s0 + t.r + ((t.pq0 - 64 + c) << t.dsh)) * (unsigned)(NIN * 2) + (unsigned)(ZK + h * 64 + 8 * g) * 2u; const unsigned step = (16u << t.dsh) * (unsigned)(NIN * 2);
#pragma unroll
        for (int kt = 0; kt < 8 + NT; ++kt) { Kn[kt][0] = *(const bf16x8*)((const char*)Z + zk); Kn[kt][1] = *(const bf16x8*)((const char*)Z + (zk + 64u)); zk += step; }
    } else {
        const unsigned lb = (unsigned)(s0 + t.r + (c << t.dsh)) * (unsigned)(NIN * 2) + (unsigned)(ZK + h * 64 + 8 * g) * 2u;
#pragma unroll
        for (int kt = 0; kt < 8 + NT; ++kt) { int pb = t.pq0 - 64 + 16 * kt; pb = pb < 0 ? 0 : (pb > t.L - 16 ? t.L - 16 : pb); pb = __builtin_amdgcn_readfirstlane(pb);
            const unsigned zk = lb + (unsigned)(pb << t.dsh) * (unsigned)(NIN * 2); Kn[kt][0] = *(const bf16x8*)((const char*)Z + zk); Kn[kt][1] = *(const bf16x8*)((const char*)Z + (zk + 64u)); } }
}
template <int NT, int NTN> __device__ __forceinline__ void att_stage(const bf16* Z, const AttTile& t, const AttTile& tn, bool init, int tok0, int s0, int h, int lane_ph, LAS unsigned char* vb, LAS float* Os, LAS float* ms, LAS float* ls,
                                                                      bf16x8 (&Qn)[4], bf16x8 (&Kn)[10][2]) {
    int lane = lane_ph; asm volatile("" : "+v"(lane));
    const int c = lane & 15, g = lane >> 4;
    constexpr float SC = 0.125f * 1.4426950408889634f;
    f32x4 sc[NT][10];
#pragma unroll
    for (int kt = 0; kt < 9; ++kt) {
#pragma unroll
        for (int q = 0; q < NT; ++q) { f32x4 a = {0.f, 0.f, 0.f, 0.f};
            a = __builtin_amdgcn_mfma_f32_16x16x32_bf16(Kn[kt + q][0], Qn[2 * q], a, 0, 0, 0); a = __builtin_amdgcn_mfma_f32_16x16x32_bf16(Kn[kt + q][1], Qn[2 * q + 1], a, 0, 0, 0); sc[q][kt] = a; } }
#pragma unroll
    for (int q = 0; q < NT; ++q) sc[q][9] = (f32x4){-1e30f, -1e30f, -1e30f, -1e30f};
    __builtin_amdgcn_sched_barrier(0);
    v4u vv[5][4];
    if (t.pq0 >= 64 && t.pq0 + 96 <= t.L) {
        unsigned zv = (unsigned)(s0 + t.r + ((t.pq0 - 64 + (lane >> 3)) << t.dsh)) * (unsigned)(NIN * 2) + (unsigned)(ZV + h * 64 + 8 * (lane & 7)) * 2u; const unsigned step = (8u << t.dsh) * (unsigned)(NIN * 2);
#pragma unroll
        for (int s = 0; s < 5; ++s)
#pragma unroll
            for (int i = 0; i < 4; ++i) { vv[s][i] = *(const v4u*)((const char*)Z + zv); zv += step; }
    } else { const unsigned lb = (unsigned)(s0 + t.r + ((lane >> 3) << t.dsh)) * (unsigned)(NIN * 2) + (unsigned)(ZV + h * 64 + 8 * (lane & 7)) * 2u;
#pragma unroll
        for (int s = 0; s < 5; ++s)
#pragma unroll
            for (int i = 0; i < 4; ++i) { int pb = t.pq0 - 64 + 32 * s + 8 * i; pb = pb < 0 ? 0 : (pb > t.L - 8 ? t.L - 8 : pb); pb = __builtin_amdgcn_readfirstlane(pb);
                vv[s][i] = *(const v4u*)((const char*)Z + (lb + (unsigned)(pb << t.dsh) * (unsigned)(NIN * 2))); } }
    float mx[NT], lsum[NT];
#pragma unroll
    for (int q = 0; q < NT; ++q) { const int pq = t.pq0 + 16 * q; float m = -1e30f;
        if (pq >= 64 && pq + 80 <= t.L) {
#pragma unroll
            for (int kt = 0; kt < 9; ++kt)
#pragma unroll
                for (int rr = 0; rr < 4; ++rr) { const int kk = 16 * kt + 4 * g + rr;
                    if (kt == 0) sc[q][kt][rr] = kk >= c ? sc[q][kt][rr] : -1e30f;
                    if (kt == 8) sc[q][kt][rr] = kk <= c + 128 ? sc[q][kt][rr] : -1e30f;
                    m = fmaxf(m, sc[q][kt][rr]); }
        } else {
#pragma unroll
            for (int kt = 0; kt < 9; ++kt) { const int pb = pq - 64 + 16 * kt; const bool tin = __builtin_amdgcn_readfirstlane((int)(pb >= 0 && pb < t.L)) != 0;
#pragma unroll
                for (int rr = 0; rr < 4; ++rr) { const int kk = 16 * kt + 4 * g + rr;
                    if (kt == 0) sc[q][kt][rr] = kk >= c ? sc[q][kt][rr] : -1e30f;
                    if (kt == 8) sc[q][kt][rr] = kk <= c + 128 ? sc[q][kt][rr] : -1e30f;
                    sc[q][kt][rr] = tin ? sc[q][kt][rr] : -1e30f;
                    m = fmaxf(m, sc[q][kt][rr]); } } }
        m = fmaxf(m, shx(m, 16, lane)); m = fmaxf(m, shx(m, 32, lane)); mx[q] = m;
        const float nm = -m * SC; f32x4 l4 = {0.f, 0.f, 0.f, 0.f};
#pragma unroll
        for (int kt = 0; kt < 9; ++kt) { const f32x4 z = sc[q][kt] * SC + nm; f32x4 p4;
#pragma unroll
            for (int rr = 0; rr < 4; ++rr) p4[rr] = __builtin_amdgcn_exp2f(z[rr]);
            sc[q][kt] = p4; l4 = l4 + p4; }
        sc[q][9] = (f32x4){0.f, 0.f, 0.f, 0.f};
        float l = (l4[0] + l4[1]) + (l4[2] + l4[3]);
        l += shx(l, 16, lane); l += shx(l, 32, lane); lsum[q] = l; }
    f32x4 o[NT][4];
#pragma unroll
    for (int q = 0; q < NT; ++q)
#pragma unroll
        for (int dt = 0; dt < 4; ++dt) o[q][dt] = (f32x4){0.f, 0.f, 0.f, 0.f};
#pragma unroll
    for (int s = 0; s < 5; ++s) {
        asm volatile("s_waitcnt lgkmcnt(0)" ::: "memory");
#pragma unroll
        for (int i = 0; i < 4; ++i) *(LAS v4u*)(vb + ((lane >> 3) + 8 * i) * 144 + 16 * (lane & 7)) = vv[s][i];
        asm volatile("s_waitcnt lgkmcnt(0)" ::: "memory");
        if (s == 4 && NTN > 0) att_load_qk<NTN ? NTN : 1>(Z, tn, tok0, s0, h, c, g, Qn, Kn);
        bf16x8 af[4];
#pragma unroll
        for (int dt = 0; dt < 4; ++dt) {
            LAS unsigned char* p0 = vb + (4 * g + (c >> 2)) * 144 + (16 * dt + 4 * (c & 3)) * 2;
            const v4i16_t lo = __builtin_amdgcn_ds_read_tr16_b64_v4i16((LAS v4i16_t*)p0), hi = __builtin_amdgcn_ds_read_tr16_b64_v4i16((LAS v4i16_t*)(p0 + 16 * 144));
            af[dt][0] = lo[0]; af[dt][1] = lo[1]; af[dt][2] = lo[2]; af[dt][3] = lo[3]; af[dt][4] = hi[0]; af[dt][5] = hi[1]; af[dt][6] = hi[2]; af[dt][7] = hi[3]; }
#pragma unroll
        for (int q = 0; q < NT; ++q) {
            union { unsigned u[4]; bf16x8 v; } pf;
            if (q == 1 && s == 0) { pf.u[0] = 0u; pf.u[1] = 0u; } else { pf.u[0] = pg8::cvt_pk_bf16(sc[q][2 * s - q][0], sc[q][2 * s - q][1]); pf.u[1] = pg8::cvt_pk_bf16(sc[q][2 * s - q][2], sc[q][2 * s - q][3]); }
            pf.u[2] = pg8::cvt_pk_bf16(sc[q][2 * s + 1 - q][0], sc[q][2 * s + 1 - q][1]); pf.u[3] = pg8::cvt_pk_bf16(sc[q][2 * s + 1 - q][2], sc[q][2 * s + 1 - q][3]);
#pragma unroll
            for (int dt = 0; dt < 4; ++dt) o[q][dt] = __builtin_amdgcn_mfma_f32_16x16x32_bf16(af[dt], pf.v, o[q][dt], 0, 0, 0); }
    }
#pragma unroll
    for (int q = 0; q < NT; ++q) { const int tq = q ? t.tq1 : t.tq0; LAS float* orow = Os + tq * 68 + 4 * g;
        if (init) {
#pragma unroll
            for (int dt = 0; dt < 4; ++dt) *(LAS f32x4*)(orow + 16 * dt) = o[q][dt];
            if (g == 0) { ms[tq] = mx[q]; ls[tq] = lsum[q]; }
        } else {
            const float m_s = ms[tq], l_s = ls[tq]; const float mn = fmaxf(m_s, mx[q]); const float a = __builtin_amdgcn_exp2f((m_s - mn) * SC), b = __builtin_amdgcn_exp2f((mx[q] - mn) * SC);
#pragma unroll
            for (int dt = 0; dt < 4; ++dt) { const f32x4 os = *(const LAS f32x4*)(orow + 16 * dt); *(LAS f32x4*)(orow + 16 * dt) = os * a + o[q][dt] * b; }
            asm volatile("s_waitcnt lgkmcnt(0)" ::: "memory");
            if (g == 0) { ms[tq] = mn; ls[tq] = l_s * a + lsum[q] * b; }
        } }
}
__device__ __forceinline__ void attn_mfma_phase(LAS unsigned char* lds, bf16* Z, float* ssq, int blk, int G, int tid, int wave, int lane_ph, bf16* dummy = nullptr) {
    LAS float* Os = (LAS float*)lds;
    LAS float* ms = (LAS float*)(lds + 69632);
    LAS float* ls = (LAS float*)(lds + 70656);
    LAS unsigned char* vb = lds + 71680 + wave * 4608;
    const int c = lane_ph & 15, g = lane_ph >> 4;
    for (int unit = blk; unit < (T / 256) * 12; unit += G) {
        const int tb = unit / 12, h = unit % 12;
        const int tok0 = 256 * tb; const int s0 = tok0 < TPR ? (tok0 & ~4095) : TPR; const int S = tok0 < TPR ? 4096 : 16384; const int B0 = tok0 - s0;
        __syncthreads();
        const AttTile t0{0, 0, S, B0 + 32 * wave, 32 * wave + c, 32 * wave + 16 + c};
        const AttTile t1{wave & 3, 2, S >> 2, (B0 >> 2) + 32 * (wave >> 2), (wave & 3) + 128 * (wave >> 2) + 4 * c, (wave & 3) + 128 * (wave >> 2) + 64 + 4 * c};
        const AttTile t2{2 * wave, 4, S >> 4, B0 >> 4, 2 * wave + 16 * c, 0};
        const AttTile t3{2 * wave + 1, 4, S >> 4, B0 >> 4, 2 * wave + 1 + 16 * c, 0};
        bf16x8 Qn[4], Kn[10][2];
        att_load_qk<2>(Z, t0, tok0, s0, h, c, g, Qn, Kn);
        att_stage<2, 2>(Z, t0, t1, true, tok0, s0, h, lane_ph, vb, Os, ms, ls, Qn, Kn);
        __syncthreads();
        att_stage<2, 1>(Z, t1, t2, false, tok0, s0, h, lane_ph, vb, Os, ms, ls, Qn, Kn);
        __syncthreads();
        att_stage<1, 1>(Z, t2, t3, false, tok0, s0, h, lane_ph, vb, Os, ms, ls, Qn, Kn);
        att_stage<1, 0>(Z, t3, t3, false, tok0, s0, h, lane_ph, vb, Os, ms, ls, Qn, Kn);
        __syncthreads();
#pragma unroll
        for (int i = 0; i < 4; ++i) { const int item = tid + 512 * i, tk = item >> 3, ch = item & 7;
            const float inv = __builtin_amdgcn_rcpf(ls[tk]); const f32x4 a = *(const LAS f32x4*)(Os + tk * 68 + 8 * ch), b = *(const LAS f32x4*)(Os + tk * 68 + 8 * ch + 4);
            float v[8] = {a[0] * inv, a[1] * inv, a[2] * inv, a[3] * inv, b[0] * inv, b[1] * inv, b[2] * inv, b[3] * inv};
            float sq = 0.f;
#pragma unroll
            for (int e = 0; e < 8; ++e) sq += v[e] * v[e];
            sq += shx(sq, 1, lane_ph); sq += shx(sq, 2, lane_ph); sq += shx(sq, 4, lane_ph);
            v4u ov; ov.x = pk2(v[0], v[1]); ov.y = pk2(v[2], v[3]); ov.z = pk2(v[4], v[5]); ov.w = pk2(v[6], v[7]);
            if (dummy) *(v4u*)(dummy + (size_t)((tok0 + tk) & 1023) * 768 + h * 64 + 8 * ch) = ov;
            else { *(v4u*)(Z + (size_t)(tok0 + tk) * NIN + ZQ + h * 64 + 8 * ch) = ov;
            if (ch == 0) unsafeAtomicAdd(ssq + tok0 + tk, pg8::qgrid<9>(sq)); } }
    }
    __syncthreads();
}

__device__ __forceinline__ void conv_item(const float* W, int k_lo, int k_n, int Ktot, int ldw, int n0, bf16* WT, int drow0, const float* g, const float* g2, int ksplit, const float* b, float* cs, float* cb, LAS float* scr, int lane, const int f8, const float wsc = 1.0f) {
    float csa[4] = {0.f, 0.f, 0.f, 0.f}, cba[4] = {0.f, 0.f, 0.f, 0.f};
    const int c = lane & 7;
    float pre[32];
    { const float* wp = W + (size_t)(k_lo + (lane >> 5)) * ldw + n0 + (lane & 31);
#pragma unroll
      for (int i = 0; i < 32; ++i) pre[i] = wp[(size_t)(2 * i) * ldw]; }
    for (int k0 = k_lo; k0 < k_lo + k_n; k0 += 64) {
#pragma unroll
        for (int i = 0; i < 32; ++i) scr[(2 * i + (lane >> 5)) * 33 + (lane & 31)] = pre[i];
        LDS_WAIT(); asm volatile("" ::: "memory");
        if (k0 + 64 < k_lo + k_n) { const float* wp = W + (size_t)(k0 + 64 + (lane >> 5)) * ldw + n0 + (lane & 31);
#pragma unroll
            for (int i = 0; i < 32; ++i) pre[i] = wp[(size_t)(2 * i) * ldw]; }
        if (f8 == 3) {
            const int n = lane & 31, kq = k0 + 32 * (lane >> 5); const LAS float* sp = scr + (32 * (lane >> 5)) * 33 + n;
            pg8::f32x16 lo, hi; float sa = 0.f, sb = 0.f;
#pragma unroll
            for (int e4 = 0; e4 < 8; ++e4) { f32x4 g4 = {1.f, 1.f, 1.f, 1.f}, b4 = {0.f, 0.f, 0.f, 0.f};
                if (g) g4 = *(const f32x4*)((kq < ksplit ? g : g2 - ksplit) + kq + 4 * e4);
                if (b) b4 = *(const f32x4*)(b + kq + 4 * e4);
#pragma unroll
                for (int j = 0; j < 4; ++j) { const int e = 4 * e4 + j; const float w = sp[e * 33], wg = w * g4[j]; sa += wg; sb += b4[j] * w; if (e < 16) lo[e] = wg * wsc; else hi[e - 16] = wg * wsc; } }
            pg8::st_frag6((unsigned char*)WT + (size_t)(drow0 + n) * (size_t)(Ktot / 4 * 3) + 96 * (kq >> 7), (kq >> 5) & 3, ((drow0 + n) & 16) ? 2 : 0, lo, hi);
            csa[0] += sa; cba[0] += sb;
            LDS_WAIT(); asm volatile("" ::: "memory"); continue; }
        float gk[8], bk[8];
#pragma unroll
        for (int e = 0; e < 8; ++e) { const int k = k0 + 8 * c + e; gk[e] = g ? (k < ksplit ? g[k] : g2[k - ksplit]) : 1.f; bk[e] = b ? b[k] : 0.f; }
#pragma unroll
        for (int j = 0; j < 4; ++j) { const int n = (lane >> 3) + 8 * j; const LAS float* sp = scr + (8 * c) * 33 + n;
            float w[8], wg[8];
#pragma unroll
            for (int e = 0; e < 8; ++e) { w[e] = sp[e * 33]; wg[e] = w[e] * gk[e]; }
            if (f8 == 1) { v2u o; o.x = pg8::pk4_fp8(wg[0] * pg8::F8_WSC, wg[1] * pg8::F8_WSC, wg[2] * pg8::F8_WSC, wg[3] * pg8::F8_WSC); o.y = pg8::pk4_fp8(wg[4] * pg8::F8_WSC, wg[5] * pg8::F8_WSC, wg[6] * pg8::F8_WSC, wg[7] * pg8::F8_WSC);
                *(v2u*)((unsigned char*)WT + (size_t)(drow0 + n) * Ktot + k0 + 8 * c) = o;
                csa[j] += (((__builtin_amdgcn_cvt_f32_fp8((int)o.x, 0) + __builtin_amdgcn_cvt_f32_fp8((int)o.x, 1)) + (__builtin_amdgcn_cvt_f32_fp8((int)o.x, 2) + __builtin_amdgcn_cvt_f32_fp8((int)o.x, 3)))
                         + ((__builtin_amdgcn_cvt_f32_fp8((int)o.y, 0) + __builtin_amdgcn_cvt_f32_fp8((int)o.y, 1)) + (__builtin_amdgcn_cvt_f32_fp8((int)o.y, 2) + __builtin_amdgcn_cvt_f32_fp8((int)o.y, 3)))) * (1.0f / pg8::F8_WSC); }
            else if (f8 == 2) { v4u o; o.x = pg8::pk_f16(wg[0], wg[1]); o.y = pg8::pk_f16(wg[2], wg[3]); o.z = pg8::pk_f16(wg[4], wg[5]); o.w = pg8::pk_f16(wg[6], wg[7]);
                *(v4u*)(WT + (size_t)(drow0 + n) * Ktot + k0 + 8 * c) = o;
                csa[j] += ((pg8::f16_lo(o.x) + pg8::f16_hi(o.x)) + (pg8::f16_lo(o.y) + pg8::f16_hi(o.y))) + ((pg8::f16_lo(o.z) + pg8::f16_hi(o.z)) + (pg8::f16_lo(o.w) + pg8::f16_hi(o.w))); }
            else {
            v4u o; o.x = pk2(wg[0], wg[1]); o.y = pk2(wg[2], wg[3]); o.z = pk2(wg[4], wg[5]); o.w = pk2(wg[6], wg[7]);
            *(v4u*)(WT + (size_t)(drow0 + n) * Ktot + k0 + 8 * c) = o;
            csa[j] += ((bf_lo(o.x) + bf_hi(o.x)) + (bf_lo(o.y) + bf_hi(o.y))) + ((bf_lo(o.z) + bf_hi(o.z)) + (bf_lo(o.w) + bf_hi(o.w))); }
#pragma unroll
            for (int e = 0; e < 8; ++e) cba[j] += bk[e] * w[e]; }
        LDS_WAIT(); asm volatile("" ::: "memory");
    }
    if (cs && f8 == 3) { float a = csa[0], bb = cba[0]; a += shx(a, 32, lane); bb += shx(bb, 32, lane);
        if (lane < 32) { unsafeAtomicAdd(cs + drow0 + lane, a); unsafeAtomicAdd(cb + drow0 + lane, bb); } }
    else if (cs) {
#pragma unroll
        for (int j = 0; j < 4; ++j) { float a = csa[j], bb = cba[j];
            a += shx(a, 1, lane); a += shx(a, 2, lane); a += shx(a, 4, lane); bb += shx(bb, 1, lane); bb += shx(bb, 2, lane); bb += shx(bb, 4, lane);
            if (c == 0) { unsafeAtomicAdd(cs + drow0 + (lane >> 3) + 8 * j, pg8::qgrid<20>(a)); unsafeAtomicAdd(cb + drow0 + (lane >> 3) + 8 * j, pg8::qgrid<20>(bb)); } }
    }
}
#ifndef PHMASK
#define PHMASK 0xFFFF
#endif
#define PHON(k) ((PHMASK >> (k)) & 1)
__device__ __forceinline__ void convert_layer(CArgs P, int l, LAS unsigned char* lds, int gw, int NGW, int wave, int lane, float* csb_junk = nullptr) {
    LAS float* scr = (LAS float*)(lds + RING_OFF + wave * 16384);
    unsigned char* ws = P->ws;
    float* csb = csb_junk ? csb_junk : (float*)(ws + WS_CSB) + (size_t)l * 6 * 16384;
    constexpr int I_D = 64 * 11, I_GU = 352 * 4, I_IN = 152 * 4, I_OUT = 64 * 4, I_LRU = 160;
    constexpr int NITEMS = 2 * I_D + 2 * I_GU + I_IN + I_OUT + I_LRU;
    for (int it = gw; it < NITEMS; it += NGW) {
        int r = it;
        if (r < 2 * I_D) { const int second = r >= I_D, rr = second ? r - I_D : r, cg = rr / 11, kc = rr % 11;
            conv_item(P->in[second ? 24 : 6] + (size_t)l * FF * D, 512 * kc, 512, FF, D, 32 * cg, (bf16*)(ws + (second ? WS_WD2 : WS_WD1)), 32 * cg, nullptr, nullptr, 0, nullptr, nullptr, nullptr, scr, lane, FFN6_D ? 3 : 1, pg8::F6_WD); continue; } r -= 2 * I_D;
        if (r < I_GU) { const int kc = r & 3, r2 = r >> 2, up = r2 >= 176, rr = up ? r2 - 176 : r2, n0 = 32 * rr, dr = 256 * (n0 >> 7) + (n0 & 127) + 128 * up;
            const float* gg = l ? P->in[20] + (size_t)(l - 1) * D : nullptr; const float* bb = l ? P->in[21] + (size_t)(l - 1) * D : nullptr;
            conv_item(P->in[up ? 5 : 4] + (size_t)l * D * FF, 512 * kc, 512, D, FF, n0, (bf16*)(ws + WS_WGU1), dr, gg, gg, D, bb, csb, csb + 16384, scr, lane, FFN6_GU ? 3 : 1, pg8::F6_WGU); continue; } r -= I_GU;
        if (r < I_GU) { const int kc = r & 3, r2 = r >> 2, up = r2 >= 176, rr = up ? r2 - 176 : r2, n0 = 32 * rr, dr = 256 * (n0 >> 7) + (n0 & 127) + 128 * up;
            conv_item(P->in[up ? 23 : 22] + (size_t)l * D * FF, 512 * kc, 512, D, FF, n0, (bf16*)(ws + WS_WGU2), dr, P->in[7] + (size_t)l * D, P->in[7] + (size_t)l * D, D, P->in[8] + (size_t)l * D, csb + 4 * 16384, csb + 5 * 16384, scr, lane, FFN6_GU ? 3 : 1, pg8::F6_WGU); continue; } r -= I_GU;
        if (r < I_IN) { const int kc = r & 3, n0 = 32 * (r >> 2); int dr;
            if (n0 < 768) dr = n0; else if (n0 < 1536) dr = ZK + (n0 - 768); else if (n0 < 2304) dr = ZV + (n0 - 1536); else if (n0 < 3584) dr = ZXL + (n0 - 2304); else dr = ZGL + (n0 - 3584);
            conv_item(P->in[9] + (size_t)l * D * NIN, 512 * kc, 512, D, NIN, n0, (bf16*)(ws + WS_WIN), dr, P->in[2] + (size_t)l * D, P->in[2] + (size_t)l * D, D, P->in[3] + (size_t)l * D, csb + 2 * 16384, csb + 3 * 16384, scr, lane, 2); continue; } r -= I_IN;
        if (r < I_OUT) { const int kc = r & 3; conv_item(P->in[19] + (size_t)l * D * D, 512 * kc, 512, D, D, 32 * (r >> 2), (bf16*)(ws + WS_WOUT), 32 * (r >> 2), P->in[17] + (size_t)l * AW, P->in[18] + (size_t)l * LW, AW, nullptr, nullptr, nullptr, scr, lane, 0); continue; } r -= I_OUT;
        { const int mat = r >> 2, n0 = 32 * (r & 3), gate = mat / 20, rem = mat % 20;
          conv_item(P->in[gate ? 14 : 12] + ((size_t)l * 20 + rem) * 16384, 0, 128, 128, 128, n0, (bf16*)(ws + WS_LRUW) + (size_t)mat * 16384, n0, nullptr, nullptr, 0, nullptr, nullptr, nullptr, scr, lane, 0); }
    }
}
__device__ __forceinline__ void sincos_d(double r, double& s, double& c) {
    const double r2 = r * r; double ts = r, tc = 1.0; s = r; c = 1.0;
#pragma unroll
    for (int k = 1; k <= 14; ++k) { tc = -tc * r2 / (double)((2 * k - 1) * (2 * k)); ts = -ts * r2 / (double)((2 * k) * (2 * k + 1)); c += tc; s += ts; }
}
__device__ __forceinline__ void prologue(CArgs P, LAS unsigned char* lds, int gtid, int NGT, int gw, int NGW, int wave, int lane, const bool do_conv = true) {
    unsigned char* ws = P->ws;
    { f32x2* st0 = (f32x2*)(ws + WS_ST0); for (int i = gtid; i < T; i += NGT) st0[i] = (f32x2){0.f, 2048.0f * (1.0f - 1e-5f)}; }
    { float* v = (float*)(ws + WS_VEC); for (int i = gtid; i < 4096; i += NGT) v[i] = i < 2048 ? 1.f : 0.f; }
    { f32x2* rp = (f32x2*)(ws + WS_ROPE);
      for (int i = gtid; i < 16384 * 8; i += NGT) { const int pos = i >> 3, fi = i & 7;
          const double invf = fi == 0 ? 1.0 : fi == 1 ? 0.19392274474868576 : fi == 2 ? 0.03760603093086393 : fi == 3 ? 0.007292664737217109 : fi == 4 ? 0.001414213562373095 : fi == 5 ? 0.0002742481756762073 : fi == 6 ? 5.318295896944988e-05 : 1.031338537721246e-05;
          const double ang = (double)pos * invf; const double kq = __builtin_rint(ang * 0.15915494309189535); const double rr = ang - kq * 6.283185307179586;
          double s, c; sincos_d(rr, s, c); rp[i] = (f32x2){(float)c, (float)s}; } }
    { unsigned char* tb = (unsigned char*)(ws + WS_TB8);
#if FFN6_GU
      for (size_t i = (size_t)gtid; i < (size_t)T * D / 32; i += NGT) { const size_t e = i * 32; const float* src = e < (size_t)TPR * D ? P->in[0] + e : P->in[1] + (e - (size_t)TPR * D);
          pg8::f32x16 lo, hi;
#pragma unroll
          for (int j = 0; j < 4; ++j) { const f32x4 a = *(const f32x4*)(src + 4 * j), b2 = *(const f32x4*)(src + 16 + 4 * j);
#pragma unroll
              for (int q = 0; q < 4; ++q) { lo[4 * j + q] = a[q]; hi[4 * j + q] = b2[q]; } }
          const int row = (int)(e >> 11), cc = (int)(e & 2047);
          pg8::st_frag6(tb + (size_t)row * 1536 + 96 * (cc >> 7), (cc >> 5) & 3, (row & 8) ? 2 : 0, lo, hi); } }
#else
      size_t i = (size_t)gtid;
      for (; i + 3 * (size_t)NGT < (size_t)T * D / 8; i += 4 * (size_t)NGT) { f32x4 a[4], b2[4];
#pragma unroll
          for (int q = 0; q < 4; ++q) { const size_t e = (i + (size_t)q * NGT) * 8; const float* src = e < (size_t)TPR * D ? P->in[0] + e : P->in[1] + (e - (size_t)TPR * D); a[q] = *(const f32x4*)src; b2[q] = *(const f32x4*)(src + 4); }
#pragma unroll
          for (int q = 0; q < 4; ++q) { const size_t e = (i + (size_t)q * NGT) * 8; v2u o; o.x = pg8::pk4_fp8(a[q][0], a[q][1], a[q][2], a[q][3]); o.y = pg8::pk4_fp8(b2[q][0], b2[q][1], b2[q][2], b2[q][3]); *(v2u*)(tb + e) = o; } }
      for (; i < (size_t)T * D / 8; i += NGT) { const size_t e = i * 8; const float* src = e < (size_t)TPR * D ? P->in[0] + e : P->in[1] + (e - (size_t)TPR * D);
          const f32x4 a = *(const f32x4*)src, b2 = *(const f32x4*)(src + 4); v2u o; o.x = pg8::pk4_fp8(a[0], a[1], a[2], a[3]); o.y = pg8::pk4_fp8(b2[0], b2[1], b2[2], b2[3]); *(v2u*)(tb + e) = o; } }
#endif
    if (do_conv) convert_layer(P, 0, lds, gw, NGW, wave, lane);
}

__device__ __forceinline__ void attn_valu_phase(LAS unsigned char* lds, bf16* Z, float* ssq, int blk, int G, int wave, int lane) {
    LAS float* sbuf = (LAS float*)lds + wave * 400;
    const int ks = lane >> 3, dp = lane & 7;
    for (int unit = blk; unit < (T / 64) * 12; unit += G) {
        const int tb = unit / 12, h = unit % 12;
        for (int qi = 0; qi < 8; ++qi) {
            const int tok = 64 * tb + 8 * wave + qi;
            const int s0 = tok < TPR ? (tok & ~4095) : TPR, S = tok < TPR ? 4096 : 16384, pos = tok - s0;
            float q8[8];
            { const v4u w = *(const v4u*)(Z + (size_t)tok * NIN + ZQ + h * 64 + 8 * dp);
              q8[0] = bf_lo(w.x) * 0.125f; q8[1] = bf_hi(w.x) * 0.125f; q8[2] = bf_lo(w.y) * 0.125f; q8[3] = bf_hi(w.y) * 0.125f; q8[4] = bf_lo(w.z) * 0.125f; q8[5] = bf_hi(w.z) * 0.125f; q8[6] = bf_lo(w.w) * 0.125f; q8[7] = bf_hi(w.w) * 0.125f; }
            for (int t = 0; t < 49; ++t) {
                const int kk = 8 * t + ks; const int gq = kk >= 258 ? 2 : (kk >= 129 ? 1 : 0); const int j = kk - 129 * gq - 64; const int kp = pos + j * (1 << (2 * gq));
                const bool valid = kk < 387 && kp >= 0 && kp < S; const int row = s0 + (valid ? kp : pos);
                const v4u w = *(const v4u*)(Z + (size_t)row * NIN + ZK + h * 64 + 8 * dp);
                float d = q8[0] * bf_lo(w.x) + q8[1] * bf_hi(w.x) + q8[2] * bf_lo(w.y) + q8[3] * bf_hi(w.y) + q8[4] * bf_lo(w.z) + q8[5] * bf_hi(w.z) + q8[6] * bf_lo(w.w) + q8[7] * bf_hi(w.w);
                d += shx(d, 1, lane); d += shx(d, 2, lane); d += shx(d, 4, lane);
                if (dp == 0) sbuf[kk] = valid ? d : -1e30f;
            }
            LDS_WAIT(); asm volatile("" ::: "memory");
            float sv[7]; float mx = -1e30f;
#pragma unroll
            for (int p = 0; p < 7; ++p) { const int idx = lane + 64 * p; sv[p] = idx < 392 ? sbuf[idx] : -1e30f; mx = fmaxf(mx, sv[p]); }
#pragma unroll
            for (int o = 1; o < 64; o <<= 1) mx = fmaxf(mx, shx(mx, o, lane));
            float sum = 0.f;
#pragma unroll
            for (int p = 0; p < 7; ++p) { const int idx = lane + 64 * p; const float e = sv[p] > -1e29f ? __expf(sv[p] - mx) : 0.f; sum += e; if (idx < 392) sbuf[idx] = e; }
#pragma unroll
            for (int o = 1; o < 64; o <<= 1) sum += shx(sum, o, lane);
            LDS_WAIT(); asm volatile("" ::: "memory");
            float a8[8] = {0.f, 0.f, 0.f, 0.f, 0.f, 0.f, 0.f, 0.f};
            for (int t = 0; t < 49; ++t) {
                const int kk = 8 * t + ks; const int gq = kk >= 258 ? 2 : (kk >= 129 ? 1 : 0); const int j = kk - 129 * gq - 64; const int kp = pos + j * (1 << (2 * gq));
                const bool valid = kk < 387 && kp >= 0 && kp < S; const int row = s0 + (valid ? kp : pos);
                const float p = sbuf[kk];
                const v4u w = *(const v4u*)(Z + (size_t)row * NIN + ZV + h * 64 + 8 * dp);
                a8[0] += p * bf_lo(w.x); a8[1] += p * bf_hi(w.x); a8[2] += p * bf_lo(w.y); a8[3] += p * bf_hi(w.y); a8[4] += p * bf_lo(w.z); a8[5] += p * bf_hi(w.z); a8[6] += p * bf_lo(w.w); a8[7] += p * bf_hi(w.w);
            }
            const float inv = 1.0f / sum; float sq = 0.f;
#pragma unroll
            for (int e = 0; e < 8; ++e) { float v = a8[e]; v += shx(v, 8, lane); v += shx(v, 16, lane); v += shx(v, 32, lane); a8[e] = v * inv; sq += a8[e] * a8[e]; }
            sq += shx(sq, 1, lane); sq += shx(sq, 2, lane); sq += shx(sq, 4, lane);
            if (ks == 0) { v4u o; o.x = pk2(a8[0], a8[1]); o.y = pk2(a8[2], a8[3]); o.z = pk2(a8[4], a8[5]); o.w = pk2(a8[6], a8[7]); *(v4u*)(Z + (size_t)tok * NIN + ZQ + h * 64 + 8 * dp) = o; }
            if (lane == 0) unsafeAtomicAdd(ssq + tok, sq);
            LDS_WAIT(); asm volatile("" ::: "memory");
        }
    }
}

__device__ __forceinline__ float neg_expm1_small(float x) {
    const float ser = -x * (1.0f + x * (0.5f + x * (0.16666667f + x * (0.041666668f + x * (0.0083333338f + x * 0.0013888889f)))));
    return x < -0.25f ? 1.0f - __expf(x) : ser; }
template <int MODE>
__device__ __forceinline__ void lru_phase(LAS unsigned char* lds, int blk, int G, int tid, int lane, int wave, bf16* Z, const bf16* LWT, const float* convw, const float* convb, const float* ba, const float* bx, const float* lam, float* tot, float* ssq) {
    LAS bf16* xcb = (LAS bf16*)lds;
    LAS float* hb = (LAS float*)(lds + 34816);
    const int c = lane & 15, g = lane >> 4, dl = 16 * wave + c;
    constexpr int UPB = NCHUNK * 10 / 256;
    const int u_lo = (G == 256) ? blk * UPB : blk, u_step = (G == 256) ? 1 : G, u_n = (G == 256) ? UPB : (NCHUNK * 10 - blk + G - 1) / G;
    int nb_cur = -1; float sp8[2] = {0.f, 0.f}, bav[2] = {0.f, 0.f}, bxv[2] = {0.f, 0.f}; bf16x8 Bfa[2][4], Bfx[2][4];
#pragma unroll
    for (int d = 0; d < 2; ++d)
#pragma unroll
        for (int ks = 0; ks < 4; ++ks) { Bfa[d][ks] = (bf16x8){0, 0, 0, 0, 0, 0, 0, 0}; Bfx[d][ks] = Bfa[d][ks]; }
    unsigned xw[19];
#define LRU_LOAD_XW(unit_) do { const int nb_ = (unit_) / NCHUNK, pu_ = (unit_) % NCHUNK, ck_ = (pu_ % 3 == 2) ? 256 + pu_ / 3 : 2 * (pu_ / 3) + pu_ % 3, tok0_ = LCH * ck_; const int s0_ = tok0_ < TPR ? (tok0_ & ~4095) : TPR, send_ = tok0_ < TPR ? s0_ + 4096 : T; \
        const int ch_ = 128 * nb_ + 2 * (tid & 63), tg_ = tid >> 6; \
        _Pragma("unroll") for (int i = 0; i < 19; ++i) { const int row_ = tok0_ + 16 * tg_ + i - 2; unsigned w_ = 0u; if (row_ >= s0_ && row_ < send_) w_ = *(const unsigned*)(Z + (size_t)row_ * NIN + ZXL + ch_); xw[i] = w_; } } while (0)
    if (u_n > 0) LRU_LOAD_XW(u_lo);
    for (int ui = 0; ui < u_n; ++ui) {
        const int unit = u_lo + ui * u_step; const int nb = unit / NCHUNK, pu = unit % NCHUNK; const int ck = (pu % 3 == 2) ? 256 + pu / 3 : 2 * (pu / 3) + pu % 3;
        const int tok0 = LCH * ck; const int s0 = tok0 < TPR ? (tok0 & ~4095) : TPR; const int send = tok0 < TPR ? s0 + 4096 : T;
        __syncthreads();
        { const int cp = tid & 63, ch = 128 * nb + 2 * cp, tg = tid >> 6;
          float w0[4], w1[4];
#pragma unroll
          for (int j = 0; j < 4; ++j) { w0[j] = convw[j * LW + ch]; w1[j] = convw[j * LW + ch + 1]; }
          const float b0 = convb[ch], b1 = convb[ch + 1];
          float x0[19], x1[19];
#pragma unroll
          for (int i = 0; i < 19; ++i) { x0[i] = bf_lo(xw[i]); x1[i] = bf_hi(xw[i]); }
#pragma unroll
          for (int i = 0; i < 16; ++i) { const float a0 = ((x0[i] * w0[0] + x0[i + 1] * w0[1]) + (x0[i + 2] * w0[2] + x0[i + 3] * w0[3])) + b0, a1 = ((x1[i] * w1[0] + x1[i + 1] * w1[1]) + (x1[i + 2] * w1[2] + x1[i + 3] * w1[3])) + b1;
              *(LAS unsigned*)(xcb + (16 * tg + i) * 136 + 2 * cp) = pk2(a0, a1); } }
        if (nb != nb_cur) { nb_cur = nb; const int ch = 128 * nb + dl;
#pragma unroll
            for (int d = 0; d < 2; ++d) { sp8[d] = 8.0f * 1.4426950408889634f * log1pf(expf(-lam[d * LW + ch])); bav[d] = ba[d * LW + ch]; bxv[d] = bx[d * LW + ch];
                const bf16* wa = LWT + ((size_t)((0 * 2 + d) * 10 + nb) * 128 + dl) * 128; const bf16* wx = LWT + ((size_t)((1 * 2 + d) * 10 + nb) * 128 + dl) * 128;
#pragma unroll
                for (int ks = 0; ks < 4; ++ks) { Bfa[d][ks] = *(const bf16x8*)(wa + 32 * ks + 8 * g); Bfx[d][ks] = *(const bf16x8*)(wx + 32 * ks + 8 * g); } } }
        float C[2] = {0.f, 0.f};
        if (MODE == 1) {
            const int cfirst = s0 / LCH, clast = send / LCH - 1; const int ch = 128 * nb + dl;
#pragma unroll
            for (int d = 0; d < 2; ++d) { const int n = d ? (clast - ck) : (ck - cfirst); const int q = (n + 3) >> 2, i0 = g * q, i1 = (i0 + q) < n ? (i0 + q) : n; float FA = 1.f, FH = 0.f;
                for (int i = i0; i < i1; i += 8) { f32x2 v[8];
#pragma unroll
                    for (int e = 0; e < 8; ++e) { const int ii = (i + e) < i1 ? (i + e) : (i1 - 1); const int kc = d ? clast - ii : cfirst + ii; v[e] = *(const f32x2*)(tot + (((size_t)kc * 2 + d) * LW + ch) * 2); }
#pragma unroll
                    for (int e = 0; e < 8; ++e) if ((i + e) < i1) { FH = v[e].x * FH + v[e].y; FA = v[e].x * FA; } }
                float Cc = 0.f;
#pragma unroll
                for (int gg = 0; gg < 4; ++gg) { const float A_g = shl(FA, c + 16 * gg), H_g = shl(FH, c + 16 * gg); Cc = A_g * Cc + H_g; }
                C[d] = Cc; }
        }
        __syncthreads();
        if (ui + 1 < u_n) LRU_LOAD_XW(u_lo + (ui + 1) * u_step);
        v4u gwp[4];
        if (MODE == 1) {
#pragma unroll
            for (int i = 0; i < 4; ++i) { const int itx = tid + 512 * i, tt = itx >> 4, cg = itx & 15; gwp[i] = *(const v4u*)(Z + (size_t)(tok0 + tt) * NIN + ZGL + 128 * nb + 8 * cg); } }
#pragma unroll
        for (int d = 0; d < 2; ++d) {
            float Cd = C[d], Atot = 1.f;
            f32x4 aaN, axN;
#define LRU_GATES(mt_, aa_, ax_) do { bf16x8 Af_[4]; _Pragma("unroll") for (int ks = 0; ks < 4; ++ks) Af_[ks] = *(const LAS bf16x8*)(xcb + (16 * (mt_) + c) * 136 + 32 * ks + 8 * g); \
                aa_ = (f32x4){0.f, 0.f, 0.f, 0.f}; ax_ = (f32x4){0.f, 0.f, 0.f, 0.f}; \
                _Pragma("unroll") for (int ks = 0; ks < 4; ++ks) { aa_ = __builtin_amdgcn_mfma_f32_16x16x32_bf16(Af_[ks], Bfa[d][ks], aa_, 0, 0, 0); ax_ = __builtin_amdgcn_mfma_f32_16x16x32_bf16(Af_[ks], Bfx[d][ks], ax_, 0, 0, 0); } } while (0)
            LRU_GATES(d ? (LCH / 16 - 1) : 0, aaN, axN);
#pragma unroll 2
            for (int it = 0; it < LCH / 16; ++it) { const int mt = d ? (LCH / 16 - 1 - it) : it;
                const f32x4 aa = aaN, ax = axN;
                if (it + 1 < LCH / 16) { const int mtn = d ? (LCH / 16 - 2 - it) : it + 1; LRU_GATES(mtn, aaN, axN); }
                float av[4], uv[4];
#pragma unroll
                for (int jp = 0; jp < 2; ++jp) {
                    constexpr float NL2E = -1.4426950408889634f;
                    const f32x2 za = (f32x2){aa[2 * jp], aa[2 * jp + 1]} * NL2E + NL2E * bav[d], zx = (f32x2){ax[2 * jp], ax[2 * jp + 1]} * NL2E + NL2E * bxv[d];
                    const f32x2 da = (f32x2){__builtin_amdgcn_exp2f(za.x), __builtin_amdgcn_exp2f(za.y)} + 1.0f, dx = (f32x2){__builtin_amdgcn_exp2f(zx.x), __builtin_amdgcn_exp2f(zx.y)} + 1.0f;
                    const f32x2 r = {__builtin_amdgcn_rcpf(da.x), __builtin_amdgcn_rcpf(da.y)}, ig = {__builtin_amdgcn_rcpf(dx.x), __builtin_amdgcn_rcpf(dx.y)};
                    const f32x2 la2 = r * (-sp8[d]);
                    const f32x2 a2 = {__builtin_amdgcn_exp2f(la2.x), __builtin_amdgcn_exp2f(la2.y)};
                    const f32x2 om = (f32x2){1.0f, 1.0f} - a2 * a2;
                    const int tl = 16 * mt + 4 * g + 2 * jp;
                    const f32x2 xv = {__uint_as_float((unsigned)xcb[tl * 136 + dl] << 16), __uint_as_float((unsigned)xcb[(tl + 1) * 136 + dl] << 16)};
                    const f32x2 u2 = (f32x2){__builtin_amdgcn_sqrtf(om.x), __builtin_amdgcn_sqrtf(om.y)} * (ig * xv);
                    av[2 * jp] = a2.x; av[2 * jp + 1] = a2.y; uv[2 * jp] = u2.x; uv[2 * jp + 1] = u2.y; }
                float Pp = 1.f, Hh = 0.f, pj[4], hj[4];
#pragma unroll
                for (int jj = 0; jj < 4; ++jj) { const int j = d ? 3 - jj : jj; Hh = av[j] * Hh + uv[j]; Pp *= av[j]; pj[j] = Pp; hj[j] = Hh; }
                float tA = Pp, tH = Hh, eA = 1.f, eH = 0.f;
#pragma unroll
                for (int dim = 0; dim < 2; ++dim) { float aA = tA, bA = tA, aH = tH, bH = tH;
                    if (dim == 0) { pg8::swap16(aA, bA); pg8::swap16(aH, bH); } else { pg8::swap32(aA, bA); pg8::swap32(aH, bH); }
                    const float loA = d ? bA : aA, loH = d ? bH : aH, hiA = d ? aA : bA, hiH = d ? aH : bH;
                    const bool later = (((g >> dim) & 1) != 0) != (d != 0);
                    const float LA = later ? loA : 1.f, LH = later ? loH : 0.f;
                    eH = eA * LH + eH; eA = eA * LA;
                    tH = hiA * loH + hiH; tA = loA * hiA; }
                const float Xin = eA * Cd + eH;
                if (MODE == 0) Atot *= tA;
                Cd = tA * Cd + tH;
                if (MODE == 1) {
#pragma unroll
                    for (int j = 0; j < 4; ++j) { LAS float* hp = hb + (16 * mt + 4 * g + j) * 132 + dl; const float hv = pj[j] * Xin + hj[j]; if (d == 0) *hp = hv; else *hp = *hp + hv; } }
            }
            if (MODE == 0) { if (g == 0) *(f32x2*)(tot + (((size_t)ck * 2 + d) * LW + 128 * nb + dl) * 2) = (f32x2){Atot, Cd}; }
        }
        if (MODE == 1) {
            __syncthreads();
#pragma unroll
            for (int i = 0; i < 4; ++i) { const int itx = tid + 512 * i, tt = itx >> 4, cg = itx & 15;
                const f32x4 f0 = *(const LAS f32x4*)(hb + tt * 132 + 8 * cg), f1 = *(const LAS f32x4*)(hb + tt * 132 + 8 * cg + 4);
                bf16* gp = Z + (size_t)(tok0 + tt) * NIN + ZGL + 128 * nb + 8 * cg; const v4u gw = gwp[i];
                float rv[8];
                rv[0] = f0[0] * gelu_tanh(bf_lo(gw.x)); rv[1] = f0[1] * gelu_tanh(bf_hi(gw.x)); rv[2] = f0[2] * gelu_tanh(bf_lo(gw.y)); rv[3] = f0[3] * gelu_tanh(bf_hi(gw.y));
                rv[4] = f1[0] * gelu_tanh(bf_lo(gw.z)); rv[5] = f1[1] * gelu_tanh(bf_hi(gw.z)); rv[6] = f1[2] * gelu_tanh(bf_lo(gw.w)); rv[7] = f1[3] * gelu_tanh(bf_hi(gw.w));
                float sq = 0.f;
#pragma unroll
                for (int e = 0; e < 8; ++e) sq += rv[e] * rv[e];
                sq += shx(sq, 1, lane); sq += shx(sq, 2, lane); sq += shx(sq, 4, lane); sq += shx(sq, 8, lane);
                v4u o; o.x = pk2(rv[0], rv[1]); o.y = pk2(rv[2], rv[3]); o.z = pk2(rv[4], rv[5]); o.w = pk2(rv[6], rv[7]); *(v4u*)gp = o;
                if (cg == 0) unsafeAtomicAdd(ssq + tok0 + tt, pg8::qgrid<6>(sq)); }
        }
    }
#undef LRU_LOAD_XW
#undef LRU_GATES
    __syncthreads();
}

__device__ __forceinline__ void rmsnorm_phase(bf16* Z, const float* ssq_att, const float* ssq_rec, int gw, int NGW, int lane) {
    for (int r = gw; r < T; r += NGW) {
        const float ra = rsqrtf(ssq_att[r] * (1.0f / AW) + 1e-5f), rr = rsqrtf(ssq_rec[r] * (1.0f / LW) + 1e-5f);
#pragma unroll
        for (int i = 0; i < 4; ++i) { const int col = 8 * (lane + 64 * i); const float sc = col < AW ? ra : rr; bf16* p = Z + (size_t)r * NIN + col; const v4u w = *(const v4u*)p;
            v4u o; o.x = pk2(bf_lo(w.x) * sc, bf_hi(w.x) * sc); o.y = pk2(bf_lo(w.y) * sc, bf_hi(w.y) * sc); o.z = pk2(bf_lo(w.z) * sc, bf_hi(w.z) * sc); o.w = pk2(bf_lo(w.w) * sc, bf_hi(w.w) * sc); *(v4u*)p = o; }
    }
}
__device__ __forceinline__ void final_ln_phase(float* out, const unsigned char* res, const float* st, const float* g, const float* b, int gw, int NGW, int lane, const float* tpv) {
    for (int r0 = gw; r0 < T; r0 += 2 * NGW) {
      v4u wv[2][4]; f32x2 sv2[2];
#pragma unroll
      for (int h = 0; h < 2; ++h) { const int r = r0 + h * NGW; if (r < T) { sv2[h] = *(const f32x2*)(st + 2 * (size_t)r);
#pragma unroll
          for (int i = 0; i < 4; ++i) wv[h][i] = __builtin_nontemporal_load((const v4u*)(res + ((size_t)r * D + 8 * (lane + 64 * i)) * 2)); } }
#pragma unroll
      for (int h = 0; h < 2; ++h) { const int r = r0 + h * NGW; if (r >= T) break;
        const f32x2 s = sv2[h]; const float mu = s.x * (1.0f / 2048.0f); const float rstd = rsqrtf(fmaxf(s.y * (1.0f / 2048.0f) - mu * mu, 0.f) + 1e-5f);
#pragma unroll
        for (int i = 0; i < 4; ++i) { const int col = 8 * (lane + 64 * i); const v4u w = wv[h][i]; float* p = out + (size_t)r * D + col;
            const f32x4 t0 = {pg8::f16_lo(w.x), pg8::f16_hi(w.x), pg8::f16_lo(w.y), pg8::f16_hi(w.y)}, t1 = {pg8::f16_lo(w.z), pg8::f16_hi(w.z), pg8::f16_lo(w.w), pg8::f16_hi(w.w)};
            f32x4 y0 = (t0 - mu) * rstd * *(const f32x4*)(g + col) + *(const f32x4*)(b + col), y1 = (t1 - mu) * rstd * *(const f32x4*)(g + col + 4) + *(const f32x4*)(b + col + 4);
#if defined(TPROBE)
            y0 = y0 * (1.0f + tpv[0]); y1 = y1 * (1.0f + tpv[0]);
#endif
            __builtin_nontemporal_store(y0, (f32x4*)p); __builtin_nontemporal_store(y1, (f32x4*)(p + 4)); }
      }
    }
}

#ifndef STAGGER_DOWN
#define STAGGER_DOWN 0
#endif
#ifndef STAGGER_OUT
#define STAGGER_OUT 0
#endif
__device__ __forceinline__ void stagger_start(int blk, unsigned ticks_per_group) {
    const unsigned long long t0 = __builtin_amdgcn_s_memrealtime(); const unsigned long long wait = (unsigned long long)(blk & 3) * ticks_per_group;
    while (__builtin_amdgcn_s_memrealtime() - t0 < wait) __builtin_amdgcn_s_sleep(16);
}
#ifndef FUSE_FIN
#define FUSE_FIN 0
#endif
#ifndef MK_N_LAUNCHES
#define MK_N_LAUNCHES 1
#endif
#if defined(XDUP) && (XDUP < 3 || XDUP == 6 || XDUP == 7 || XDUP == 8 || XDUP == 10 || XDUP == 11 || XDUP == 12 || (XDUP >= 13 && XDUP <= 19))
constexpr int N_PHASES_C = 1 + 9 + 1 + 9 + 1 + (XDUP == 19 ? 6 : 0);
#else
constexpr int N_PHASES_C = 1 + 8 + 1 + 8 + (FUSE_FIN ? 0 : 1);
#endif
__global__ void __launch_bounds__(NWAVES * 64, 2) enc_fwd(Args args) {
    __builtin_amdgcn_s_setreg(1473, 1);
    extern __shared__ __attribute__((aligned(16))) unsigned char lds_raw[];
    LAS unsigned char* lds = (LAS unsigned char*)lds_raw;
    volatile LAS unsigned* MISC = (volatile LAS unsigned*)(lds + MISC_OFF);
    const int tid = threadIdx.x, lane = tid & 63, wave = __builtin_amdgcn_readfirstlane(tid >> 6);
    const int G = gridDim.x, blk = blockIdx.x;
    (void)lane; (void)wave;
    GAS unsigned char* ws = (GAS unsigned char*)args.ws;
    for (int u = tid; u < (LDS_BYTES - LDSCTL_OFF) / 4; u += NWAVES * 64) ((LAS unsigned*)(lds + LDSCTL_OFF))[u] = 0u;
    __syncthreads();
    unsigned bar_x; { const XcdBarrier b0 = xcd_barrier_post((unsigned*)(args.ws + WS_CTL) + CW_BAR, MISC + 8); bar_x = b0.x; }
#define GRID_BAR() do { unsigned xx_ = bar_x; asm volatile("" : "+s"(xx_)); XcdBarrier b_; b_.bar = (unsigned*)(ws + WS_CTL) + CW_BAR; b_.x = xx_; b_.st = MISC + 8; xcd_barrier(b_); } while (0)
    int ph = 0;
    const int lo = args.ph_lo, hi = args.ph_hi; (void)lo; (void)hi;
#if defined(TPROBE)
    unsigned long long tp_acc0 = 0, tp_acc1 = 0, tp_all = 0, tp_t0 = 0, tp_c0 = 0; int tp_cls = 2;
#if TPROBE == 1
#define TP_BEGIN(k) tp_cls = ((k) == 1 || (k) == 2 || (k) == 3 || (k) == 8) ? 0 : (((k) == 4 || (k) == 6) ? 1 : 2); tp_t0 = __builtin_amdgcn_s_memrealtime();
#define TP_MID()
#elif TPROBE == 3
#define TP_BEGIN(k) tp_cls = ((k) == 1 || (k) == 2) ? 0 : (((k) == 3 || (k) == 8) ? 1 : 2); tp_t0 = __builtin_amdgcn_s_memrealtime();
#define TP_MID()
#elif TPROBE == 5
#define TP_BEGIN(k) tp_cls = ((k) == 1) ? 0 : 2; tp_t0 = __builtin_amdgcn_s_memrealtime(); tp_c0 = __builtin_amdgcn_s_memtime();
#define TP_MID()
#elif TPROBE == 4
#define TP_BEGIN(k) tp_cls = ((k) == 1) ? 0 : (((k) == 0 || (k) == 9) ? 1 : 2); tp_t0 = __builtin_amdgcn_s_memrealtime();
#define TP_MID()
#else
#define TP_BEGIN(k) tp_cls = ((k) == 4) ? 0 : (((k) == 6) ? 1 : 2); tp_t0 = __builtin_amdgcn_s_memrealtime();
#define TP_MID() { __syncthreads(); const unsigned long long n_ = __builtin_amdgcn_s_memrealtime(); tp_all += n_ - tp_t0; tp_acc0 += n_ - tp_t0; tp_t0 = n_; tp_cls = 2; }
#endif
#if TPROBE == 5
#define TP_END() { const unsigned long long d_ = __builtin_amdgcn_s_memrealtime() - tp_t0, dc_ = __builtin_amdgcn_s_memtime() - tp_c0; if (tp_cls == 0) { tp_acc0 += d_; tp_acc1 += dc_; } \
        if (blk == 0 && tid == 0) { float* tpw = (float*)(args.ws + WS_VEC + 32768); const float ghz = 0.1f * (float)tp_acc1 / (float)(tp_acc0 ? tp_acc0 : 1); tpw[0] = 0.01f * floorf(ghz * 10.0f + 0.5f); tpw[1] = 0.0f; } }
#else
#define TP_END() { const unsigned long long d_ = __builtin_amdgcn_s_memrealtime() - tp_t0; tp_all += d_; if (tp_cls == 0) tp_acc0 += d_; if (tp_cls == 1) tp_acc1 += d_; \
        if (blk == 0 && tid == 0) { float* tpw = (float*)(args.ws + WS_VEC + 32768); tpw[0] = 0.02f + 0.08f * (floorf(40.0f * (float)tp_acc0 / (float)tp_all + 0.5f) / 40.0f); tpw[1] = 2.0f + 8.0f * (floorf(40.0f * (float)tp_acc1 / (float)tp_all + 0.5f) / 40.0f);     } }
#endif
#else
#define TP_BEGIN(k)
#define TP_END()
#define TP_MID()
#endif
#if MK_N_LAUNCHES == 1
#define PH_IN_RANGE true
#define PH_BAR_AFTER (ph + 1 < N_PHASES_C)
#else
#define PH_IN_RANGE (ph >= lo && ph < hi)
#define PH_BAR_AFTER (ph + 1 < hi)
#endif
#define PHASE_BEGIN(k) if (PH_IN_RANGE) { TP_BEGIN(k) if (PHON(k)) { int tidx = wave * 64 + pg8::lane_now(), blkx = blk, Gx = G; CArgs P = (CArgs)__builtin_amdgcn_kernarg_segment_ptr(); asm volatile("" : "+s"(ws), "+s"(outg), "+v"(tidx), "+s"(blkx), "+s"(Gx), "+s"(P)); const int NGW = Gx * NWAVES, NGT = Gx * NWAVES * 64; (void)NGW; (void)NGT; const int lanex = tidx & 63, wavex = __builtin_amdgcn_readfirstlane(tidx >> 6), gwx = blkx * NWAVES + wavex, gtidx = blkx * (NWAVES * 64) + tidx; (void)lanex; (void)gwx; (void)gtidx;
#define PHASE_END   } if (PH_BAR_AFTER) { TP_END() GRID_BAR(); } } ++ph;

    GAS float* outg = (GAS float*)args.out;
#define out ((float*)outg)

#if defined(XDUP) && XDUP == 19
    PHASE_BEGIN(0) PHASE_END PHASE_BEGIN(0) PHASE_END PHASE_BEGIN(0) PHASE_END PHASE_BEGIN(0) PHASE_END PHASE_BEGIN(0) PHASE_END PHASE_BEGIN(0) PHASE_END PHASE_BEGIN(0) PHASE_END PHASE_BEGIN(0) PHASE_END
#endif
#if defined(XDUP) && XDUP == 18
    PHASE_BEGIN(0) prologue(P, lds, gtidx, NGT, gwx, NGW, wavex, lanex, false); PHASE_END
#endif
    PHASE_BEGIN(0) prologue(P, lds, gtidx, NGT, gwx, NGW, wavex, lanex); PHASE_END

    { constexpr int l = 0;
    {
#define TB ((bf16*)(ws + WS_TB))
#define HB ((bf16*)(ws + WS_BIG))
#define Z ((bf16*)(ws + WS_BIG))
#define csb ((float*)(ws + WS_CSB) + (size_t)l * 6 * 16384)
#define ones ((const float*)(ws + WS_VEC))
#define zeros (ones + 2048)
#define st_prev (l ? (const float*)(ws + WS_ST + 2 * STAT_BYTES) : (const float*)(ws + WS_ST0))
#define g_prev (l ? P->in[20] : ones)
#define b_prev (l ? P->in[21] : zeros)
#define st1 ((float*)(ws + WS_ST + (size_t)(3 * l + 0) * STAT_BYTES))
#define st2 ((float*)(ws + WS_ST + (size_t)(3 * l + 1) * STAT_BYTES))
#define st3 ((float*)(ws + WS_ST + (size_t)(3 * l + 2) * STAT_BYTES))
#ifndef F8TO6
#define F8TO6 0
#endif
#if FFN6_D
#define GU_EPI pg8::EpiGU6
#ifndef F6_FIX
#define F6_FIX 1.0f
#endif
#define DOWN_SC (0.5f / (pg8::F6_WD * pg8::F6_HSC) * F6_FIX)
#else
#define GU_EPI pg8::EpiGU
#define DOWN_SC (0.5f / (pg8::F8_WSC * pg8::F8_HSC) * (F8TO6 ? 8.0f : 1.0f))
#endif
#ifndef WGM_GU
#define WGM_GU PG8_WGM
#endif
#ifndef WGM_D
#define WGM_D PG8_WGM
#endif
#ifndef WGM_IN
#define WGM_IN PG8_WGM
#endif
#ifndef WGM_OUT
#define WGM_OUT PG8_WGM
#endif
#define ssq_att ((float*)(ws + WS_SSQ + (size_t)(2 * l) * SSQ_BYTES))
#define ssq_rec ((float*)(ws + WS_SSQ + (size_t)(2 * l + 1) * SSQ_BYTES))
        PHASE_BEGIN(1) { pg8::Gemm gm{(const bf16*)(ws + WS_TB8), (const bf16*)(ws + WS_WGU1), T, 2 * FF, D / 2, D / 2}; pg8::StaticOrder S; S.init(T, 2 * FF, Gx, blkx);
            pg8::EpiGU E{(unsigned char*)HB, st_prev, csb, csb + 16384};
            pg8::gemm_phase<pg8::EpiGU, pg8::StaticOrder, PG8_ALIGN, PG8_SP2, true>(lds + RING_OFF, gm, S, E, tidx); } PHASE_END
#if defined(XDUP) && XDUP == 11
        PHASE_BEGIN(1) { pg8::Gemm gm{(const bf16*)(ws + WS_TB8), (const bf16*)(ws + WS_WGU1), T, 2 * FF, D / 2, D / 2}; pg8::FixedOrder S; S.init(T, 2 * FF, Gx, blkx);
            pg8::EpiNull E{(float*)(ws + WS_VEC + 65536)};
            pg8::gemm_phase<pg8::EpiNull, pg8::FixedOrder, PG8_ALIGN, PG8_SP2, true, false, 2>(lds + RING_OFF, gm, S, E, tidx); } PHASE_END
#endif
#if defined(XDUP) && XDUP >= 13 && XDUP <= 16
        PHASE_BEGIN(1) { pg8::Gemm gm{(const bf16*)(ws + WS_TB8), (const bf16*)(ws + WS_WGU1), T, 2 * FF, D / 2, D / 2}; pg8::StaticOrder S; S.init(T, 2 * FF, Gx, blkx);
            pg8::EpiNull E{(float*)(ws + WS_VEC + 65536)};
            pg8::gemm_phase<pg8::EpiNull, pg8::StaticOrder, PG8_ALIGN, PG8_SP2, true, false, 1, false, false, XDUP - 13>(lds + RING_OFF, gm, S, E, tidx); } PHASE_END
#endif
#if defined(XDUP) && XDUP == 12
        PHASE_BEGIN(1) { pg8::Gemm gm{(const bf16*)(ws + WS_TB8), (const bf16*)(ws + WS_WGU1), T, 2 * FF, D / 2, D / 2}; pg8::StaticOrder S; S.init(T, 2 * FF, Gx, blkx);
            pg8::EpiNull E{(float*)(ws + WS_VEC + 65536)};
            pg8::gemm_phase<pg8::EpiNull, pg8::StaticOrder, PG8_ALIGN, PG8_SP2, false, false, 1, true>(lds + RING_OFF, gm, S, E, tidx); } PHASE_END
#endif
#if defined(XDUP) && XDUP == 9
        for (int xb = 0; xb < 10; ++xb) { GRID_BAR(); }
#endif
#if defined(XDUP) && XDUP == 10
        PHASE_BEGIN(1) { pg8::Gemm gm{(const bf16*)(ws + WS_TB8), (const bf16*)(ws + WS_WGU1), T, 2 * FF, D / 2, D / 2}; pg8::FixedOrder S; S.init(T, 2 * FF, Gx, blkx);
            pg8::EpiNull E{(float*)(ws + WS_VEC + 65536)};
            pg8::gemm_phase<pg8::EpiNull, pg8::FixedOrder, PG8_ALIGN, PG8_SP2, true>(lds + RING_OFF, gm, S, E, tidx); } PHASE_END
#endif
#if defined(XDUP) && XDUP == 1
        PHASE_BEGIN(1) { pg8::Gemm gm{(const bf16*)(ws + WS_TB8), (const bf16*)(ws + WS_WGU1), T, 2 * FF, D / 2, D / 2}; pg8::StaticOrder S; S.init(T, 2 * FF, Gx, blkx);
            pg8::EpiNull E{(float*)(ws + WS_VEC + 65536)};
            pg8::gemm_phase<pg8::EpiNull, pg8::StaticOrder, PG8_ALIGN, PG8_SP2, true>(lds + RING_OFF, gm, S, E, tidx); } PHASE_END
#elif defined(XDUP) && XDUP == 2
        PHASE_BEGIN(1) { pg8::Gemm gm{(const bf16*)(ws + WS_TB8), (const bf16*)(ws + WS_WGU1), T, 2 * FF, D / 2, D / 2}; pg8::StaticOrder S; S.init(T, 2 * FF, Gx, blkx, WGM_GU);
            GU_EPI E{(unsigned char*)HB, st_prev, csb, csb + 16384};
            pg8::gemm_phase<GU_EPI, pg8::StaticOrder, PG8_ALIGN, PG8_SP2, !FFN6_GU, false, 1, FFN6_GU>(lds + RING_OFF, gm, S, E, tidx); } PHASE_END
#endif
        PHASE_BEGIN(2) { if (STAGGER_DOWN) stagger_start(blkx, STAGGER_DOWN); pg8::Gemm gm{HB, (const bf16*)(ws + WS_WD1), T, D, FF / 2, FF / 2}; pg8::StaticOrder S; S.init(T, D, Gx, blkx, WGM_D);
            pg8::EpiRes<false> E{P, ws, l == 0, (unsigned)(l ? WS_ST + 2 * STAT_BYTES : WS_ST0), (unsigned)(WS_ST + (size_t)(3 * l + 0) * STAT_BYTES), l ? 20 : -1, 21, 0, DOWN_SC, 0u};
            pg8::gemm_phase<pg8::EpiRes<false>, pg8::StaticOrder, PG8_ALIGN, PG8_SP2, !FFN6_D, false, 1, FFN6_D, F8TO6>(lds + RING_OFF, gm, S, E, tidx); } PHASE_END
        PHASE_BEGIN(3) { pg8::Gemm gm{TB, (const bf16*)(ws + WS_WIN), T, NIN, D, D}; pg8::StaticOrder S; S.init(T, NIN, Gx, blkx, WGM_IN);
            pg8::EpiIn E{Z, st1, csb + 2 * 16384, csb + 3 * 16384, (const float*)(ws + WS_ROPE)};
            pg8::gemm_phase<pg8::EpiIn, pg8::StaticOrder, PG8_ALIGN, PG8_SP2, false, true>(lds + RING_OFF, gm, S, E, tidx); } PHASE_END
#if defined(XDUP) && XDUP == 7
        PHASE_BEGIN(3) { pg8::Gemm gm{TB, (const bf16*)(ws + WS_WIN), T, NIN, D, D}; pg8::StaticOrder S; S.init(T, NIN, Gx, blkx);
            pg8::EpiIn E{Z, st1, csb + 2 * 16384, csb + 3 * 16384, (const float*)(ws + WS_ROPE)};
            pg8::gemm_phase<pg8::EpiIn, pg8::StaticOrder, PG8_ALIGN, PG8_SP2, false, true>(lds + RING_OFF, gm, S, E, tidx); } PHASE_END
#endif
        PHASE_BEGIN(4)
#if defined(ATTN_VALU)
            attn_valu_phase(lds, Z, ssq_att, blkx, Gx, wavex, lanex);
#else
#if defined(XDUP) && XDUP == 4
            attn_mfma_phase(lds, Z, ssq_att, blkx, Gx, tidx, wavex, lanex, (bf16*)(ws + WS_TB));
#endif
            attn_mfma_phase(lds, Z, ssq_att, blkx, Gx, tidx, wavex, lanex);
#endif
            TP_MID()
            if (PHON(5)) lru_phase<0>(lds, blkx, Gx, tidx, lanex, wavex, Z, (const bf16*)(ws + WS_LRUW), P->in[10] + (size_t)l * 4 * LW, P->in[11] + (size_t)l * LW, P->in[13] + (size_t)l * 2 * LW, P->in[15] + (size_t)l * 2 * LW, P->in[16] + (size_t)l * 2 * LW, (float*)(ws + WS_TOT), ssq_rec);
#if defined(XDUP) && XDUP == 3
            lru_phase<0>(lds, blkx, Gx, tidx, lanex, wavex, Z, (const bf16*)(ws + WS_LRUW), P->in[10] + (size_t)l * 4 * LW, P->in[11] + (size_t)l * LW, P->in[13] + (size_t)l * 2 * LW, P->in[15] + (size_t)l * 2 * LW, P->in[16] + (size_t)l * 2 * LW, (float*)(ws + WS_TOT), ssq_rec);
#endif
            PHASE_END
        PHASE_BEGIN(6) lru_phase<1>(lds, blkx, Gx, tidx, lanex, wavex, Z, (const bf16*)(ws + WS_LRUW), P->in[10] + (size_t)l * 4 * LW, P->in[11] + (size_t)l * LW, P->in[13] + (size_t)l * 2 * LW, P->in[15] + (size_t)l * 2 * LW, P->in[16] + (size_t)l * 2 * LW, (float*)(ws + WS_TOT), ssq_rec); PHASE_END
        PHASE_BEGIN(8) { if (STAGGER_OUT) stagger_start(blkx, STAGGER_OUT); pg8::Gemm gm{Z, (const bf16*)(ws + WS_WOUT), T, D, D, NIN}; pg8::StaticOrder S; S.init(T, D, Gx, blkx, WGM_OUT);
            pg8::EpiRes<true, false, 12> E{P, ws, 0, (unsigned)(WS_ST + (size_t)(3 * l + 0) * STAT_BYTES), (unsigned)(WS_ST + (size_t)(3 * l + 1) * STAT_BYTES), 2, 3, l * D, 1.0f, (unsigned)(WS_SSQ + (size_t)(2 * l) * SSQ_BYTES)};
            pg8::gemm_phase<pg8::EpiRes<true, false, 12>, pg8::StaticOrder, PG8_ALIGN, PG8_SP2>(lds + RING_OFF, gm, S, E, tidx); } PHASE_END
        PHASE_BEGIN(1) { pg8::Gemm gm{(const bf16*)(ws + WS_TB8), (const bf16*)(ws + WS_WGU2), T, 2 * FF, D / 2, D / 2}; pg8::StaticOrder S; S.init(T, 2 * FF, Gx, blkx, WGM_GU);
            GU_EPI E{(unsigned char*)HB, st2, csb + 4 * 16384, csb + 5 * 16384};
            pg8::gemm_phase<GU_EPI, pg8::StaticOrder, PG8_ALIGN, PG8_SP2, !FFN6_GU, false, 1, FFN6_GU>(lds + RING_OFF, gm, S, E, tidx); } PHASE_END
#if defined(XDUP) && XDUP == 8
        PHASE_BEGIN(2) { pg8::Gemm gm{HB, (const bf16*)(ws + WS_WD2), T, D, FF / 2, FF / 2}; pg8::StaticOrder S; S.init(T, D, Gx, blkx);
            pg8::EpiRes<true, true> E{P, ws, 0, (unsigned)(WS_ST + (size_t)(3 * l + 1) * STAT_BYTES), (unsigned)(WS_ST + (size_t)(3 * l + 2) * STAT_BYTES), 7, 8, l * D, 0.5f / (pg8::F8_WSC * pg8::F8_HSC), 0u};
            pg8::gemm_phase<pg8::EpiRes<true, true>, pg8::StaticOrder, PG8_ALIGN, PG8_SP2, true>(lds + RING_OFF, gm, S, E, tidx); } PHASE_END
#endif
#if defined(XDUP) && XDUP == 6
        PHASE_BEGIN(2) { pg8::Gemm gm{HB, (const bf16*)(ws + WS_WD2), T, D, FF / 2, FF / 2}; pg8::StaticOrder S; S.init(T, D, Gx, blkx);
            pg8::EpiNull E{(float*)(ws + WS_VEC + 65536)};
            pg8::gemm_phase<pg8::EpiNull, pg8::StaticOrder, PG8_ALIGN, PG8_SP2, true>(lds + RING_OFF, gm, S, E, tidx); } PHASE_END
#endif
        PHASE_BEGIN(2) { if (STAGGER_DOWN) stagger_start(blkx, STAGGER_DOWN); pg8::Gemm gm{HB, (const bf16*)(ws + WS_WD2), T, D, FF / 2, FF / 2}; pg8::StaticOrder S; S.init(T, D, Gx, blkx, WGM_D);
            using EpiD2 = pg8::EpiRes<(l == 1) ? false : true, false, 0, (FUSE_FIN && l == 1)>;
            EpiD2 E{P, ws, 0, (unsigned)(WS_ST + (size_t)(3 * l + 1) * STAT_BYTES), (unsigned)(WS_ST + (size_t)(3 * l + 2) * STAT_BYTES), 7, 8, l * D, DOWN_SC, 0u};
            pg8::gemm_phase<EpiD2, pg8::StaticOrder, PG8_ALIGN, PG8_SP2, !FFN6_D, false, 1, FFN6_D, F8TO6>(lds + RING_OFF, gm, S, E, tidx); } PHASE_END
        if (l == 0) { PHASE_BEGIN(9) convert_layer(P, 1, lds, gwx, NGW, wavex, lanex);
#if defined(XDUP) && XDUP == 5
            convert_layer(P, 1, lds, gwx, NGW, wavex, lanex, (float*)(ws + WS_TOT));
#endif
            PHASE_END }
    }
    }
    { constexpr int l = 1;
    {
#define TB ((bf16*)(ws + WS_TB))
#define HB ((bf16*)(ws + WS_BIG))
#define Z ((bf16*)(ws + WS_BIG))
#define csb ((float*)(ws + WS_CSB) + (size_t)l * 6 * 16384)
#define ones ((const float*)(ws + WS_VEC))
#define zeros (ones + 2048)
#define st_prev (l ? (const float*)(ws + WS_ST + 2 * STAT_BYTES) : (const float*)(ws + WS_ST0))
#define g_prev (l ? P->in[20] : ones)
#define b_prev (l ? P->in[21] : zeros)
#define st1 ((float*)(ws + WS_ST + (size_t)(3 * l + 0) * STAT_BYTES))
#define st2 ((float*)(ws + WS_ST + (size_t)(3 * l + 1) * STAT_BYTES))
#define st3 ((float*)(ws + WS_ST + (size_t)(3 * l + 2) * STAT_BYTES))
#ifndef F8TO6
#define F8TO6 0
#endif
#if FFN6_D
#define GU_EPI pg8::EpiGU6
#ifndef F6_FIX
#define F6_FIX 1.0f
#endif
#define DOWN_SC (0.5f / (pg8::F6_WD * pg8::F6_HSC) * F6_FIX)
#else
#define GU_EPI pg8::EpiGU
#define DOWN_SC (0.5f / (pg8::F8_WSC * pg8::F8_HSC) * (F8TO6 ? 8.0f : 1.0f))
#endif
#ifndef WGM_GU
#define WGM_GU PG8_WGM
#endif
#ifndef WGM_D
#define WGM_D PG8_WGM
#endif
#ifndef WGM_IN
#define WGM_IN PG8_WGM
#endif
#ifndef WGM_OUT
#define WGM_OUT PG8_WGM
#endif
#define ssq_att ((float*)(ws + WS_SSQ + (size_t)(2 * l) * SSQ_BYTES))
#define ssq_rec ((float*)(ws + WS_SSQ + (size_t)(2 * l + 1) * SSQ_BYTES))
        PHASE_BEGIN(1) { pg8::Gemm gm{(const bf16*)(ws + WS_TB8), (const bf16*)(ws + WS_WGU1), T, 2 * FF, D / 2, D / 2}; pg8::StaticOrder S; S.init(T, 2 * FF, Gx, blkx);
            pg8::EpiGU E{(unsigned char*)HB, st_prev, csb, csb + 16384};
            pg8::gemm_phase<pg8::EpiGU, pg8::StaticOrder, PG8_ALIGN, PG8_SP2, true>(lds + RING_OFF, gm, S, E, tidx); } PHASE_END
#if defined(XDUP) && XDUP == 11
        PHASE_BEGIN(1) { pg8::Gemm gm{(const bf16*)(ws + WS_TB8), (const bf16*)(ws + WS_WGU1), T, 2 * FF, D / 2, D / 2}; pg8::FixedOrder S; S.init(T, 2 * FF, Gx, blkx);
            pg8::EpiNull E{(float*)(ws + WS_VEC + 65536)};
            pg8::gemm_phase<pg8::EpiNull, pg8::FixedOrder, PG8_ALIGN, PG8_SP2, true, false, 2>(lds + RING_OFF, gm, S, E, tidx); } PHASE_END
#endif
#if defined(XDUP) && XDUP >= 13 && XDUP <= 16
        PHASE_BEGIN(1) { pg8::Gemm gm{(const bf16*)(ws + WS_TB8), (const bf16*)(ws + WS_WGU1), T, 2 * FF, D / 2, D / 2}; pg8::StaticOrder S; S.init(T, 2 * FF, Gx, blkx);
            pg8::EpiNull E{(float*)(ws + WS_VEC + 65536)};
            pg8::gemm_phase<pg8::EpiNull, pg8::StaticOrder, PG8_ALIGN, PG8_SP2, true, false, 1, false, false, XDUP - 13>(lds + RING_OFF, gm, S, E, tidx); } PHASE_END
#endif
#if defined(XDUP) && XDUP == 12
        PHASE_BEGIN(1) { pg8::Gemm gm{(const bf16*)(ws + WS_TB8), (const bf16*)(ws + WS_WGU1), T, 2 * FF, D / 2, D / 2}; pg8::StaticOrder S; S.init(T, 2 * FF, Gx, blkx);
            pg8::EpiNull E{(float*)(ws + WS_VEC + 65536)};
            pg8::gemm_phase<pg8::EpiNull, pg8::StaticOrder, PG8_ALIGN, PG8_SP2, false, false, 1, true>(lds + RING_OFF, gm, S, E, tidx); } PHASE_END
#endif
#if defined(XDUP) && XDUP == 9
        for (int xb = 0; xb < 10; ++xb) { GRID_BAR(); }
#endif
#if defined(XDUP) && XDUP == 10
        PHASE_BEGIN(1) { pg8::Gemm gm{(const bf16*)(ws + WS_TB8), (const bf16*)(ws + WS_WGU1), T, 2 * FF, D / 2, D / 2}; pg8::FixedOrder S; S.init(T, 2 * FF, Gx, blkx);
            pg8::EpiNull E{(float*)(ws + WS_VEC + 65536)};
            pg8::gemm_phase<pg8::EpiNull, pg8::FixedOrder, PG8_ALIGN, PG8_SP2, true>(lds + RING_OFF, gm, S, E, tidx); } PHASE_END
#endif
#if defined(XDUP) && XDUP == 1
        PHASE_BEGIN(1) { pg8::Gemm gm{(const bf16*)(ws + WS_TB8), (const bf16*)(ws + WS_WGU1), T, 2 * FF, D / 2, D / 2}; pg8::StaticOrder S; S.init(T, 2 * FF, Gx, blkx);
            pg8::EpiNull E{(float*)(ws + WS_VEC + 65536)};
            pg8::gemm_phase<pg8::EpiNull, pg8::StaticOrder, PG8_ALIGN, PG8_SP2, true>(lds + RING_OFF, gm, S, E, tidx); } PHASE_END
#elif defined(XDUP) && XDUP == 2
        PHASE_BEGIN(1) { pg8::Gemm gm{(const bf16*)(ws + WS_TB8), (const bf16*)(ws + WS_WGU1), T, 2 * FF, D / 2, D / 2}; pg8::StaticOrder S; S.init(T, 2 * FF, Gx, blkx, WGM_GU);
            GU_EPI E{(unsigned char*)HB, st_prev, csb, csb + 16384};
            pg8::gemm_phase<GU_EPI, pg8::StaticOrder, PG8_ALIGN, PG8_SP2, !FFN6_GU, false, 1, FFN6_GU>(lds + RING_OFF, gm, S, E, tidx); } PHASE_END
#endif
        PHASE_BEGIN(2) { if (STAGGER_DOWN) stagger_start(blkx, STAGGER_DOWN); pg8::Gemm gm{HB, (const bf16*)(ws + WS_WD1), T, D, FF / 2, FF / 2}; pg8::StaticOrder S; S.init(T, D, Gx, blkx, WGM_D);
            pg8::EpiRes<false> E{P, ws, l == 0, (unsigned)(l ? WS_ST + 2 * STAT_BYTES : WS_ST0), (unsigned)(WS_ST + (size_t)(3 * l + 0) * STAT_BYTES), l ? 20 : -1, 21, 0, DOWN_SC, 0u};
            pg8::gemm_phase<pg8::EpiRes<false>, pg8::StaticOrder, PG8_ALIGN, PG8_SP2, !FFN6_D, false, 1, FFN6_D, F8TO6>(lds + RING_OFF, gm, S, E, tidx); } PHASE_END
        PHASE_BEGIN(3) { pg8::Gemm gm{TB, (const bf16*)(ws + WS_WIN), T, NIN, D, D}; pg8::StaticOrder S; S.init(T, NIN, Gx, blkx, WGM_IN);
            pg8::EpiIn E{Z, st1, csb + 2 * 16384, csb + 3 * 16384, (const float*)(ws + WS_ROPE)};
            pg8::gemm_phase<pg8::EpiIn, pg8::StaticOrder, PG8_ALIGN, PG8_SP2, false, true>(lds + RING_OFF, gm, S, E, tidx); } PHASE_END
#if defined(XDUP) && XDUP == 7
        PHASE_BEGIN(3) { pg8::Gemm gm{TB, (const bf16*)(ws + WS_WIN), T, NIN, D, D}; pg8::StaticOrder S; S.init(T, NIN, Gx, blkx);
            pg8::EpiIn E{Z, st1, csb + 2 * 16384, csb + 3 * 16384, (const float*)(ws + WS_ROPE)};
            pg8::gemm_phase<pg8::EpiIn, pg8::StaticOrder, PG8_ALIGN, PG8_SP2, false, true>(lds + RING_OFF, gm, S, E, tidx); } PHASE_END
#endif
        PHASE_BEGIN(4)
#if defined(ATTN_VALU)
            attn_valu_phase(lds, Z, ssq_att, blkx, Gx, wavex, lanex);
#else
#if defined(XDUP) && XDUP == 4
            attn_mfma_phase(lds, Z, ssq_att, blkx, Gx, tidx, wavex, lanex, (bf16*)(ws + WS_TB));
#endif
            attn_mfma_phase(lds, Z, ssq_att, blkx, Gx, tidx, wavex, lanex);
#endif
            TP_MID()
            if (PHON(5)) lru_phase<0>(lds, blkx, Gx, tidx, lanex, wavex, Z, (const bf16*)(ws + WS_LRUW), P->in[10] + (size_t)l * 4 * LW, P->in[11] + (size_t)l * LW, P->in[13] + (size_t)l * 2 * LW, P->in[15] + (size_t)l * 2 * LW, P->in[16] + (size_t)l * 2 * LW, (float*)(ws + WS_TOT), ssq_rec);
#if defined(XDUP) && XDUP == 3
            lru_phase<0>(lds, blkx, Gx, tidx, lanex, wavex, Z, (const bf16*)(ws + WS_LRUW), P->in[10] + (size_t)l * 4 * LW, P->in[11] + (size_t)l * LW, P->in[13] + (size_t)l * 2 * LW, P->in[15] + (size_t)l * 2 * LW, P->in[16] + (size_t)l * 2 * LW, (float*)(ws + WS_TOT), ssq_rec);
#endif
            PHASE_END
        PHASE_BEGIN(6) lru_phase<1>(lds, blkx, Gx, tidx, lanex, wavex, Z, (const bf16*)(ws + WS_LRUW), P->in[10] + (size_t)l * 4 * LW, P->in[11] + (size_t)l * LW, P->in[13] + (size_t)l * 2 * LW, P->in[15] + (size_t)l * 2 * LW, P->in[16] + (size_t)l * 2 * LW, (float*)(ws + WS_TOT), ssq_rec); PHASE_END
        PHASE_BEGIN(8) { if (STAGGER_OUT) stagger_start(blkx, STAGGER_OUT); pg8::Gemm gm{Z, (const bf16*)(ws + WS_WOUT), T, D, D, NIN}; pg8::StaticOrder S; S.init(T, D, Gx, blkx, WGM_OUT);
            pg8::EpiRes<true, false, 12> E{P, ws, 0, (unsigned)(WS_ST + (size_t)(3 * l + 0) * STAT_BYTES), (unsigned)(WS_ST + (size_t)(3 * l + 1) * STAT_BYTES), 2, 3, l * D, 1.0f, (unsigned)(WS_SSQ + (size_t)(2 * l) * SSQ_BYTES)};
            pg8::gemm_phase<pg8::EpiRes<true, false, 12>, pg8::StaticOrder, PG8_ALIGN, PG8_SP2>(lds + RING_OFF, gm, S, E, tidx); } PHASE_END
        PHASE_BEGIN(1) { pg8::Gemm gm{(const bf16*)(ws + WS_TB8), (const bf16*)(ws + WS_WGU2), T, 2 * FF, D / 2, D / 2}; pg8::StaticOrder S; S.init(T, 2 * FF, Gx, blkx, WGM_GU);
            GU_EPI E{(unsigned char*)HB, st2, csb + 4 * 16384, csb + 5 * 16384};
            pg8::gemm_phase<GU_EPI, pg8::StaticOrder, PG8_ALIGN, PG8_SP2, !FFN6_GU, false, 1, FFN6_GU>(lds + RING_OFF, gm, S, E, tidx); } PHASE_END
#if defined(XDUP) && XDUP == 8
        PHASE_BEGIN(2) { pg8::Gemm gm{HB, (const bf16*)(ws + WS_WD2), T, D, FF / 2, FF / 2}; pg8::StaticOrder S; S.init(T, D, Gx, blkx);
            pg8::EpiRes<true, true> E{P, ws, 0, (unsigned)(WS_ST + (size_t)(3 * l + 1) * STAT_BYTES), (unsigned)(WS_ST + (size_t)(3 * l + 2) * STAT_BYTES), 7, 8, l * D, 0.5f / (pg8::F8_WSC * pg8::F8_HSC), 0u};
            pg8::gemm_phase<pg8::EpiRes<true, true>, pg8::StaticOrder, PG8_ALIGN, PG8_SP2, true>(lds + RING_OFF, gm, S, E, tidx); } PHASE_END
#endif
#if defined(XDUP) && XDUP == 6
        PHASE_BEGIN(2) { pg8::Gemm gm{HB, (const bf16*)(ws + WS_WD2), T, D, FF / 2, FF / 2}; pg8::StaticOrder S; S.init(T, D, Gx, blkx);
            pg8::EpiNull E{(float*)(ws + WS_VEC + 65536)};
            pg8::gemm_phase<pg8::EpiNull, pg8::StaticOrder, PG8_ALIGN, PG8_SP2, true>(lds + RING_OFF, gm, S, E, tidx); } PHASE_END
#endif
        PHASE_BEGIN(2) { if (STAGGER_DOWN) stagger_start(blkx, STAGGER_DOWN); pg8::Gemm gm{HB, (const bf16*)(ws + WS_WD2), T, D, FF / 2, FF / 2}; pg8::StaticOrder S; S.init(T, D, Gx, blkx, WGM_D);
            using EpiD2 = pg8::EpiRes<(l == 1) ? false : true, false, 0, (FUSE_FIN && l == 1)>;
            EpiD2 E{P, ws, 0, (unsigned)(WS_ST + (size_t)(3 * l + 1) * STAT_BYTES), (unsigned)(WS_ST + (size_t)(3 * l + 2) * STAT_BYTES), 7, 8, l * D, DOWN_SC, 0u};
            pg8::gemm_phase<EpiD2, pg8::StaticOrder, PG8_ALIGN, PG8_SP2, !FFN6_D, false, 1, FFN6_D, F8TO6>(lds + RING_OFF, gm, S, E, tidx); } PHASE_END
        if (l == 0) { PHASE_BEGIN(9) convert_layer(P, 1, lds, gwx, NGW, wavex, lanex);
#if defined(XDUP) && XDUP == 5
            convert_layer(P, 1, lds, gwx, NGW, wavex, lanex, (float*)(ws + WS_TOT));
#endif
            PHASE_END }
    }
    }

#if !FUSE_FIN
#if defined(XDUP) && XDUP == 17
    PHASE_BEGIN(10) final_ln_phase(out, (const unsigned char*)(ws + WS_TB), (const float*)(ws + WS_ST + 5 * STAT_BYTES), P->in[20] + D, P->in[21] + D, gwx, NGW, lanex, (const float*)(ws + WS_VEC + 32768)); PHASE_END
#endif
    PHASE_BEGIN(10) final_ln_phase(out, (const unsigned char*)(ws + WS_TB), (const float*)(ws + WS_ST + 5 * STAT_BYTES), P->in[20] + D, P->in[21] + D, gwx, NGW, lanex, (const float*)(ws + WS_VEC + 32768)); PHASE_END
#endif
#undef PHASE_BEGIN
#undef PH_IN_RANGE
#undef PH_BAR_AFTER
#undef GRID_BAR
#undef PHASE_END
#undef TB
#undef HB
#undef Z
#undef csb
#undef ones
#undef zeros
#undef st_prev
#undef g_prev
#undef b_prev
#undef st1
#undef st2
#undef st3
#undef ssq_att
#undef ssq_rec
#undef out
}
constexpr int N_PHASES = N_PHASES_C;

#ifndef MK_N_LAUNCHES
#define MK_N_LAUNCHES 1
#endif
extern "C" void kernel_launch(void* const* d_in, const int* in_sizes, int n_in, void* d_out, int out_size, void* d_ws, size_t ws_size, hipStream_t stream) {
    static int grid = 0;
    if (grid == 0) {
        if (n_in != 25 || out_size != T * D || ws_size < WS_END) { fprintf(stderr, "kernel_launch: unexpected shapes (n_in %d, out %d, ws %zu)\n", n_in, out_size, ws_size); grid = -1; return; }
        int dev = 0, cus = 0, per_cu = 0;
        if (hipGetDevice(&dev) != hipSuccess || hipDeviceGetAttribute(&cus, hipDeviceAttributeMultiprocessorCount, dev) != hipSuccess) { grid = -1; return; }
        if (hipFuncSetAttribute((const void*)enc_fwd, hipFuncAttributeMaxDynamicSharedMemorySize, LDS_BYTES) != hipSuccess) { grid = -1; return; }
        if (hipOccupancyMaxActiveBlocksPerMultiprocessor(&per_cu, (const void*)enc_fwd, NWAVES * 64, LDS_BYTES) != hipSuccess || per_cu < 1) fprintf(stderr, "kernel_launch: occupancy query reports %d\n", per_cu);
        (void)hipGetLastError();
        grid = cus;
    }
    if (grid < 0) return;
    if (hipMemsetAsync((char*)d_ws + WS_CTL, 0, CTL_ZERO_BYTES, stream) != hipSuccess) return;
    Args a{};
    for (int i = 0; i < 25; ++i) a.in[i] = (const float*)d_in[i];
    a.out = (float*)d_out; a.ws = (unsigned char*)d_ws;
#if MK_N_LAUNCHES == 1
    a.ph_lo = 0; a.ph_hi = N_PHASES;
    hipLaunchKernelGGL(enc_fwd, dim3(grid), dim3(NWAVES * 64), LDS_BYTES, stream, a);
#else
    for (int p = 0; p < N_PHASES; ++p) { a.ph_lo = p; a.ph_hi = p + 1; hipLaunchKernelGGL(enc_fwd, dim3(grid), dim3(NWAVES * 64), LDS_BYTES, stream, a); }
#endif
}
```

```cpp
#include <hip/hip_runtime.h>
#include <cstdio>
#include <cstdint>

#ifndef PG8_SP2
#define PG8_SP2 true
#endif
#ifndef PG8_ALIGN
#define PG8_ALIGN true
#endif
constexpr int NWAVES = 8;
constexpr int T = 49152, TPR = 32768, D = 2048, FF = 5632, NIN = 4864, AW = 768, LW = 1280;
constexpr int ZQ = 0, ZGL = 768, ZK = 2048, ZV = 2816, ZXL = 3584;
constexpr int LCH = 128, NCHUNK = T / LCH;
constexpr size_t MiB = 1u << 20;
constexpr size_t WS_CTL = 0, CTL_ZERO_BYTES = 5 * MiB;
constexpr size_t STAT_BYTES = (size_t)T * 8, SSQ_BYTES = (size_t)T * 4;
constexpr size_t WS_ST = 1 * MiB;
constexpr size_t WS_SSQ = WS_ST + 6 * STAT_BYTES;
constexpr size_t WS_CSB = 4 * MiB;
static_assert(WS_SSQ + 4 * SSQ_BYTES <= WS_CSB && WS_CSB + 2 * 6 * 65536 <= CTL_ZERO_BYTES, "zero region");
constexpr size_t WS_ST0 = 5 * MiB;
constexpr size_t WS_VEC = 5 * MiB + 512 * 1024;
constexpr size_t WS_ROPE = 6 * MiB;
constexpr size_t WS_LRUW = 7 * MiB;
constexpr size_t WS_TOT = 10 * MiB;
constexpr size_t WS_WGU1 = 26 * MiB, WS_WD1 = 70 * MiB, WS_WIN = 92 * MiB, WS_WOUT = 111 * MiB, WS_WGU2 = 119 * MiB, WS_WD2 = 163 * MiB;
constexpr size_t WS_TB = 185 * MiB;
constexpr size_t WS_BIG = 377 * MiB;
constexpr size_t WS_TB8 = 905 * MiB;
constexpr size_t WS_END = 1001 * MiB;
static_assert(WS_TOT + (size_t)NCHUNK * 2 * 1280 * 8 <= WS_WGU1 && WS_WD2 + (size_t)D * FF * 2 <= WS_TB && WS_TB + (size_t)T * D * 2 <= WS_BIG && WS_BIG + (size_t)T * FF * 2 <= WS_TB8 && WS_TB8 + (size_t)T * D <= WS_END, "d_ws map");
constexpr int CW_BAR = 4096;
constexpr int RING_OFF = 0, RING_BYTES = 131072;
constexpr int LDSCTL_OFF = RING_BYTES, MISC_OFF = LDSCTL_OFF + 320;
constexpr int LDS_BYTES = 147456;
struct Args { const float* in[25]; float* out; unsigned char* ws; int ph_lo, ph_hi; };
#define GAS __attribute__((address_space(1)))
typedef const __attribute__((address_space(4))) Args* CArgs;
namespace pg8 {
#define PG8_LAS __attribute__((address_space(3)))
typedef unsigned short bf16_t;
typedef short bf16x8 __attribute__((ext_vector_type(8)));
typedef float f32x4 __attribute__((ext_vector_type(4)));
typedef unsigned u32x4 __attribute__((ext_vector_type(4)));
constexpr int BM = 256, BK = 64, HALF = 128, HTB = HALF * BK * 2  , STAGE_BYTES = 8 * HTB, NXCD = 8;
#ifndef PG8_WGM
#define PG8_WGM 4
#endif
constexpr int WGM = PG8_WGM;

__host__ __device__ __forceinline__ int lds_byte(int r, int c) { const int st = (r >> 4) * 2 + (c >> 5), rr = r & 15, cc = c & 31, ob = rr * 64 + cc * 2; return st * 1024 + (ob ^ (((ob >> 9) & 1) << 5)); }
__host__ __device__ __forceinline__ void stage_rc(int b, int& R, int& C) { const int st = b / 1024, sb = b % 1024, swz = sb ^ (((sb >> 9) & 1) << 5); R = (st >> 1) * 16 + swz / 64; C = (st & 1) * 32 + (swz % 64) / 2; }
__host__ __device__ __forceinline__ int perm32(int rho) { const int n = rho >> 4, i = rho & 15; return 8 * (i >> 2) + 4 * n + (i & 3); }

struct Unit { int pm, pn; };
struct Gemm { const bf16_t* A; const bf16_t* Bt; int M, N, K, lda; };

struct StaticOrder {
    int nM, nN, nwg, G, c, wgm;
    __host__ __device__ void init(int M, int N, int G_, int c_, int wgm_ = WGM) { nM = M / BM; nN = N / BM; nwg = nM * nN; G = G_; c = c_; wgm = wgm_; }
    __host__ __device__ bool next(int i, Unit& u) const {
        const long L = (long)i * G + c; if (L >= nwg) return false;
        int wgid = (int)L; { const int q = nwg / NXCD, r = nwg % NXCD, xcd = wgid % NXCD, off = wgid / NXCD; wgid = (xcd < r ? xcd * (q + 1) : r * (q + 1) + (xcd - r) * q) + off; }
        const int nig = wgm * nN, gid = wgid / nig, fm = gid * wgm, gsz = (nM - fm) < wgm ? (nM - fm) : wgm;
        u.pm = fm + ((wgid % nig) % gsz); u.pn = (wgid % nig) / gsz; return true;
    }
    __device__ __forceinline__ void a_ready(const Unit&) const {}
    __device__ __forceinline__ void done(const Unit&) const {}
};


struct FixedOrder : StaticOrder {
    __host__ __device__ bool next(int i, Unit& u) const { const long L = (long)i * G + c; if (L >= nwg) return false; u.pm = 0; u.pn = 0; return true; }
};

__device__ __forceinline__ unsigned cvt_pk_bf16(float lo, float hi) { unsigned r; asm volatile("v_cvt_pk_bf16_f32 %0, %1, %2" : "=v"(r) : "v"(lo), "v"(hi)); return r; }
__device__ __forceinline__ float shx(float v, int m, int lane) { return __builtin_bit_cast(float, __builtin_amdgcn_ds_bpermute((lane ^ m) << 2, __builtin_bit_cast(int, v))); }
__device__ __forceinline__ float shl(float v, int src) { return __builtin_bit_cast(float, __builtin_amdgcn_ds_bpermute(src << 2, __builtin_bit_cast(int, v))); }
__device__ __forceinline__ int lane_now() { int l; asm volatile("v_mbcnt_lo_u32_b32 %0, -1, 0\n\tv_mbcnt_hi_u32_b32 %0, -1, %0" : "=v"(l)); return l; }
template <int SH> __device__ __forceinline__ float qgrid(float x) { return __builtin_rintf(x * (float)(1 << SH)) * (1.0f / (float)(1 << SH)); }
typedef float f32x2 __attribute__((ext_vector_type(2)));
typedef unsigned u32x2 __attribute__((ext_vector_type(2)));
constexpr float ALPHA_RES = 1.41421356237309515f;
__device__ __forceinline__ void row_stats(const float* st, int r, float& mu, float& rstd) {
    const f32x2 s = *(const f32x2*)(st + 2 * (size_t)r);
    mu = s.x * (1.0f / 2048.0f); const float var = s.y * (1.0f / 2048.0f) - mu * mu;
    rstd = __builtin_amdgcn_rsqf(fmaxf(var, 0.0f) + 1e-5f);
}
__device__ __forceinline__ unsigned pk_f16(float lo, float hi) { unsigned r; asm("v_cvt_pk_f16_f32 %0, %1, %2" : "=v"(r) : "v"(lo), "v"(hi)); return r; }
__device__ __forceinline__ float f16_lo(unsigned w) { return (float)__builtin_bit_cast(_Float16, (unsigned short)(w & 0xffffu)); }
__device__ __forceinline__ float f16_hi(unsigned w) { return (float)__builtin_bit_cast(_Float16, (unsigned short)(w >> 16)); }
__device__ __forceinline__ unsigned pk4_fp8(float a, float b, float c, float d) {
    int w = __builtin_amdgcn_cvt_pk_fp8_f32(a, b, 0, false); w = __builtin_amdgcn_cvt_pk_fp8_f32(c, d, w, true); return (unsigned)w; }
constexpr float F8_WSC = 512.0f, F8_HSC = 32.0f;
#ifndef FFN6_GU
#define FFN6_GU 0
#endif
#ifndef FFN6_D
#define FFN6_D 0
#endif
constexpr float GU_WSC = FFN6_GU ? 128.0f : 512.0f;
typedef float f32x16 __attribute__((ext_vector_type(16)));
typedef unsigned u32x6 __attribute__((ext_vector_type(6)));
constexpr float F6_WGU = 128.0f, F6_WD = 224.0f, F6_HSC = 6.0f;
__device__ __forceinline__ void swap32(float& a, float& b) { asm volatile("s_nop 1\n\tv_permlane32_swap_b32 %0, %1" : "+v"(a), "+v"(b)); }
__device__ __forceinline__ void swap16(float& a, float& b) { asm volatile("s_nop 1\n\tv_permlane16_swap_b32 %0, %1" : "+v"(a), "+v"(b)); }
__device__ __forceinline__ void tr4(float& x0, float& x1, float& x2, float& x3) { swap32(x0, x2); swap32(x1, x3); swap16(x0, x1); swap16(x2, x3); }
__device__ __forceinline__ void st_frag6(unsigned char* rowkt, int kb, int sw, const f32x16 lo, const f32x16 hi) {
    const u32x6 w = __builtin_amdgcn_cvt_scalef32_2xpk16_fp6_f32(lo, hi, 1.0f);
    *(u32x4*)(rowkt + 16 * kb) = (u32x4){w[0], w[1], w[2], w[3]}; *(u32x2*)(rowkt + 64 + 8 * (kb ^ sw)) = (u32x2){w[4], w[5]}; }
__device__ __forceinline__ float silu_f(float v) { return v * __builtin_amdgcn_rcpf(1.0f + __builtin_amdgcn_exp2f(v * -1.4426950408889634f)); }

struct EpiGU {
    static constexpr bool PERM = true, AFTER_DRAIN = false, PF = false; static constexpr int MIDK = 0;
    unsigned char* H; const float* st; const float* cs; const float* cb;
    __device__ __forceinline__ void operator()(const f32x4 (&acc)[2][2][4][2], const Unit& u, int wr, int wc, int fr, int fq) const {
        const int row0 = u.pm * BM + wr * 64 + fr, rb = u.pn * BM + wc * 32 + 8 * fq, hc = u.pn * 128 + wc * 32 + 8 * fq; constexpr float dsc = 1.0f / GU_WSC;
        f32x4 csg[2], cbg[2], csu[2], cbu[2]; f32x2 sv[8];
#pragma unroll
        for (int i = 0; i < 8; ++i) sv[i] = *(const f32x2*)(st + 2 * (size_t)(row0 + (i >> 2) * HALF + (i & 3) * 16));
        constexpr float NL2E = -1.4426950408889634f, NLN2 = -0.6931471805599453f;
#pragma unroll
        for (int n = 0; n < 2; ++n) { csg[n] = *(const f32x4*)(cs + rb + 4 * n) * NL2E; cbg[n] = *(const f32x4*)(cb + rb + 4 * n) * NL2E; csu[n] = *(const f32x4*)(cs + rb + HALF + 4 * n) * (F8_HSC * NLN2); cbu[n] = *(const f32x4*)(cb + rb + HALF + 4 * n) * (F8_HSC * NLN2); }
#pragma unroll
        for (int ai = 0; ai < 2; ++ai)
#pragma unroll
            for (int m = 0; m < 4; ++m) { const int r = row0 + ai * HALF + m * 16; const f32x2 s2 = sv[ai * 4 + m];
                const float mu = s2.x * (1.0f / 2048.0f), rstd = __builtin_amdgcn_rsqf(fmaxf(s2.y * (1.0f / 2048.0f) - mu * mu, 0.0f) + 1e-5f);
                const float ag = dsc * rstd * NL2E, au = dsc * rstd * (F8_HSC * NLN2), mr = mu * rstd;
                f32x4 hv[2];
#pragma unroll
                for (int n = 0; n < 2; ++n) { const f32x4 z = acc[ai][0][m][n] * ag + (cbg[n] - csg[n] * mr), up = acc[ai][1][m][n] * au + (cbu[n] - csu[n] * mr);
                    const f32x4 gt = z; f32x4 e, r;
#pragma unroll
                    for (int j = 0; j < 4; ++j) e[j] = __builtin_amdgcn_exp2f(z[j]);
                    const f32x4 den = e + 1.0f;
#pragma unroll
                    for (int j = 0; j < 4; ++j) r[j] = __builtin_amdgcn_rcpf(den[j]);
                    hv[n] = (gt * up) * r; }
                u32x2 w; w.x = pk4_fp8(hv[0][0], hv[0][1], hv[0][2], hv[0][3]); w.y = pk4_fp8(hv[1][0], hv[1][1], hv[1][2], hv[1][3]);
                *(u32x2*)(H + (size_t)r * 5632 + hc) = w; }
    }
};
struct EpiGU6 {
    static constexpr bool PERM = true, AFTER_DRAIN = false, PF = false; static constexpr int MIDK = 0;
    unsigned char* H; const float* st; const float* cs; const float* cb;
    __device__ __forceinline__ void operator()(const f32x4 (&acc)[2][2][4][2], const Unit& u, int wr, int wc, int fr, int fq) const {
        const int row0 = u.pm * BM + wr * 64 + fr, rb = u.pn * BM + wc * 32 + 8 * fq; constexpr float dsc = 1.0f / GU_WSC;
        f32x4 csg[2], cbg[2], csu[2], cbu[2]; f32x2 sv[8];
#pragma unroll
        for (int i = 0; i < 8; ++i) sv[i] = *(const f32x2*)(st + 2 * (size_t)(row0 + (i >> 2) * HALF + (i & 3) * 16));
#pragma unroll
        for (int n = 0; n < 2; ++n) { csg[n] = *(const f32x4*)(cs + rb + 4 * n); cbg[n] = *(const f32x4*)(cb + rb + 4 * n); csu[n] = *(const f32x4*)(cs + rb + HALF + 4 * n) * F6_HSC; cbu[n] = *(const f32x4*)(cb + rb + HALF + 4 * n) * F6_HSC; }
#pragma unroll
        for (int ai = 0; ai < 2; ++ai) { float hv[4][8];
#pragma unroll
            for (int m = 0; m < 4; ++m) { const f32x2 s2 = sv[ai * 4 + m];
                const float mu = s2.x * (1.0f / 2048.0f), rstd = __builtin_amdgcn_rsqf(fmaxf(s2.y * (1.0f / 2048.0f) - mu * mu, 0.0f) + 1e-5f);
                const float ag = dsc * rstd, au = ag * F6_HSC, mr = mu * rstd;
#pragma unroll
                for (int n = 0; n < 2; ++n) { const f32x4 gt = acc[ai][0][m][n] * ag + (cbg[n] - csg[n] * mr), up = acc[ai][1][m][n] * au + (cbu[n] - csu[n] * mr);
#pragma unroll
                    for (int j = 0; j < 4; ++j) hv[m][4 * n + j] = gt[j] * __builtin_amdgcn_rcpf(1.0f + __builtin_amdgcn_exp2f(gt[j] * -1.4426950408889634f)) * up[j]; } }
#pragma unroll
            for (int d = 0; d < 8; ++d) tr4(hv[0][d], hv[1][d], hv[2][d], hv[3][d]);
            f32x16 lo, hi;
#pragma unroll
            for (int d = 0; d < 8; ++d) { lo[d] = hv[0][d]; lo[8 + d] = hv[1][d]; hi[d] = hv[2][d]; hi[8 + d] = hv[3][d]; }
            const int r = u.pm * BM + wr * 64 + ai * HALF + fq * 16 + fr;
            st_frag6(H + (size_t)r * 4224 + 96 * u.pn, wc, (fr & 8) ? 2 : 0, lo, hi); }
    }
};
struct EpiIn {
    static constexpr bool PERM = true, AFTER_DRAIN = false, PF = false; static constexpr int MIDK = 0;
    bf16_t* Z; const float* st; const float* cs; const float* cb; const float* rope;
    __device__ __forceinline__ void operator()(const f32x4 (&acc)[2][2][4][2], const Unit& u, int wr, int wc, int fr, int fq) const {
        const int row0 = u.pm * BM + wr * 64 + fr, rb = u.pn * BM + wc * 32 + 8 * fq;
        const bool rot = (u.pn < 3 || (u.pn >= 8 && u.pn < 11)) && ((wc & 1) == 0);
        f32x4 csv[2][2], cbv[2][2];
#pragma unroll
        for (int bj = 0; bj < 2; ++bj)
#pragma unroll
            for (int n = 0; n < 2; ++n) { csv[bj][n] = *(const f32x4*)(cs + rb + bj * HALF + 4 * n); cbv[bj][n] = *(const f32x4*)(cb + rb + bj * HALF + 4 * n); }
        f32x2 sv[8];
#pragma unroll
        for (int i = 0; i < 8; ++i) sv[i] = *(const f32x2*)(st + 2 * (size_t)(row0 + (i >> 2) * HALF + (i & 3) * 16));
#pragma unroll
        for (int ai = 0; ai < 2; ++ai)
#pragma unroll
            for (int m = 0; m < 4; ++m) { const int r = row0 + ai * HALF + m * 16; const f32x2 s2 = sv[ai * 4 + m];
                const float mu = s2.x * (1.0f / 2048.0f), rstd = __builtin_amdgcn_rsqf(fmaxf(s2.y * (1.0f / 2048.0f) - mu * mu, 0.0f) + 1e-5f);
                f32x4 cs0 = {1.f, 0.f, 1.f, 0.f}, cs1 = cs0, cs2 = cs0, cs3 = cs0;
                if (rot && fq < 2) { const int pos = r < 32768 ? (r & 4095) : (r - 32768); const f32x4* rp = (const f32x4*)(rope + (size_t)pos * 16); cs0 = rp[0]; cs1 = rp[1]; cs2 = rp[2]; cs3 = rp[3]; }
                const float sg = (fq == 0) ? -1.f : 1.f;
#pragma unroll
                for (int bj = 0; bj < 2; ++bj) { f32x4 v0 = (acc[ai][bj][m][0] - csv[bj][0] * mu) * rstd + cbv[bj][0], v1 = (acc[ai][bj][m][1] - csv[bj][1] * mu) * rstd + cbv[bj][1];
                    if (rot) { f32x4 p0, p1;
#pragma unroll
                        for (int j = 0; j < 4; ++j) { p0[j] = shx(v0[j], 16, (fr + 16 * fq)); p1[j] = shx(v1[j], 16, (fr + 16 * fq)); }
                        if (fq < 2) {
                            v0[0] = v0[0] * cs0[0] + sg * p0[0] * cs0[1]; v0[1] = v0[1] * cs0[2] + sg * p0[1] * cs0[3]; v0[2] = v0[2] * cs1[0] + sg * p0[2] * cs1[1]; v0[3] = v0[3] * cs1[2] + sg * p0[3] * cs1[3];
                            v1[0] = v1[0] * cs2[0] + sg * p1[0] * cs2[1]; v1[1] = v1[1] * cs2[2] + sg * p1[1] * cs2[3]; v1[2] = v1[2] * cs3[0] + sg * p1[2] * cs3[1]; v1[3] = v1[3] * cs3[2] + sg * p1[3] * cs3[3]; } }
                    u32x4 w; w.x = cvt_pk_bf16(v0[0], v0[1]); w.y = cvt_pk_bf16(v0[2], v0[3]); w.z = cvt_pk_bf16(v1[0], v1[1]); w.w = cvt_pk_bf16(v1[2], v1[3]);
                    *(u32x4*)(Z + (size_t)r * 4864 + rb + bj * HALF) = w; } }
    }
};
template <bool TB8, bool DUMMY = false, int MK = 0, bool FIN = false> struct EpiRes {
#ifndef RES_PF
#define RES_PF 0
#endif
    static constexpr bool PERM = true, AFTER_DRAIN = false, PF = (RES_PF != 0); static constexpr int MIDK = MK;
    CArgs a; GAS unsigned char* ws; int x_in;
    unsigned st_off, stout_off; int gi, bi, goff; float sc; unsigned ssq_off;
    __device__ __forceinline__ void pf(const Unit& u, int wid, int lane, PG8_LAS unsigned char* junk) const {
        if (x_in) return;
#pragma unroll
        for (int j = 0; j < 4; ++j) { const int sidx = (wid * 4 + j) * 64 + lane, row = sidx >> 3, sec = sidx & 7;
            GAS const unsigned char* p = ws + WS_TB + (size_t)(u.pm * BM + row) * 4096 + (size_t)(u.pn * 512 + sec * 64);
            __builtin_amdgcn_global_load_lds((GAS void*)p, (PG8_LAS void*)(junk + wid * 1024 + j * 256), 4, 0, 0); }
    }
    __device__ __forceinline__ void midk(f32x4 (&acc)[2][2][4][2], const Unit& u, int wr, int wc, int fr, int fq) const {
        const int row0 = u.pm * BM + wr * 64 + fr; const float* sa = (const float*)(ws + ssq_off); const float* sr = sa + T;
        float ra[8];
#pragma unroll
        for (int i = 0; i < 8; ++i) { const int r = row0 + (i >> 2) * HALF + (i & 3) * 16; ra[i] = __builtin_amdgcn_rsqf(sa[r] * (1.0f / 768.0f) + 1e-5f) * __builtin_amdgcn_sqrtf(sr[r] * (1.0f / 1280.0f) + 1e-5f); }
#pragma unroll
        for (int i = 0; i < 8; ++i)
#pragma unroll
            for (int bj = 0; bj < 2; ++bj)
#pragma unroll
                for (int n = 0; n < 2; ++n) acc[i >> 2][bj][i & 3][n] *= ra[i];
    }
    __device__ __forceinline__ void operator()(const f32x4 (&acc)[2][2][4][2], const Unit& u, int wr, int wc, int fr, int fq) const {
        const int row0 = u.pm * BM + wr * 64 + fr, col0 = u.pn * BM + wc * 32 + 8 * fq;
        unsigned char* RES = (unsigned char*)(ws + WS_TB); unsigned char* T8 = (unsigned char*)(ws + WS_TB8);
        f32x4 (&am)[2][2][4][2] = const_cast<f32x4 (&)[2][2][4][2]>(acc);
        const float* X = (u.pm < 128) ? a->in[0] : a->in[1] - (size_t)TPR * D;
        const float* st = (const float*)(ws + st_off); float* st_out = (float*)(ws + stout_off);
        const float* g = gi < 0 ? (const float*)(ws + WS_VEC) : a->in[gi] + goff; const float* b = gi < 0 ? (const float*)(ws + WS_VEC) + 2048 : a->in[bi] + goff;
        const unsigned rbase = (unsigned)row0 * 8192u + (unsigned)col0 * 4u;
#define RES_ROWOFF(i) ((unsigned)(((i) >> 2) * HALF + ((i) & 3) * 16) * 8192u)
#define RES_LOAD(dst, sdst, i) do { const unsigned ob_ = rbase + RES_ROWOFF(i); sdst = *(const f32x2*)((const char*)st + (size_t)(row0 + ((i) >> 2) * HALF + ((i) & 3) * 16) * 8); \
        if (x_in) { _Pragma("unroll") for (int bj = 0; bj < 2; ++bj) _Pragma("unroll") for (int n = 0; n < 2; ++n) dst[bj][n] = *(const f32x4*)((const char*)X + (ob_ + (unsigned)(bj * HALF + 4 * n) * 4u)); } \
        else { _Pragma("unroll") for (int bj = 0; bj < 2; ++bj) { const u32x4 w_ = *(const u32x4*)(RES + ((ob_ + (unsigned)(bj * HALF) * 4u) >> 1)); \
            dst[bj][0] = (f32x4){f16_lo(w_.x), f16_hi(w_.x), f16_lo(w_.y), f16_hi(w_.y)}; dst[bj][1] = (f32x4){f16_lo(w_.z), f16_hi(w_.z), f16_lo(w_.w), f16_hi(w_.w)}; } } } while (0)
        f32x4 gv[2][2], bv[2][2];
#pragma unroll
        for (int bj = 0; bj < 2; ++bj)
#pragma unroll
            for (int n = 0; n < 2; ++n) { gv[bj][n] = *(const f32x4*)(g + col0 + bj * HALF + 4 * n); bv[bj][n] = *(const f32x4*)(b + col0 + bj * HALF + 4 * n); }
#pragma unroll
        for (int bj = 0; bj < 2; ++bj)
#pragma unroll
            for (int n = 0; n < 2; ++n) { gv[bj][n] = gv[bj][n] * ALPHA_RES; bv[bj][n] = bv[bj][n] * ALPHA_RES; }
        const bool dmy_ = DUMMY && (sc == 12345.678f);
        f32x4 oo[2][2], oe[2][2];
        f32x4 t0[2][2], t1[2][2], t2[2][2]; f32x2 s0, s1, s2;
#ifndef RES_LA
#define RES_LA 2
#endif
        u32x4 rw[8][2]; f32x2 sw_[8];
#define RES_RAW(i) do { const unsigned ob_ = rbase + RES_ROWOFF(i); sw_[i] = *(const f32x2*)((const char*)st + (size_t)(row0 + ((i) >> 2) * HALF + ((i) & 3) * 16) * 8); \
        _Pragma("unroll") for (int bj = 0; bj < 2; ++bj) rw[i][bj] = *(const u32x4*)(RES + ((ob_ + (unsigned)(bj * HALF) * 4u) >> 1)); } while (0)
        if (x_in) { RES_LOAD(t0, s0, 0); RES_LOAD(t1, s1, 1); }
        else {
#pragma unroll
            for (int i = 0; i < RES_LA; ++i) RES_RAW(i); }
#pragma unroll
        for (int i = 0; i < 8; ++i) { const int r = row0 + (i >> 2) * HALF + (i & 3) * 16;
                if (x_in) { if (i < 6) RES_LOAD(t2, s2, i + 2); }
                else { if (i + RES_LA < 8) RES_RAW(i + RES_LA);
                    s0 = sw_[i];
#pragma unroll
                    for (int bj = 0; bj < 2; ++bj) { const u32x4 w_ = rw[i][bj]; t0[bj][0] = (f32x4){f16_lo(w_.x), f16_hi(w_.x), f16_lo(w_.y), f16_hi(w_.y)}; t0[bj][1] = (f32x4){f16_lo(w_.z), f16_hi(w_.z), f16_lo(w_.w), f16_hi(w_.w)}; } }
                const float mu = s0.x * (1.0f / 2048.0f), rstd = __builtin_amdgcn_rsqf(fmaxf(s0.y * (1.0f / 2048.0f) - mu * mu, 0.0f) + 1e-5f);
                float scr = sc; if constexpr (MK > 0) scr = sc * __builtin_amdgcn_rsqf(((const float*)(ws + ssq_off))[T + r] * (1.0f / 1280.0f) + 1e-5f);
                const unsigned ob = rbase + RES_ROWOFF(i); const float nmr = -mu * rstd; f32x4 sv4 = {0.f, 0.f, 0.f, 0.f}, qv4 = {0.f, 0.f, 0.f, 0.f};
#pragma unroll
                for (int bj = 0; bj < 2; ++bj) { f32x4 (&o)[2] = oo[bj];
#pragma unroll
                    for (int n = 0; n < 2; ++n) {
                        const f32x4 A_ = gv[bj][n] * rstd, C_ = gv[bj][n] * nmr + bv[bj][n];
                        o[n] = acc[i >> 2][bj][i & 3][n] * scr + (t0[bj][n] * A_ + C_);
                        sv4 = sv4 + o[n]; qv4 = o[n] * o[n] + qv4; }
                    const unsigned cb_ = ob + (unsigned)(bj * HALF) * 4u;
                    if constexpr (FIN) { am[i >> 2][bj][i & 3][0] = o[0]; am[i >> 2][bj][i & 3][1] = o[1]; }
                    else { u32x4 w; w.x = pk_f16(o[0][0], o[0][1]); w.y = pk_f16(o[0][2], o[0][3]); w.z = pk_f16(o[1][0], o[1][1]); w.w = pk_f16(o[1][2], o[1][3]); if (!DUMMY || dmy_) *(u32x4*)(RES + (cb_ >> 1)) = w; }
                    if constexpr (TB8 && !FFN6_GU) { u32x2 w; w.x = pk4_fp8(o[0][0], o[0][1], o[0][2], o[0][3]); w.y = pk4_fp8(o[1][0], o[1][1], o[1][2], o[1][3]); if (!DUMMY || dmy_) *(u32x2*)(T8 + (cb_ >> 2)) = w; } }
                if constexpr (TB8 && FFN6_GU) {
                    if ((i & 1) == 0) {
#pragma unroll
                        for (int bj = 0; bj < 2; ++bj)
#pragma unroll
                            for (int n = 0; n < 2; ++n) oe[bj][n] = oo[bj][n]; }
                    else { f32x16 lo, hi;
#pragma unroll
                        for (int d = 0; d < 8; ++d) { float x0 = oe[0][d >> 2][d & 3], x1 = oe[1][d >> 2][d & 3], x2 = oo[0][d >> 2][d & 3], x3 = oo[1][d >> 2][d & 3]; tr4(x0, x1, x2, x3); lo[d] = x0; lo[8 + d] = x1; hi[d] = x2; hi[8 + d] = x3; }
                        const int ri = row0 + ((i - 1 + (fq >> 1)) >> 2) * HALF + ((i - 1 + (fq >> 1)) & 3) * 16;
                        st_frag6(T8 + (size_t)ri * 1536 + 96 * (2 * u.pn + (fq & 1)), wc, (fr & 8) ? 2 : 0, lo, hi); } }
                float s = (sv4[0] + sv4[1]) + (sv4[2] + sv4[3]), q = (qv4[0] + qv4[1]) + (qv4[2] + qv4[3]);
                s += shx(s, 16, (fr + 16 * fq)); s += shx(s, 32, (fr + 16 * fq)); q += shx(q, 16, (fr + 16 * fq)); q += shx(q, 32, (fr + 16 * fq));
                if (fq == 0 && (!DUMMY || dmy_)) { unsafeAtomicAdd(st_out + 2 * (size_t)r, qgrid<8>(s)); unsafeAtomicAdd(st_out + 2 * (size_t)r + 1, qgrid<6>(q)); }
                if (x_in) {
#pragma unroll
                for (int bj = 0; bj < 2; ++bj)
#pragma unroll
                    for (int n = 0; n < 2; ++n) { t0[bj][n] = t1[bj][n]; t1[bj][n] = t2[bj][n]; }
                s0 = s1; s1 = s2; }
                asm volatile("" ::: "memory"); }
        if constexpr (FIN) {
            unsigned* cnt = (unsigned*)(ws + WS_CTL + 524288) + u.pm * 16;
            __builtin_amdgcn_fence(__ATOMIC_RELEASE, "agent");
            if (fr + 16 * fq == 0) __hip_atomic_fetch_add(cnt, 1u, __ATOMIC_RELAXED, __HIP_MEMORY_SCOPE_AGENT);
            { const unsigned long long t0_ = __builtin_amdgcn_s_memrealtime();
              while ((unsigned)__builtin_amdgcn_readfirstlane((int)__hip_atomic_load(cnt, __ATOMIC_RELAXED, __HIP_MEMORY_SCOPE_AGENT)) < 64u) { if (__builtin_amdgcn_s_memrealtime() - t0_ > 2000000ull) break; __builtin_amdgcn_s_sleep(2); } }
            __builtin_amdgcn_fence(__ATOMIC_ACQUIRE, "agent");
            const float* g3 = a->in[20] + D; const float* b3 = a->in[21] + D; float* OUT = a->out;
#pragma unroll
            for (int bj = 0; bj < 2; ++bj)
#pragma unroll
                for (int n = 0; n < 2; ++n) { gv[bj][n] = *(const f32x4*)(g3 + col0 + bj * HALF + 4 * n); bv[bj][n] = *(const f32x4*)(b3 + col0 + bj * HALF + 4 * n); }
#pragma unroll
            for (int i = 0; i < 8; ++i) { const int r = row0 + (i >> 2) * HALF + (i & 3) * 16;
                const float sx = __hip_atomic_load(st_out + 2 * (size_t)r, __ATOMIC_RELAXED, __HIP_MEMORY_SCOPE_AGENT), sy = __hip_atomic_load(st_out + 2 * (size_t)r + 1, __ATOMIC_RELAXED, __HIP_MEMORY_SCOPE_AGENT);
                const float mu = sx * (1.0f / 2048.0f), rstd = __builtin_amdgcn_rsqf(fmaxf(sy * (1.0f / 2048.0f) - mu * mu, 0.0f) + 1e-5f);
#pragma unroll
                for (int bj = 0; bj < 2; ++bj)
#pragma unroll
                    for (int n = 0; n < 2; ++n) *(f32x4*)(OUT + (size_t)r * 2048 + col0 + bj * HALF + 4 * n) = (am[i >> 2][bj][i & 3][n] - mu) * rstd * gv[bj][n] + bv[bj][n]; }
        }
#undef RES_LOAD
#undef RES_RAW
#undef RES_ROWOFF
    }
};

struct EpiNull {
    static constexpr bool PERM = true, AFTER_DRAIN = false, PF = false; static constexpr int MIDK = 0;
    float* sink;
    __device__ __forceinline__ void operator()(const f32x4 (&acc)[2][2][4][2], const Unit& u, int wr, int wc, int fr, int fq) const {
        float s = 0.f;
#pragma unroll
        for (int ai = 0; ai < 2; ++ai)
#pragma unroll
            for (int bj = 0; bj < 2; ++bj)
#pragma unroll
                for (int m = 0; m < 4; ++m)
#pragma unroll
                    for (int n = 0; n < 2; ++n) s += acc[ai][bj][m][n][0] + acc[ai][bj][m][n][1] + acc[ai][bj][m][n][2] + acc[ai][bj][m][n][3];
        if (s == 12345.678f) sink[0] = s;
    }
};
typedef int v4i_t __attribute__((ext_vector_type(4)));
typedef int v8i_t __attribute__((ext_vector_type(8)));
typedef int v2i_t __attribute__((ext_vector_type(2)));
__device__ __forceinline__ v8i_t cat8(bf16x8 lo, bf16x8 hi) { const v4i_t a = __builtin_bit_cast(v4i_t, lo), b = __builtin_bit_cast(v4i_t, hi); return __builtin_shufflevector(a, b, 0, 1, 2, 3, 4, 5, 6, 7); }
typedef _Float16 f16x8_t __attribute__((ext_vector_type(8)));
template <class Epi, class Sched, bool ALIGN_EPI = false, bool SP2 = false, bool F8 = false, bool F16 = false, int MREP = 1, bool F6 = false, bool CV6 = false, int BMASK = 0>
__device__ __forceinline__ void gemm_phase(PG8_LAS unsigned char* lds, const Gemm g, const Sched& S, const Epi& E, const int tid) {
    const int wid = __builtin_amdgcn_readfirstlane(tid >> 6), lane = tid & 63, wr = wid >> 2, wc = wid & 3, fr = lane & 15, fq = lane >> 4;
    const int K = g.K, nt = K / BK;
    static_assert(!F6 || SP2, "F6 is written for the SP2 loop");
    unsigned voffA[2], voffB[2];
#pragma unroll
    for (int i = 0; i < 2; ++i) {
        if constexpr (F6) { const int p0 = tid + 512 * i, p = p0 >= 768 ? p0 - 256 : p0, R = p / 6, Rb = Epi::PERM ? ((R & ~31) + perm32(R & 31)) : R;
            voffA[i] = (unsigned)(R * (g.lda * 3 / 2) + (p % 6) * 16); voffB[i] = (unsigned)(Rb * (K * 3 / 2) + (p % 6) * 16); }
        else { int R, C; stage_rc(tid * 16 + i * 8192, R, C); const int Rb = Epi::PERM ? ((R & ~31) + perm32(R & 31)) : R;
            voffA[i] = (unsigned)(R * g.lda + C) * 2u; voffB[i] = (unsigned)(Rb * K + C) * 2u; } }
    const size_t kstep = F6 ? (size_t)96 : (size_t)(BK * 2);
    const size_t hstep = F6 ? (size_t)HALF * K * 3 / 2 : (size_t)HALF * K * 2;
    const size_t tstep = 2 * hstep; const size_t hstepA = F6 ? (size_t)HALF * g.lda * 3 / 2 : (size_t)HALF * g.lda * 2, tstepA = 2 * hstepA;
    const unsigned ldsw = (unsigned)wid * 1024u;
    const int sw6 = (fr & 8) ? 2 : 0;
    const int aoff = F6 ? (wr * 64 + fr) * 96 + 16 * fq : lds_byte(wr * 64 + fr, fq * 8), boff = F6 ? (wc * 32 + fr) * 96 + 16 * fq : lds_byte(wc * 32 + fr, fq * 8); constexpr int KOFF = 1024;
    const int atl = (wr * 64 + fr) * 96 + 64 + 8 * (fq ^ sw6), btl = (wc * 32 + fr) * 96 + 64 + 8 * (fq ^ sw6);
#define PG8_SA(b, h) (((b) * 2 + (h)) * HTB)
#define PG8_SB(b, h) ((4 + (b) * 2 + (h)) * HTB)
    const __amdgpu_buffer_rsrc_t rsrcA = __builtin_amdgcn_make_buffer_rsrc((void*)g.A, 0, 0x7fffffff, 0x00020000), rsrcB = __builtin_amdgcn_make_buffer_rsrc((void*)g.Bt, 0, 0x7fffffff, 0x00020000);
#define PG8_STAGE(bufoff, goff, voff) do { if constexpr (BMASK != 0) { if ((BMASK == 3) || ((voff) == voffB && (BMASK & 1)) || ((voff) == voffA && (BMASK & 2))) asm volatile("s_mov_b64 exec, 0xffff" ::: "memory"); } _Pragma("unroll") for (int _i = 0; _i < 2; ++_i) { \
        __builtin_amdgcn_raw_ptr_buffer_load_lds(((voff) == voffA) ? rsrcA : rsrcB, (PG8_LAS void*)(lds + (bufoff) + ldsw + _i * 8192), 16, (int)(voff)[_i], (int)(goff), 0, 0); } if constexpr (BMASK != 0) asm volatile("s_mov_b64 exec, -1" ::: "memory"); } while (0)
#define PG8_LD6(dst, base, mainoff, tailoff) do { dst[0] = *(const PG8_LAS bf16x8*)(lds + (base) + (mainoff)); const v2i_t t_ = *(const PG8_LAS v2i_t*)(lds + (base) + (tailoff)); \
        dst[1] = __builtin_bit_cast(bf16x8, __builtin_shufflevector(t_, t_, 0, 1, -1, -1)); } while (0)
#define PG8_LDA(dst, b, h) do { _Pragma("unroll") for (int m = 0; m < 4; ++m) { if constexpr (F6) PG8_LD6(dst[m], PG8_SA(b, h) + m * 1536, aoff, atl); \
        else { _Pragma("unroll") for (int k = 0; k < 2; ++k) dst[m][k] = *(const PG8_LAS bf16x8*)(lds + PG8_SA(b, h) + aoff + m * 2048 + k * KOFF); if constexpr (CV6) { PG8_WAIT_L(0); PG8_CV6(dst[m], 4.0f); } } } } while (0)
#define PG8_LDB(dst, b, h) do { _Pragma("unroll") for (int n = 0; n < 2; ++n) { if constexpr (F6) PG8_LD6(dst[n], PG8_SB(b, h) + n * 1536, boff, btl); \
        else { _Pragma("unroll") for (int k = 0; k < 2; ++k) dst[n][k] = *(const PG8_LAS bf16x8*)(lds + PG8_SB(b, h) + boff + n * 2048 + k * KOFF); if constexpr (CV6) { PG8_WAIT_L(0); PG8_CV6(dst[n], 2.0f); } } } } while (0)
#define PG8_CV6(fr_, dv) do { const v4i_t a_ = __builtin_bit_cast(v4i_t, fr_[0]), b_ = __builtin_bit_cast(v4i_t, fr_[1]); f32x16 lo_, hi_; \
        _Pragma("unroll") for (int q_ = 0; q_ < 4; ++q_) { lo_[4 * q_] = __builtin_amdgcn_cvt_f32_fp8(a_[q_], 0); lo_[4 * q_ + 1] = __builtin_amdgcn_cvt_f32_fp8(a_[q_], 1); lo_[4 * q_ + 2] = __builtin_amdgcn_cvt_f32_fp8(a_[q_], 2); lo_[4 * q_ + 3] = __builtin_amdgcn_cvt_f32_fp8(a_[q_], 3); \
            hi_[4 * q_] = __builtin_amdgcn_cvt_f32_fp8(b_[q_], 0); hi_[4 * q_ + 1] = __builtin_amdgcn_cvt_f32_fp8(b_[q_], 1); hi_[4 * q_ + 2] = __builtin_amdgcn_cvt_f32_fp8(b_[q_], 2); hi_[4 * q_ + 3] = __builtin_amdgcn_cvt_f32_fp8(b_[q_], 3); } \
        const u32x6 w_ = __builtin_amdgcn_cvt_scalef32_2xpk16_fp6_f32(lo_, hi_, dv); fr_[0] = __builtin_bit_cast(bf16x8, (u32x4){w_[0], w_[1], w_[2], w_[3]}); fr_[1] = __builtin_bit_cast(bf16x8, (u32x4){w_[4], w_[5], 0u, 0u}); } while (0)
#define PG8_MMA(ai, bj, At, Bt) do { __builtin_amdgcn_s_setprio(1); _Pragma("unroll") for (int rep_ = 0; rep_ < MREP; ++rep_) _Pragma("unroll") for (int m = 0; m < 4; ++m) _Pragma("unroll") for (int n = 0; n < 2; ++n) { \
        if constexpr (F6 || CV6) acc[ai][bj][m][n] = __builtin_amdgcn_mfma_scale_f32_16x16x128_f8f6f4(cat8(Bt[n][0], Bt[n][1]), cat8(At[m][0], At[m][1]), acc[ai][bj][m][n], 2, 2, 0, 0x7f7f7f7f, 0, 0x7f7f7f7f); \
        else if constexpr (F8) acc[ai][bj][m][n] = __builtin_amdgcn_mfma_scale_f32_16x16x128_f8f6f4(cat8(Bt[n][0], Bt[n][1]), cat8(At[m][0], At[m][1]), acc[ai][bj][m][n], 0, 0, 0, 0x7f7f7f7f, 0, 0x7f7f7f7f); \
        else if constexpr (F16) { _Pragma("unroll") for (int k = 0; k < 2; ++k) acc[ai][bj][m][n] = __builtin_amdgcn_mfma_f32_16x16x32_f16(__builtin_bit_cast(f16x8_t, Bt[n][k]), __builtin_bit_cast(f16x8_t, At[m][k]), acc[ai][bj][m][n], 0, 0, 0); } \
        else { _Pragma("unroll") for (int k = 0; k < 2; ++k) acc[ai][bj][m][n] = __builtin_amdgcn_mfma_f32_16x16x32_bf16(Bt[n][k], At[m][k], acc[ai][bj][m][n], 0, 0, 0); } } __builtin_amdgcn_s_setprio(0); } while (0)
#define PG8_ST1(bufoff, goff, voff, _i) do { __builtin_amdgcn_raw_ptr_buffer_load_lds(((voff) == voffA) ? rsrcA : rsrcB, (PG8_LAS void*)(lds + (bufoff) + ldsw + (_i) * 8192), 16, (int)(voff)[_i], (int)(goff), 0, 0); PG8_SCHED; } while (0)
#define PG8_MMQ(ai, bj, m, At, Bt) do { _Pragma("unroll") for (int n = 0; n < 2; ++n) { \
        if constexpr (F6 || CV6) acc[ai][bj][m][n] = __builtin_amdgcn_mfma_scale_f32_16x16x128_f8f6f4(cat8(Bt[n][0], Bt[n][1]), cat8(At[m][0], At[m][1]), acc[ai][bj][m][n], 2, 2, 0, 0x7f7f7f7f, 0, 0x7f7f7f7f); \
        else if constexpr (F8) acc[ai][bj][m][n] = __builtin_amdgcn_mfma_scale_f32_16x16x128_f8f6f4(cat8(Bt[n][0], Bt[n][1]), cat8(At[m][0], At[m][1]), acc[ai][bj][m][n], 0, 0, 0, 0x7f7f7f7f, 0, 0x7f7f7f7f); \
        else if constexpr (F16) { _Pragma("unroll") for (int k = 0; k < 2; ++k) acc[ai][bj][m][n] = __builtin_amdgcn_mfma_f32_16x16x32_f16(__builtin_bit_cast(f16x8_t, Bt[n][k]), __builtin_bit_cast(f16x8_t, At[m][k]), acc[ai][bj][m][n], 0, 0, 0); } \
        else { _Pragma("unroll") for (int k = 0; k < 2; ++k) acc[ai][bj][m][n] = __builtin_amdgcn_mfma_f32_16x16x32_bf16(Bt[n][k], At[m][k], acc[ai][bj][m][n], 0, 0, 0); } } PG8_SCHED; } while (0)
#define PG8_BLK1(At, B0, B1, buf, goff, voff) do { __builtin_amdgcn_s_setprio(1); PG8_MMQ(0, 0, 0, At, B0); PG8_MMQ(0, 0, 1, At, B0); PG8_ST1(buf, goff, voff, 0); PG8_MMQ(0, 0, 2, At, B0); PG8_MMQ(0, 0, 3, At, B0); PG8_ST1(buf, goff, voff, 1); \
        PG8_MMQ(0, 1, 0, At, B1); PG8_MMQ(0, 1, 1, At, B1); PG8_MMQ(0, 1, 2, At, B1); PG8_MMQ(0, 1, 3, At, B1); __builtin_amdgcn_s_setprio(0); } while (0)
#define PG8_BLK2(At, B0, B1, buf0, goff0, voff0, buf1, goff1, voff1, buf2, goff2, voff2) do { __builtin_amdgcn_s_setprio(1); PG8_MMQ(1, 0, 0, At, B0); PG8_ST1(buf0, goff0, voff0, 0); PG8_MMQ(1, 0, 1, At, B0); PG8_ST1(buf0, goff0, voff0, 1); \
        PG8_MMQ(1, 0, 2, At, B0); PG8_ST1(buf1, goff1, voff1, 0); PG8_MMQ(1, 0, 3, At, B0); PG8_ST1(buf1, goff1, voff1, 1); PG8_MMQ(1, 1, 0, At, B1); PG8_ST1(buf2, goff2, voff2, 0); PG8_MMQ(1, 1, 1, At, B1); PG8_ST1(buf2, goff2, voff2, 1); \
        PG8_MMQ(1, 1, 2, At, B1); PG8_MMQ(1, 1, 3, At, B1); __builtin_amdgcn_s_setprio(0); } while (0)
#define PG8_BLK2H(At, B0, B1, buf1, goff1, voff1, buf2, goff2, voff2) do { __builtin_amdgcn_s_setprio(1); PG8_MMQ(1, 0, 0, At, B0); PG8_MMQ(1, 0, 1, At, B0); PG8_ST1(buf1, goff1, voff1, 1); \
        PG8_MMQ(1, 0, 2, At, B0); PG8_MMQ(1, 0, 3, At, B0); PG8_ST1(buf2, goff2, voff2, 0); PG8_MMQ(1, 1, 0, At, B1); PG8_MMQ(1, 1, 1, At, B1); PG8_ST1(buf2, goff2, voff2, 1); \
        PG8_MMQ(1, 1, 2, At, B1); PG8_MMQ(1, 1, 3, At, B1); __builtin_amdgcn_s_setprio(0); } while (0)
#ifndef PG8_DMI
#define PG8_DMI 0
#endif
#define PG8_WAIT_V(n) asm volatile("s_waitcnt vmcnt(" #n ")" ::: "memory")
#define PG8_WAIT_L(n) asm volatile("s_waitcnt lgkmcnt(" #n ")" ::: "memory")
#define PG8_BAR __builtin_amdgcn_s_barrier()
#define PG8_SCHED __builtin_amdgcn_sched_barrier(0)
    Unit cur, nxt; int ui = 0;
    if (!S.next(0, cur)) return;
    f32x4 acc[2][2][4][2];
#pragma unroll
    for (int a = 0; a < 2; ++a)
#pragma unroll
        for (int b = 0; b < 2; ++b)
#pragma unroll
            for (int m = 0; m < 4; ++m)
#pragma unroll
                for (int n = 0; n < 2; ++n) acc[a][b][m][n] = (f32x4){0.f, 0.f, 0.f, 0.f};
    bf16x8 At[4][2], B0[2][2], B1[2][2];
    unsigned cA = (unsigned)((size_t)cur.pm * tstepA), cB = (unsigned)((size_t)cur.pn * tstep);
    S.a_ready(cur);
    if constexpr (Epi::PF) E.pf(cur, wid, lane, lds + 133120);
    if constexpr (SP2) {
        PG8_STAGE(PG8_SB(0, 0), cB, voffB); PG8_STAGE(PG8_SB(0, 1), cB + hstep, voffB); PG8_STAGE(PG8_SA(0, 0), cA, voffA); PG8_STAGE(PG8_SA(0, 1), cA + hstepA, voffA);
        if (wr == 1) PG8_BAR;
        PG8_WAIT_V(2); PG8_BAR;
        PG8_STAGE(PG8_SB(1, 0), cB + kstep, voffB); PG8_STAGE(PG8_SA(1, 0), cA + kstep, voffA); PG8_STAGE(PG8_SB(1, 1), cB + hstep + kstep, voffB);
        PG8_WAIT_V(6); PG8_BAR;
    } else {
        PG8_STAGE(PG8_SB(0, 0), cB, voffB); PG8_STAGE(PG8_SA(0, 0), cA, voffA); PG8_STAGE(PG8_SB(0, 1), cB + hstep, voffB); PG8_STAGE(PG8_SA(0, 1), cA + hstepA, voffA);
        if (wr == 1) PG8_BAR;
        PG8_WAIT_V(4); PG8_BAR;
        PG8_STAGE(PG8_SB(1, 0), cB + kstep, voffB); PG8_STAGE(PG8_SA(1, 0), cA + kstep, voffA); PG8_STAGE(PG8_SB(1, 1), cB + hstep + kstep, voffB);
        PG8_WAIT_V(6); PG8_BAR;
    }
    for (;;) {
        const bool has_next = S.next(ui + 1, nxt);
        const unsigned nA = has_next ? (unsigned)((size_t)nxt.pm * tstepA) : cA, nB = has_next ? (unsigned)((size_t)nxt.pn * tstep) : cB;
        for (int t = 0; t < nt; t += 2) {
            const bool last = (t == nt - 2);
            const unsigned a1 = cA + (unsigned)((t + 1) * kstep);
            const unsigned a2 = last ? nA : cA + (unsigned)((t + 2) * kstep), b2 = last ? nB : cB + (unsigned)((t + 2) * kstep);
            const unsigned a3 = a2 + (unsigned)kstep, b3 = b2 + (unsigned)kstep;
            if (last && has_next) S.a_ready(nxt);
            if constexpr (Epi::MIDK > 0) { if (t == Epi::MIDK) E.midk(acc, cur, wr, wc, lane & 15, lane >> 4); }
            if constexpr (SP2 && PG8_DMI == 2 && MREP == 1) {
            PG8_LDB(B0, 0, 0); PG8_LDB(B1, 0, 1); PG8_SCHED; PG8_LDA(At, 0, 0); PG8_STAGE(PG8_SA(1, 1), a1 + hstepA, voffA);
            PG8_WAIT_V(8); PG8_WAIT_L(0); PG8_BAR; PG8_MMA(0, 0, At, B0); PG8_MMA(0, 1, At, B1); PG8_BAR; PG8_SCHED;
            PG8_LDA(At, 0, 1); PG8_STAGE(PG8_SB(0, 0), b2, voffB); PG8_ST1(PG8_SB(0, 1), b2 + hstep, voffB, 0);
            PG8_WAIT_V(5); PG8_WAIT_L(0); PG8_BAR; PG8_BLK2H(At, B0, B1, PG8_SB(0, 1), b2 + hstep, voffB, PG8_SA(0, 0), a2, voffA); PG8_BAR; PG8_SCHED;
            PG8_LDB(B0, 1, 0); PG8_LDB(B1, 1, 1); PG8_SCHED; PG8_LDA(At, 1, 0); PG8_STAGE(PG8_SA(0, 1), a2 + hstepA, voffA);
            PG8_WAIT_V(8); PG8_WAIT_L(0); PG8_BAR; PG8_MMA(0, 0, At, B0); PG8_MMA(0, 1, At, B1); PG8_BAR; PG8_SCHED;
            PG8_LDA(At, 1, 1); PG8_STAGE(PG8_SB(1, 0), b3, voffB); PG8_ST1(PG8_SB(1, 1), b3 + hstep, voffB, 0);
            PG8_WAIT_V(5); PG8_WAIT_L(0); PG8_BAR; PG8_BLK2H(At, B0, B1, PG8_SB(1, 1), b3 + hstep, voffB, PG8_SA(1, 0), a3, voffA); PG8_BAR; PG8_SCHED;
            } else if constexpr (SP2 && PG8_DMI == 1 && MREP == 1) {
            PG8_LDB(B0, 0, 0); PG8_LDB(B1, 0, 1); PG8_SCHED; PG8_LDA(At, 0, 0);
            PG8_WAIT_V(6); PG8_WAIT_L(0); PG8_BAR; PG8_BLK1(At, B0, B1, PG8_SA(1, 1), a1 + hstepA, voffA); PG8_BAR; PG8_SCHED;
            PG8_LDA(At, 0, 1);
            PG8_WAIT_V(2); PG8_WAIT_L(0); PG8_BAR; PG8_BLK2(At, B0, B1, PG8_SB(0, 0), b2, voffB, PG8_SB(0, 1), b2 + hstep, voffB, PG8_SA(0, 0), a2, voffA); PG8_BAR; PG8_SCHED;
            PG8_LDB(B0, 1, 0); PG8_LDB(B1, 1, 1); PG8_SCHED; PG8_LDA(At, 1, 0);
            PG8_WAIT_V(6); PG8_WAIT_L(0); PG8_BAR; PG8_BLK1(At, B0, B1, PG8_SA(0, 1), a2 + hstepA, voffA); PG8_BAR; PG8_SCHED;
            PG8_LDA(At, 1, 1);
            PG8_WAIT_V(2); PG8_WAIT_L(0); PG8_BAR; PG8_BLK2(At, B0, B1, PG8_SB(1, 0), b3, voffB, PG8_SB(1, 1), b3 + hstep, voffB, PG8_SA(1, 0), a3, voffA); PG8_BAR; PG8_SCHED;
            } else if constexpr (SP2) {
            PG8_LDB(B0, 0, 0); PG8_LDB(B1, 0, 1); PG8_SCHED; PG8_LDA(At, 0, 0); PG8_STAGE(PG8_SA(1, 1), a1 + hstepA, voffA);
            PG8_WAIT_V(8); PG8_WAIT_L(0); PG8_BAR; PG8_MMA(0, 0, At, B0); PG8_MMA(0, 1, At, B1); PG8_BAR; PG8_SCHED;
            PG8_LDA(At, 0, 1); PG8_STAGE(PG8_SB(0, 0), b2, voffB); PG8_STAGE(PG8_SB(0, 1), b2 + hstep, voffB); PG8_STAGE(PG8_SA(0, 0), a2, voffA);
            PG8_WAIT_V(8); PG8_WAIT_L(0); PG8_BAR; PG8_MMA(1, 0, At, B0); PG8_MMA(1, 1, At, B1); PG8_BAR; PG8_SCHED;
            PG8_LDB(B0, 1, 0); PG8_LDB(B1, 1, 1); PG8_SCHED; PG8_LDA(At, 1, 0); PG8_STAGE(PG8_SA(0, 1), a2 + hstepA, voffA);
            PG8_WAIT_V(8); PG8_WAIT_L(0); PG8_BAR; PG8_MMA(0, 0, At, B0); PG8_MMA(0, 1, At, B1); PG8_BAR; PG8_SCHED;
            PG8_LDA(At, 1, 1); PG8_STAGE(PG8_SB(1, 0), b3, voffB); PG8_STAGE(PG8_SB(1, 1), b3 + hstep, voffB); PG8_STAGE(PG8_SA(1, 0), a3, voffA);
            PG8_WAIT_V(8); PG8_WAIT_L(0); PG8_BAR; PG8_MMA(1, 0, At, B0); PG8_MMA(1, 1, At, B1); PG8_BAR; PG8_SCHED;
            } else {
            PG8_LDB(B0, 0, 0); PG8_SCHED; PG8_LDA(At, 0, 0); PG8_STAGE(PG8_SA(1, 1), a1 + hstepA, voffA);
            PG8_WAIT_L(8); PG8_BAR; PG8_WAIT_L(0); PG8_MMA(0, 0, At, B0); PG8_BAR; PG8_SCHED;
            PG8_LDB(B1, 0, 1); PG8_STAGE(PG8_SB(0, 0), b2, voffB);
            PG8_BAR; PG8_WAIT_L(0); PG8_MMA(0, 1, At, B1); PG8_BAR;
            PG8_LDA(At, 0, 1); PG8_STAGE(PG8_SA(0, 0), a2, voffA);
            PG8_BAR; PG8_WAIT_L(0); PG8_MMA(1, 0, At, B0); PG8_BAR; PG8_SCHED;
            PG8_STAGE(PG8_SB(0, 1), b2 + hstep, voffB);
            PG8_WAIT_V(6); PG8_BAR; PG8_MMA(1, 1, At, B1); PG8_BAR;
            PG8_LDB(B0, 1, 0); PG8_SCHED; PG8_LDA(At, 1, 0); PG8_STAGE(PG8_SA(0, 1), a2 + hstepA, voffA);
            PG8_WAIT_L(8); PG8_BAR; PG8_WAIT_L(0); PG8_MMA(0, 0, At, B0); PG8_BAR; PG8_SCHED;
            PG8_LDB(B1, 1, 1); PG8_STAGE(PG8_SB(1, 0), b3, voffB);
            PG8_BAR; PG8_WAIT_L(0); PG8_MMA(0, 1, At, B1); PG8_BAR;
            PG8_LDA(At, 1, 1); PG8_STAGE(PG8_SA(1, 0), a3, voffA);
            PG8_BAR; PG8_WAIT_L(0); PG8_MMA(1, 0, At, B0); PG8_BAR; PG8_SCHED;
            PG8_STAGE(PG8_SB(1, 1), b3 + hstep, voffB);
            PG8_WAIT_V(6); PG8_BAR; PG8_MMA(1, 1, At, B1); PG8_BAR;
            }
        }
        if constexpr (ALIGN_EPI) { if (wr == 0) PG8_BAR; }
        if constexpr (!Epi::AFTER_DRAIN) { const int l2 = lane_now(); if constexpr (Epi::PF) { if (has_next) E.pf(nxt, wid, l2, lds + 133120); } E(acc, cur, wr, wc, l2 & 15, l2 >> 4); S.done(cur); }
        if (!has_next) break;
#pragma unroll
        for (int a = 0; a < 2; ++a)
#pragma unroll
            for (int b = 0; b < 2; ++b)
#pragma unroll
                for (int m = 0; m < 4; ++m)
#pragma unroll
                    for (int n = 0; n < 2; ++n) acc[a][b][m][n] = (f32x4){0.f, 0.f, 0.f, 0.f};
        cur = nxt; cA = nA; cB = nB; ++ui;
        if constexpr (ALIGN_EPI) { if (wr == 1) PG8_BAR; }
    }
    PG8_WAIT_V(0);
    if constexpr (!ALIGN_EPI) { if (wr == 0) PG8_BAR; }
    PG8_BAR;
    if constexpr (Epi::AFTER_DRAIN) { E.fused(acc, cur, wr, wc, fr, fq, lds, wid, lane); S.done(cur); }
#undef PG8_SA
#undef PG8_SB
#undef PG8_STAGE
#undef PG8_LD6
#undef PG8_CV6
#undef PG8_LDA
#undef PG8_LDB
#undef PG8_MMA
#undef PG8_ST1
#undef PG8_MMQ
#undef PG8_BLK1
#undef PG8_BLK2
#undef PG8_BLK2H
#undef PG8_WAIT_V
#undef PG8_WAIT_L
#undef PG8_BAR
#undef PG8_SCHED
}
}
#define LAS __attribute__((address_space(3)))
typedef unsigned short bf16;
typedef unsigned v4u __attribute__((ext_vector_type(4)));
typedef unsigned v2u __attribute__((ext_vector_type(2)));
typedef float f32x4 __attribute__((ext_vector_type(4)));
typedef float f32x2 __attribute__((ext_vector_type(2)));
typedef short bf16x8 __attribute__((ext_vector_type(8)));
using pg8::shx; using pg8::shl;
#define LDS_WAIT() asm volatile("s_waitcnt lgkmcnt(0)" ::: "memory")
__device__ __forceinline__ unsigned f2bf(float f) { unsigned u = __builtin_bit_cast(unsigned, f); return (u + 0x7fffu + ((u >> 16) & 1u)) >> 16; }
__device__ __forceinline__ unsigned pk2(float lo, float hi) { return pg8::cvt_pk_bf16(lo, hi); }
__device__ __forceinline__ float bf_lo(unsigned w) { return __uint_as_float(w << 16); }
__device__ __forceinline__ float bf_hi(unsigned w) { return __uint_as_float(w & 0xffff0000u); }
__device__ __forceinline__ float sigmoid_f(float v) { return __builtin_amdgcn_rcpf(1.0f + __builtin_amdgcn_exp2f(v * -1.4426950408889634f)); }
__device__ __forceinline__ float gelu_tanh(float x) { const float y = 0.7978845608028654f * (x + 0.044715f * x * x * x); const float th = 1.0f - 2.0f * __builtin_amdgcn_rcpf(1.0f + __builtin_amdgcn_exp2f(2.885390081777927f * y)); return 0.5f * x * (1.0f + th); }
#define XB_TMO      128
#define XB_XCNT(j)  (256  + 64 * (j))
#define XB_XSUB(j)  (1280 + 64 * (j))
#define XB_XGEN(j)  (2304 + 64 * (j))
#define XB_TOP      3328
#define XB_TOPGEN   3392
#define XCD_BAR_WORDS 3456
#define XB_SPIN_CAP (1u << 18)

__device__ __forceinline__ unsigned xb_ld(unsigned* p)              { return __hip_atomic_load(p, __ATOMIC_RELAXED, __HIP_MEMORY_SCOPE_AGENT); }
__device__ __forceinline__ unsigned xb_add(unsigned* p, unsigned v) { return __hip_atomic_fetch_add(p, v, __ATOMIC_RELAXED, __HIP_MEMORY_SCOPE_AGENT); }
__device__ __forceinline__ unsigned xb_xcc_id() { return (unsigned)__builtin_amdgcn_s_getreg((3 << 11) | 20) & 0xFu; }
#define XB_SPIN(cond, bar) do { unsigned _sp = 0; while (cond) { __builtin_amdgcn_s_sleep(1); \
    if ((++_sp & 255u) == 0u) { if (xb_ld(&(bar)[XB_TMO])) break; if (_sp > XB_SPIN_CAP) { atomicAdd(&(bar)[XB_TMO], 1u); break; } } } } while (0)

struct XcdBarrier {
    unsigned* bar; unsigned x;
    volatile LAS unsigned* st;
};

__device__ __forceinline__ XcdBarrier xcd_barrier_post(unsigned* bar, volatile LAS unsigned* st) {
    XcdBarrier b; b.bar = bar; b.x = xb_xcc_id(); b.st = st;
    if (threadIdx.x == 0) (void)xb_add(&bar[XB_XCNT(b.x)], 1u);
    return b;
}
__device__ __forceinline__ void xcd_barrier_complete(unsigned* bar, unsigned x, unsigned& nloc, unsigned& nx) {
    const unsigned G = gridDim.x * gridDim.y * gridDim.z;
    unsigned sum, cnt, mine, sp = 0u;
    for (;;) {
        sum = 0u; cnt = 0u; mine = 0u;
#pragma unroll
        for (unsigned j = 0; j < 16; ++j) { const unsigned c = xb_ld(&bar[XB_XCNT(j)]); sum += c; cnt += (c > 0u) ? 1u : 0u; mine = (j == x) ? c : mine; }
        if (sum == G) break;
        __builtin_amdgcn_s_sleep(1);
        if ((++sp & 255u) == 0u) { if (xb_ld(&bar[XB_TMO])) break; if (sp > XB_SPIN_CAP) { atomicAdd(&bar[XB_TMO], 1u); break; } }
    }
    nloc = mine > 0u ? mine : 1u; nx = cnt > 0u ? cnt : 1u;
}

__device__ __forceinline__ void xcd_barrier(const XcdBarrier& b) {
    asm volatile("s_waitcnt vmcnt(0)" ::: "memory");
    __syncthreads();
    if (threadIdx.x == 0) {
        unsigned* bar = b.bar;
        __builtin_amdgcn_s_waitcnt(0);
        unsigned nloc = b.st[0], nx = b.st[1];
        if (nloc == 0u) { xcd_barrier_complete(bar, b.x, nloc, nx); b.st[0] = nloc; b.st[1] = nx; }
        const unsigned old = xb_add(&bar[XB_XSUB(b.x)], 1u);
        const unsigned gen = old / nloc;
        if (old + 1u == (gen + 1u) * nloc) {
            __builtin_amdgcn_fence(__ATOMIC_RELEASE, "agent");
            asm volatile("s_waitcnt vmcnt(0)" ::: "memory");
            const unsigned og = xb_add(&bar[XB_TOP], 1u);
            const unsigned tg = og / nx;
            if (og + 1u == (tg + 1u) * nx) xb_add(&bar[XB_TOPGEN], 1u);
            else XB_SPIN(xb_ld(&bar[XB_TOPGEN]) == tg, bar);
            __builtin_amdgcn_fence(__ATOMIC_ACQUIRE, "agent");
            xb_add(&bar[XB_XGEN(b.x)], 1u);
            asm volatile("s_waitcnt vmcnt(0)" ::: "memory");
        } else {
            XB_SPIN(xb_ld(&bar[XB_XGEN(b.x)]) == gen, bar);
            __builtin_amdgcn_fence(__ATOMIC_ACQUIRE, "agent");
            asm volatile("s_waitcnt vmcnt(0)" ::: "memory");
        }
    }
    __syncthreads();
}

typedef short v4i16_t __attribute__((ext_vector_type(4)));
struct AttTile { int r, dsh, L, pq0, tq0, tq1; };
template <int NT> __device__ __forceinline__ void att_load_qk(const bf16* Z, const AttTile& t, int tok0, int s0, int h, int c, int g, bf16x8 (&Qn)[4], bf16x8 (&Kn)[10][2]) {
    const __amdgpu_buffer_rsrc_t rz = __builtin_amdgcn_make_buffer_rsrc((void*)Z, 0, 0x7fffffff, 0x00020000);
    { const unsigned zq = (unsigned)(tok0 + t.tq0) * (unsigned)(NIN * 2) + (unsigned)(ZQ + h * 64 + 8 * g) * 2u; Qn[0] = __builtin_bit_cast(bf16x8, __builtin_amdgcn_raw_buffer_load_b128(rz, (int)(zq), 0, 0)); Qn[1] = __builtin_bit_cast(bf16x8, __builtin_amdgcn_raw_buffer_load_b128(rz, (int)(zq + 64u), 0, 0)); }
    if (NT == 2) { const unsigned zq = (unsigned)(tok0 + t.tq1) * (unsigned)(NIN * 2) + (unsigned)(ZQ + h * 64 + 8 * g) * 2u; Qn[2] = __builtin_bit_cast(bf16x8, __builtin_amdgcn_raw_buffer_load_b128(rz, (int)(zq), 0, 0)); Qn[3] = __builtin_bit_cast(bf16x8, __builtin_amdgcn_raw_buffer_load_b128(rz, (int)(zq + 64u), 0, 0)); }
    if (t.pq0 >= 64 && t.pq0 + 96 <= t.L) {
        unsigned zk = (unsigned)(s0 + t.r + ((t.pq0 - 64 + c) << t.dsh)) * (unsigned)(NIN * 2) + (unsigned)(ZK + h * 64 + 8 * g) * 2u; const unsigned step = (16u << t.dsh) * (unsigned)(NIN * 2);
#pragma unroll
        for (int kt = 0; kt < 8 + NT; ++kt) { Kn[kt][0] = __builtin_bit_cast(bf16x8, __builtin_amdgcn_raw_buffer_load_b128(rz, (int)(zk), 0, 0)); Kn[kt][1] = __builtin_bit_cast(bf16x8, __builtin_amdgcn_raw_buffer_load_b128(rz, (int)(zk + 64u), 0, 0)); zk += step; }
    } else {
        const unsigned lb = (unsigned)(s0 + t.r + (c << t.dsh)) * (unsigned)(NIN * 2) + (unsigned)(ZK + h * 64 + 8 * g) * 2u;
#pragma unroll
        for (int kt = 0; kt < 8 + NT; ++kt) { int pb = t.pq0 - 64 + 16 * kt; pb = pb < 0 ? 0 : (pb > t.L - 16 ? t.L - 16 : pb); pb = __builtin_amdgcn_readfirstlane(pb);
            const unsigned zk = lb + (unsigned)(pb << t.dsh) * (unsigned)(NIN * 2); Kn[kt][0] = __builtin_bit_cast(bf16x8, __builtin_amdgcn_raw_buffer_load_b128(rz, (int)(zk), 0, 0)); Kn[kt][1] = __builtin_bit_cast(bf16x8, __builtin_amdgcn_raw_buffer_load_b128(rz, (int)(zk + 64u), 0, 0)); } }
}
template <int NT, int NTN> __device__ __forceinline__ void att_stage(const bf16* Z, const AttTile& t, const AttTile& tn, bool init, int tok0, int s0, int h, int lane_ph, LAS unsigned char* vb, LAS float* Os, LAS float* ms, LAS float* ls,
                                                                      bf16x8 (&Qn)[4], bf16x8 (&Kn)[10][2]) {
    const __amdgpu_buffer_rsrc_t rz = __builtin_amdgcn_make_buffer_rsrc((void*)Z, 0, 0x7fffffff, 0x00020000);
    int lane = lane_ph; asm volatile("" : "+v"(lane));
    const int c = lane & 15, g = lane >> 4;
    constexpr float SC = 0.125f * 1.4426950408889634f;
    f32x4 sc[NT][10];
#pragma unroll
    for (int kt = 0; kt < 9; ++kt) {
#pragma unroll
        for (int q = 0; q < NT; ++q) { f32x4 a = {0.f, 0.f, 0.f, 0.f};
            a = __builtin_amdgcn_mfma_f32_16x16x32_bf16(Kn[kt + q][0], Qn[2 * q], a, 0, 0, 0); a = __builtin_amdgcn_mfma_f32_16x16x32_bf16(Kn[kt + q][1], Qn[2 * q + 1], a, 0, 0, 0); sc[q][kt] = a; } }
#pragma unroll
    for (int q = 0; q < NT; ++q) sc[q][9] = (f32x4){-1e30f, -1e30f, -1e30f, -1e30f};
    __builtin_amdgcn_sched_barrier(0);
    v4u vv[5][4];
    if (t.pq0 >= 64 && t.pq0 + 96 <= t.L) {
        unsigned zv = (unsigned)(s0 + t.r + ((t.pq0 - 64 + (lane >> 3)) << t.dsh)) * (unsigned)(NIN * 2) + (unsigned)(ZV + h * 64 + 8 * (lane & 7)) * 2u; const unsigned step = (8u << t.dsh) * (unsigned)(NIN * 2);
#pragma unroll
        for (int s = 0; s < 5; ++s)
#pragma unroll
            for (int i = 0; i < 4; ++i) { vv[s][i] = __builtin_amdgcn_raw_buffer_load_b128(rz, (int)zv, 0, 0); zv += step; }
    } else { const unsigned lb = (unsigned)(s0 + t.r + ((lane >> 3) << t.dsh)) * (unsigned)(NIN * 2) + (unsigned)(ZV + h * 64 + 8 * (lane & 7)) * 2u;
#pragma unroll
        for (int s = 0; s < 5; ++s)
#pragma unroll
            for (int i = 0; i < 4; ++i) { int pb = t.pq0 - 64 + 32 * s + 8 * i; pb = pb < 0 ? 0 : (pb > t.L - 8 ? t.L - 8 : pb); pb = __builtin_amdgcn_readfirstlane(pb);
                vv[s][i] = __builtin_amdgcn_raw_buffer_load_b128(rz, (int)(lb + (unsigned)(pb << t.dsh) * (unsigned)(NIN * 2)), 0, 0); } }
    float mx[NT], lsum[NT];
#pragma unroll
    for (int q = 0; q < NT; ++q) { const int pq = t.pq0 + 16 * q; float m = -1e30f;
        if (pq >= 64 && pq + 80 <= t.L) {
#pragma unroll
            for (int kt = 0; kt < 9; ++kt)
#pragma unroll
                for (int rr = 0; rr < 4; ++rr) { const int kk = 16 * kt + 4 * g + rr;
                    if (kt == 0) sc[q][kt][rr] = kk >= c ? sc[q][kt][rr] : -1e30f;
                    if (kt == 8) sc[q][kt][rr] = kk <= c + 128 ? sc[q][kt][rr] : -1e30f;
                    m = fmaxf(m, sc[q][kt][rr]); }
        } else {
#pragma unroll
            for (int kt = 0; kt < 9; ++kt) { const int pb = pq - 64 + 16 * kt; const bool tin = __builtin_amdgcn_readfirstlane((int)(pb >= 0 && pb < t.L)) != 0;
#pragma unroll
                for (int rr = 0; rr < 4; ++rr) { const int kk = 16 * kt + 4 * g + rr;
                    if (kt == 0) sc[q][kt][rr] = kk >= c ? sc[q][kt][rr] : -1e30f;
                    if (kt == 8) sc[q][kt][rr] = kk <= c + 128 ? sc[q][kt][rr] : -1e30f;
                    sc[q][kt][rr] = tin ? sc[q][kt][rr] : -1e30f;
                    m = fmaxf(m, sc[q][kt][rr]); } } }
        m = fmaxf(m, shx(m, 16, lane)); m = fmaxf(m, shx(m, 32, lane)); mx[q] = m;
        const float nm = -m * SC; f32x4 l4 = {0.f, 0.f, 0.f, 0.f};
#pragma unroll
        for (int kt = 0; kt < 9; ++kt) { const f32x4 z = sc[q][kt] * SC + nm; f32x4 p4;
#pragma unroll
            for (int rr = 0; rr < 4; ++rr) p4[rr] = __builtin_amdgcn_exp2f(z[rr]);
            sc[q][kt] = p4; l4 = l4 + p4; }
        sc[q][9] = (f32x4){0.f, 0.f, 0.f, 0.f};
        float l = (l4[0] + l4[1]) + (l4[2] + l4[3]);
        l += shx(l, 16, lane); l += shx(l, 32, lane); lsum[q] = l; }
    f32x4 o[NT][4];
#pragma unroll
    for (int q = 0; q < NT; ++q)
#pragma unroll
        for (int dt = 0; dt < 4; ++dt) o[q][dt] = (f32x4){0.f, 0.f, 0.f, 0.f};
#pragma unroll
    for (int s = 0; s < 5; ++s) {
        asm volatile("s_waitcnt lgkmcnt(0)" ::: "memory");
#pragma unroll
        for (int i = 0; i < 4; ++i) *(LAS v4u*)(vb + ((lane >> 3) + 8 * i) * 144 + 16 * (lane & 7)) = vv[s][i];
        asm volatile("s_waitcnt lgkmcnt(0)" ::: "memory");
        if (s == 4 && NTN > 0) att_load_qk<NTN ? NTN : 1>(Z, tn, tok0, s0, h, c, g, Qn, Kn);
        bf16x8 af[4];
#pragma unroll
        for (int dt = 0; dt < 4; ++dt) {
            LAS unsigned char* p0 = vb + (4 * g + (c >> 2)) * 144 + (16 * dt + 4 * (c & 3)) * 2;
            const v4i16_t lo = __builtin_amdgcn_ds_read_tr16_b64_v4i16((LAS v4i16_t*)p0), hi = __builtin_amdgcn_ds_read_tr16_b64_v4i16((LAS v4i16_t*)(p0 + 16 * 144));
            af[dt][0] = lo[0]; af[dt][1] = lo[1]; af[dt][2] = lo[2]; af[dt][3] = lo[3]; af[dt][4] = hi[0]; af[dt][5] = hi[1]; af[dt][6] = hi[2]; af[dt][7] = hi[3]; }
#pragma unroll
        for (int q = 0; q < NT; ++q) {
            union { unsigned u[4]; bf16x8 v; } pf;
            if (q == 1 && s == 0) { pf.u[0] = 0u; pf.u[1] = 0u; } else { pf.u[0] = pg8::cvt_pk_bf16(sc[q][2 * s - q][0], sc[q][2 * s - q][1]); pf.u[1] = pg8::cvt_pk_bf16(sc[q][2 * s - q][2], sc[q][2 * s - q][3]); }
            pf.u[2] = pg8::cvt_pk_bf16(sc[q][2 * s + 1 - q][0], sc[q][2 * s + 1 - q][1]); pf.u[3] = pg8::cvt_pk_bf16(sc[q][2 * s + 1 - q][2], sc[q][2 * s + 1 - q][3]);
#pragma unroll
            for (int dt = 0; dt < 4; ++dt) o[q][dt] = __builtin_amdgcn_mfma_f32_16x16x32_bf16(af[dt], pf.v, o[q][dt], 0, 0, 0); }
    }
#pragma unroll
    for (int q = 0; q < NT; ++q) { const int tq = q ? t.tq1 : t.tq0; LAS float* orow = Os + tq * 68 + 4 * g;
        if (init) {
#pragma unroll
            for (int dt = 0; dt < 4; ++dt) *(LAS f32x4*)(orow + 16 * dt) = o[q][dt];
            if (g == 0) { ms[tq] = mx[q]; ls[tq] = lsum[q]; }
        } else {
            const float m_s = ms[tq], l_s = ls[tq]; const float mn = fmaxf(m_s, mx[q]); const float a = __builtin_amdgcn_exp2f((m_s - mn) * SC), b = __builtin_amdgcn_exp2f((mx[q] - mn) * SC);
#pragma unroll
            for (int dt = 0; dt < 4; ++dt) { const f32x4 os = *(const LAS f32x4*)(orow + 16 * dt); *(LAS f32x4*)(orow + 16 * dt) = os * a + o[q][dt] * b; }
            asm volatile("s_waitcnt lgkmcnt(0)" ::: "memory");
            if (g == 0) { ms[tq] = mn; ls[tq] = l_s * a + lsum[q] * b; }
        } }
}
__device__ __forceinline__ void attn_mfma_phase(LAS unsigned char* lds, bf16* Z, float* ssq, int blk, int G, int tid, int wave, int lane_ph, bf16* dummy = nullptr) {
    LAS float* Os = (LAS float*)lds;
    LAS float* ms = (LAS float*)(lds + 69632);
    LAS float* ls = (LAS float*)(lds + 70656);
    LAS unsigned char* vb = lds + 71680 + wave * 4608;
    const int c = lane_ph & 15, g = lane_ph >> 4;
    for (int unit = blk; unit < (T / 256) * 12; unit += G) {
        const int tb = unit / 12, h = unit % 12;
        const int tok0 = 256 * tb; const int s0 = tok0 < TPR ? (tok0 & ~4095) : TPR; const int S = tok0 < TPR ? 4096 : 16384; const int B0 = tok0 - s0;
        __syncthreads();
        const AttTile t0{0, 0, S, B0 + 32 * wave, 32 * wave + c, 32 * wave + 16 + c};
        const AttTile t1{wave & 3, 2, S >> 2, (B0 >> 2) + 32 * (wave >> 2), (wave & 3) + 128 * (wave >> 2) + 4 * c, (wave & 3) + 128 * (wave >> 2) + 64 + 4 * c};
        const AttTile t2{2 * wave, 4, S >> 4, B0 >> 4, 2 * wave + 16 * c, 0};
        const AttTile t3{2 * wave + 1, 4, S >> 4, B0 >> 4, 2 * wave + 1 + 16 * c, 0};
        bf16x8 Qn[4], Kn[10][2];
        att_load_qk<2>(Z, t0, tok0, s0, h, c, g, Qn, Kn);
        att_stage<2, 2>(Z, t0, t1, true, tok0, s0, h, lane_ph, vb, Os, ms, ls, Qn, Kn);
        __syncthreads();
        att_stage<2, 1>(Z, t1, t2, false, tok0, s0, h, lane_ph, vb, Os, ms, ls, Qn, Kn);
        __syncthreads();
        att_stage<1, 1>(Z, t2, t3, false, tok0, s0, h, lane_ph, vb, Os, ms, ls, Qn, Kn);
        att_stage<1, 0>(Z, t3, t3, false, tok0, s0, h, lane_ph, vb, Os, ms, ls, Qn, Kn);
        __syncthreads();
#pragma unroll
        for (int i = 0; i < 4; ++i) { const int item = tid + 512 * i, tk = item >> 3, ch = item & 7;
            const float inv = __builtin_amdgcn_rcpf(ls[tk]); const f32x4 a = *(const LAS f32x4*)(Os + tk * 68 + 8 * ch), b = *(const LAS f32x4*)(Os + tk * 68 + 8 * ch + 4);
            float v[8] = {a[0] * inv, a[1] * inv, a[2] * inv, a[3] * inv, b[0] * inv, b[1] * inv, b[2] * inv, b[3] * inv};
            float sq = 0.f;
#pragma unroll
            for (int e = 0; e < 8; ++e) sq += v[e] * v[e];
            sq += shx(sq, 1, lane_ph); sq += shx(sq, 2, lane_ph); sq += shx(sq, 4, lane_ph);
            v4u ov; ov.x = pk2(v[0], v[1]); ov.y = pk2(v[2], v[3]); ov.z = pk2(v[4], v[5]); ov.w = pk2(v[6], v[7]);
            if (dummy) *(v4u*)(dummy + (size_t)((tok0 + tk) & 1023) * 768 + h * 64 + 8 * ch) = ov;
            else { *(v4u*)(Z + (size_t)(tok0 + tk) * NIN + ZQ + h * 64 + 8 * ch) = ov;
            if (ch == 0) unsafeAtomicAdd(ssq + tok0 + tk, pg8::qgrid<9>(sq)); } }
    }
    __syncthreads();
}

__device__ __forceinline__ void conv_item(const float* W, int k_lo, int k_n, int Ktot, int ldw, int n0, bf16* WT, int drow0, const float* g, const float* g2, int ksplit, const float* b, float* cs, float* cb, LAS float* scr, int lane, const int f8, const float wsc = 1.0f) {
    float csa[4] = {0.f, 0.f, 0.f, 0.f}, cba[4] = {0.f, 0.f, 0.f, 0.f};
    const int c = lane & 7;
    float pre[32];
    { const float* wp = W + (size_t)(k_lo + (lane >> 5)) * ldw + n0 + (lane & 31);
#pragma unroll
      for (int i = 0; i < 32; ++i) pre[i] = wp[(size_t)(2 * i) * ldw]; }
    for (int k0 = k_lo; k0 < k_lo + k_n; k0 += 64) {
#pragma unroll
        for (int i = 0; i < 32; ++i) scr[(2 * i + (lane >> 5)) * 33 + (lane & 31)] = pre[i];
        LDS_WAIT(); asm volatile("" ::: "memory");
        if (k0 + 64 < k_lo + k_n) { const float* wp = W + (size_t)(k0 + 64 + (lane >> 5)) * ldw + n0 + (lane & 31);
#pragma unroll
            for (int i = 0; i < 32; ++i) pre[i] = wp[(size_t)(2 * i) * ldw]; }
        if (f8 == 3) {
            const int n = lane & 31, kq = k0 + 32 * (lane >> 5); const LAS float* sp = scr + (32 * (lane >> 5)) * 33 + n;
            pg8::f32x16 lo, hi; float sa = 0.f, sb = 0.f;
#pragma unroll
            for (int e4 = 0; e4 < 8; ++e4) { f32x4 g4 = {1.f, 1.f, 1.f, 1.f}, b4 = {0.f, 0.f, 0.f, 0.f};
                if (g) g4 = *(const f32x4*)((kq < ksplit ? g : g2 - ksplit) + kq + 4 * e4);
                if (b) b4 = *(const f32x4*)(b + kq + 4 * e4);
#pragma unroll
                for (int j = 0; j < 4; ++j) { const int e = 4 * e4 + j; const float w = sp[e * 33], wg = w * g4[j]; sa += wg; sb += b4[j] * w; if (e < 16) lo[e] = wg * wsc; else hi[e - 16] = wg * wsc; } }
            pg8::st_frag6((unsigned char*)WT + (size_t)(drow0 + n) * (size_t)(Ktot / 4 * 3) + 96 * (kq >> 7), (kq >> 5) & 3, ((drow0 + n) & 16) ? 2 : 0, lo, hi);
            csa[0] += sa; cba[0] += sb;
            LDS_WAIT(); asm volatile("" ::: "memory"); continue; }
        float gk[8], bk[8];
#pragma unroll
        for (int e = 0; e < 8; ++e) { const int k = k0 + 8 * c + e; gk[e] = g ? (k < ksplit ? g[k] : g2[k - ksplit]) : 1.f; bk[e] = b ? b[k] : 0.f; }
#pragma unroll
        for (int j = 0; j < 4; ++j) { const int n = (lane >> 3) + 8 * j; const LAS float* sp = scr + (8 * c) * 33 + n;
            float w[8], wg[8];
#pragma unroll
            for (int e = 0; e < 8; ++e) { w[e] = sp[e * 33]; wg[e] = w[e] * gk[e]; }
            if (f8 == 1) { v2u o; o.x = pg8::pk4_fp8(wg[0] * pg8::F8_WSC, wg[1] * pg8::F8_WSC, wg[2] * pg8::F8_WSC, wg[3] * pg8::F8_WSC); o.y = pg8::pk4_fp8(wg[4] * pg8::F8_WSC, wg[5] * pg8::F8_WSC, wg[6] * pg8::F8_WSC, wg[7] * pg8::F8_WSC);
                *(v2u*)((unsigned char*)WT + (size_t)(drow0 + n) * Ktot + k0 + 8 * c) = o;
                csa[j] += (((__builtin_amdgcn_cvt_f32_fp8((int)o.x, 0) + __builtin_amdgcn_cvt_f32_fp8((int)o.x, 1)) + (__builtin_amdgcn_cvt_f32_fp8((int)o.x, 2) + __builtin_amdgcn_cvt_f32_fp8((int)o.x, 3)))
                         + ((__builtin_amdgcn_cvt_f32_fp8((int)o.y, 0) + __builtin_amdgcn_cvt_f32_fp8((int)o.y, 1)) + (__builtin_amdgcn_cvt_f32_fp8((int)o.y, 2) + __builtin_amdgcn_cvt_f32_fp8((int)o.y, 3)))) * (1.0f / pg8::F8_WSC); }
            else if (f8 == 2) { v4u o; o.x = pg8::pk_f16(wg[0], wg[1]); o.y = pg8::pk_f16(wg[2], wg[3]); o.z = pg8::pk_f16(wg[4], wg[5]); o.w = pg8::pk_f16(wg[6], wg[7]);
                *(v4u*)(WT + (size_t)(drow0 + n) * Ktot + k0 + 8 * c) = o;
                csa[j] += ((pg8::f16_lo(o.x) + pg8::f16_hi(o.x)) + (pg8::f16_lo(o.y) + pg8::f16_hi(o.y))) + ((pg8::f16_lo(o.z) + pg8::f16_hi(o.z)) + (pg8::f16_lo(o.w) + pg8::f16_hi(o.w))); }
            else {
            v4u o; o.x = pk2(wg[0], wg[1]); o.y = pk2(wg[2], wg[3]); o.z = pk2(wg[4], wg[5]); o.w = pk2(wg[6], wg[7]);
            *(v4u*)(WT + (size_t)(drow0 + n) * Ktot + k0 + 8 * c) = o;
            csa[j] += ((bf_lo(o.x) + bf_hi(o.x)) + (bf_lo(o.y) + bf_hi(o.y))) + ((bf_lo(o.z) + bf_hi(o.z)) + (bf_lo(o.w) + bf_hi(o.w))); }
#pragma unroll
            for (int e = 0; e < 8; ++e) cba[j] += bk[e] * w[e]; }
        LDS_WAIT(); asm volatile("" ::: "memory");
    }
    if (cs && f8 == 3) { float a = csa[0], bb = cba[0]; a += shx(a, 32, lane); bb += shx(bb, 32, lane);
        if (lane < 32) { unsafeAtomicAdd(cs + drow0 + lane, a); unsafeAtomicAdd(cb + drow0 + lane, bb); } }
    else if (cs) {
#pragma unroll
        for (int j = 0; j < 4; ++j) { float a = csa[j], bb = cba[j];
            a += shx(a, 1, lane); a += shx(a, 2, lane); a += shx(a, 4, lane); bb += shx(bb, 1, lane); bb += shx(bb, 2, lane); bb += shx(bb, 4, lane);
            if (c == 0) { unsafeAtomicAdd(cs + drow0 + (lane >> 3) + 8 * j, pg8::qgrid<20>(a)); unsafeAtomicAdd(cb + drow0 + (lane >> 3) + 8 * j, pg8::qgrid<20>(bb)); } }
    }
}
#ifndef PHMASK
#define PHMASK 0xFFFF
#endif
#define PHON(k) ((PHMASK >> (k)) & 1)
__device__ __forceinline__ void convert_layer(CArgs P, int l, LAS unsigned char* lds, int gw, int NGW, int wave, int lane, float* csb_junk = nullptr) {
    LAS float* scr = (LAS float*)(lds + RING_OFF + wave * 16384);
    unsigned char* ws = P->ws;
    float* csb = csb_junk ? csb_junk : (float*)(ws + WS_CSB) + (size_t)l * 6 * 16384;
    constexpr int I_D = 64 * 11, I_GU = 352 * 4, I_IN = 152 * 4, I_OUT = 64 * 4, I_LRU = 160;
    constexpr int NITEMS = 2 * I_D + 2 * I_GU + I_IN + I_OUT + I_LRU;
    for (int it = gw; it < NITEMS; it += NGW) {
        int r = it;
        if (r < 2 * I_D) { const int second = r >= I_D, rr = second ? r - I_D : r, cg = rr / 11, kc = rr % 11;
            conv_item(P->in[second ? 24 : 6] + (size_t)l * FF * D, 512 * kc, 512, FF, D, 32 * cg, (bf16*)(ws + (second ? WS_WD2 : WS_WD1)), 32 * cg, nullptr, nullptr, 0, nullptr, nullptr, nullptr, scr, lane, FFN6_D ? 3 : 1, pg8::F6_WD); continue; } r -= 2 * I_D;
        if (r < I_GU) { const int kc = r & 3, r2 = r >> 2, up = r2 >= 176, rr = up ? r2 - 176 : r2, n0 = 32 * rr, dr = 256 * (n0 >> 7) + (n0 & 127) + 128 * up;
            const float* gg = l ? P->in[20] + (size_t)(l - 1) * D : nullptr; const float* bb = l ? P->in[21] + (size_t)(l - 1) * D : nullptr;
            conv_item(P->in[up ? 5 : 4] + (size_t)l * D * FF, 512 * kc, 512, D, FF, n0, (bf16*)(ws + WS_WGU1), dr, gg, gg, D, bb, csb, csb + 16384, scr, lane, FFN6_GU ? 3 : 1, pg8::F6_WGU); continue; } r -= I_GU;
        if (r < I_GU) { const int kc = r & 3, r2 = r >> 2, up = r2 >= 176, rr = up ? r2 - 176 : r2, n0 = 32 * rr, dr = 256 * (n0 >> 7) + (n0 & 127) + 128 * up;
            conv_item(P->in[up ? 23 : 22] + (size_t)l * D * FF, 512 * kc, 512, D, FF, n0, (bf16*)(ws + WS_WGU2), dr, P->in[7] + (size_t)l * D, P->in[7] + (size_t)l * D, D, P->in[8] + (size_t)l * D, csb + 4 * 16384, csb + 5 * 16384, scr, lane, FFN6_GU ? 3 : 1, pg8::F6_WGU); continue; } r -= I_GU;
        if (r < I_IN) { const int kc = r & 3, n0 = 32 * (r >> 2); int dr;
            if (n0 < 768) dr = n0; else if (n0 < 1536) dr = ZK + (n0 - 768); else if (n0 < 2304) dr = ZV + (n0 - 1536); else if (n0 < 3584) dr = ZXL + (n0 - 2304); else dr = ZGL + (n0 - 3584);
            conv_item(P->in[9] + (size_t)l * D * NIN, 512 * kc, 512, D, NIN, n0, (bf16*)(ws + WS_WIN), dr, P->in[2] + (size_t)l * D, P->in[2] + (size_t)l * D, D, P->in[3] + (size_t)l * D, csb + 2 * 16384, csb + 3 * 16384, scr, lane, 2); continue; } r -= I_IN;
        if (r < I_OUT) { const int kc = r & 3; conv_item(P->in[19] + (size_t)l * D * D, 512 * kc, 512, D, D, 32 * (r >> 2), (bf16*)(ws + WS_WOUT), 32 * (r >> 2), P->in[17] + (size_t)l * AW, P->in[18] + (size_t)l * LW, AW, nullptr, nullptr, nullptr, scr, lane, 0); continue; } r -= I_OUT;
        { const int mat = r >> 2, n0 = 32 * (r & 3), gate = mat / 20, rem = mat % 20;
          conv_item(P->in[gate ? 14 : 12] + ((size_t)l * 20 + rem) * 16384, 0, 128, 128, 128, n0, (bf16*)(ws + WS_LRUW) + (size_t)mat * 16384, n0, nullptr, nullptr, 0, nullptr, nullptr, nullptr, scr, lane, 0); }
    }
}
__device__ __forceinline__ void sincos_d(double r, double& s, double& c) {
    const double r2 = r * r; double ts = r, tc = 1.0; s = r; c = 1.0;
#pragma unroll
    for (int k = 1; k <= 14; ++k) { tc = -tc * r2 / (double)((2 * k - 1) * (2 * k)); ts = -ts * r2 / (double)((2 * k) * (2 * k + 1)); c += tc; s += ts; }
}
__device__ __forceinline__ void prologue(CArgs P, LAS unsigned char* lds, int gtid, int NGT, int gw, int NGW, int wave, int lane, const bool do_conv = true) {
    unsigned char* ws = P->ws;
    { f32x2* st0 = (f32x2*)(ws + WS_ST0); for (int i = gtid; i < T; i += NGT) st0[i] = (f32x2){0.f, 2048.0f * (1.0f - 1e-5f)}; }
    { float* v = (float*)(ws + WS_VEC); for (int i = gtid; i < 4096; i += NGT) v[i] = i < 2048 ? 1.f : 0.f; }
    { f32x2* rp = (f32x2*)(ws + WS_ROPE);
      for (int i = gtid; i < 16384 * 8; i += NGT) { const int pos = i >> 3, fi = i & 7;
          const double invf = fi == 0 ? 1.0 : fi == 1 ? 0.19392274474868576 : fi == 2 ? 0.03760603093086393 : fi == 3 ? 0.007292664737217109 : fi == 4 ? 0.001414213562373095 : fi == 5 ? 0.0002742481756762073 : fi == 6 ? 5.318295896944988e-05 : 1.031338537721246e-05;
          const double ang = (double)pos * invf; const double kq = __builtin_rint(ang * 0.15915494309189535); const double rr = ang - kq * 6.283185307179586;
          double s, c; sincos_d(rr, s, c); rp[i] = (f32x2){(float)c, (float)s}; } }
    { unsigned char* tb = (unsigned char*)(ws + WS_TB8);
#if FFN6_GU
      for (size_t i = (size_t)gtid; i < (size_t)T * D / 32; i += NGT) { const size_t e = i * 32; const float* src = e < (size_t)TPR * D ? P->in[0] + e : P->in[1] + (e - (size_t)TPR * D);
          pg8::f32x16 lo, hi;
#pragma unroll
          for (int j = 0; j < 4; ++j) { const f32x4 a = *(const f32x4*)(src + 4 * j), b2 = *(const f32x4*)(src + 16 + 4 * j);
#pragma unroll
              for (int q = 0; q < 4; ++q) { lo[4 * j + q] = a[q]; hi[4 * j + q] = b2[q]; } }
          const int row = (int)(e >> 11), cc = (int)(e & 2047);
          pg8::st_frag6(tb + (size_t)row * 1536 + 96 * (cc >> 7), (cc >> 5) & 3, (row & 8) ? 2 : 0, lo, hi); } }
#else
      size_t i = (size_t)gtid;
      for (; i + 3 * (size_t)NGT < (size_t)T * D / 8; i += 4 * (size_t)NGT) { f32x4 a[4], b2[4];
#pragma unroll
          for (int q = 0; q < 4; ++q) { const size_t e = (i + (size_t)q * NGT) * 8; const float* src = e < (size_t)TPR * D ? P->in[0] + e : P->in[1] + (e - (size_t)TPR * D); a[q] = *(const f32x4*)src; b2[q] = *(const f32x4*)(src + 4); }
#pragma unroll
          for (int q = 0; q < 4; ++q) { const size_t e = (i + (size_t)q * NGT) * 8; v2u o; o.x = pg8::pk4_fp8(a[q][0], a[q][1], a[q][2], a[q][3]); o.y = pg8::pk4_fp8(b2[q][0], b2[q][1], b2[q][2], b2[q][3]); *(v2u*)(tb + e) = o; } }
      for (; i < (size_t)T * D / 8; i += NGT) { const size_t e = i * 8; const float* src = e < (size_t)TPR * D ? P->in[0] + e : P->in[1] + (e - (size_t)TPR * D);
          const f32x4 a = *(const f32x4*)src, b2 = *(const f32x4*)(src + 4); v2u o; o.x = pg8::pk4_fp8(a[0], a[1], a[2], a[3]); o.y = pg8::pk4_fp8(b2[0], b2[1], b2[2], b2[3]); *(v2u*)(tb + e) = o; } }
#endif
    if (do_conv) convert_layer(P, 0, lds, gw, NGW, wave, lane);
}

__device__ __forceinline__ void attn_valu_phase(LAS unsigned char* lds, bf16* Z, float* ssq, int blk, int G, int wave, int lane) {
    LAS float* sbuf = (LAS float*)lds + wave * 400;
    const int ks = lane >> 3, dp = lane & 7;
    for (int unit = blk; unit < (T / 64) * 12; unit += G) {
        const int tb = unit / 12, h = unit % 12;
        for (int qi = 0; qi < 8; ++qi) {
            const int tok = 64 * tb + 8 * wave + qi;
            const int s0 = tok < TPR ? (tok & ~4095) : TPR, S = tok < TPR ? 4096 : 16384, pos = tok - s0;
            float q8[8];
            { const v4u w = *(const v4u*)(Z + (size_t)tok * NIN + ZQ + h * 64 + 8 * dp);
              q8[0] = bf_lo(w.x) * 0.125f; q8[1] = bf_hi(w.x) * 0.125f; q8[2] = bf_lo(w.y) * 0.125f; q8[3] = bf_hi(w.y) * 0.125f; q8[4] = bf_lo(w.z) * 0.125f; q8[5] = bf_hi(w.z) * 0.125f; q8[6] = bf_lo(w.w) * 0.125f; q8[7] = bf_hi(w.w) * 0.125f; }
            for (int t = 0; t < 49; ++t) {
                const int kk = 8 * t + ks; const int gq = kk >= 258 ? 2 : (kk >= 129 ? 1 : 0); const int j = kk - 129 * gq - 64; const int kp = pos + j * (1 << (2 * gq));
                const bool valid = kk < 387 && kp >= 0 && kp < S; const int row = s0 + (valid ? kp : pos);
                const v4u w = *(const v4u*)(Z + (size_t)row * NIN + ZK + h * 64 + 8 * dp);
                float d = q8[0] * bf_lo(w.x) + q8[1] * bf_hi(w.x) + q8[2] * bf_lo(w.y) + q8[3] * bf_hi(w.y) + q8[4] * bf_lo(w.z) + q8[5] * bf_hi(w.z) + q8[6] * bf_lo(w.w) + q8[7] * bf_hi(w.w);
                d += shx(d, 1, lane); d += shx(d, 2, lane); d += shx(d, 4, lane);
                if (dp == 0) sbuf[kk] = valid ? d : -1e30f;
            }
            LDS_WAIT(); asm volatile("" ::: "memory");
            float sv[7]; float mx = -1e30f;
#pragma unroll
            for (int p = 0; p < 7; ++p) { const int idx = lane + 64 * p; sv[p] = idx < 392 ? sbuf[idx] : -1e30f; mx = fmaxf(mx, sv[p]); }
#pragma unroll
            for (int o = 1; o < 64; o <<= 1) mx = fmaxf(mx, shx(mx, o, lane));
            float sum = 0.f;
#pragma unroll
            for (int p = 0; p < 7; ++p) { const int idx = lane + 64 * p; const float e = sv[p] > -1e29f ? __expf(sv[p] - mx) : 0.f; sum += e; if (idx < 392) sbuf[idx] = e; }
#pragma unroll
            for (int o = 1; o < 64; o <<= 1) sum += shx(sum, o, lane);
            LDS_WAIT(); asm volatile("" ::: "memory");
            float a8[8] = {0.f, 0.f, 0.f, 0.f, 0.f, 0.f, 0.f, 0.f};
            for (int t = 0; t < 49; ++t) {
                const int kk = 8 * t + ks; const int gq = kk >= 258 ? 2 : (kk >= 129 ? 1 : 0); const int j = kk - 129 * gq - 64; const int kp = pos + j * (1 << (2 * gq));
                const bool valid = kk < 387 && kp >= 0 && kp < S; const int row = s0 + (valid ? kp : pos);
                const float p = sbuf[kk];
                const v4u w = *(const v4u*)(Z + (size_t)row * NIN + ZV + h * 64 + 8 * dp);
                a8[0] += p * bf_lo(w.x); a8[1] += p * bf_hi(w.x); a8[2] += p * bf_lo(w.y); a8[3] += p * bf_hi(w.y); a8[4] += p * bf_lo(w.z); a8[5] += p * bf_hi(w.z); a8[6] += p * bf_lo(w.w); a8[7] += p * bf_hi(w.w);
            }
            const float inv = 1.0f / sum; float sq = 0.f;
#pragma unroll
            for (int e = 0; e < 8; ++e) { float v = a8[e]; v += shx(v, 8, lane); v += shx(v, 16, lane); v += shx(v, 32, lane); a8[e] = v * inv; sq += a8[e] * a8[e]; }
            sq += shx(sq, 1, lane); sq += shx(sq, 2, lane); sq += shx(sq, 4, lane);
            if (ks == 0) { v4u o; o.x = pk2(a8[0], a8[1]); o.y = pk2(a8[2], a8[3]); o.z = pk2(a8[4], a8[5]); o.w = pk2(a8[6], a8[7]); *(v4u*)(Z + (size_t)tok * NIN + ZQ + h * 64 + 8 * dp) = o; }
            if (lane == 0) unsafeAtomicAdd(ssq + tok, sq);
            LDS_WAIT(); asm volatile("" ::: "memory");
        }
    }
}

__device__ __forceinline__ float neg_expm1_small(float x) {
    const float ser = -x * (1.0f + x * (0.5f + x * (0.16666667f + x * (0.041666668f + x * (0.0083333338f + x * 0.0013888889f)))));
    return x < -0.25f ? 1.0f - __expf(x) : ser; }
template <int MODE>
__device__ __forceinline__ void lru_phase(LAS unsigned char* lds, int blk, int G, int tid, int lane, int wave, bf16* Z, const bf16* LWT, const float* convw, const float* convb, const float* ba, const float* bx, const float* lam, float* tot, float* ssq) {
    LAS bf16* xcb = (LAS bf16*)lds;
    LAS float* hb = (LAS float*)(lds + 34816);
    const int c = lane & 15, g = lane >> 4, dl = 16 * wave + c;
    constexpr int UPB = NCHUNK * 10 / 256;
    const int u_lo = (G == 256) ? blk * UPB : blk, u_step = (G == 256) ? 1 : G, u_n = (G == 256) ? UPB : (NCHUNK * 10 - blk + G - 1) / G;
    int nb_cur = -1; float sp8[2] = {0.f, 0.f}, bav[2] = {0.f, 0.f}, bxv[2] = {0.f, 0.f}; bf16x8 Bfa[2][4], Bfx[2][4];
#pragma unroll
    for (int d = 0; d < 2; ++d)
#pragma unroll
        for (int ks = 0; ks < 4; ++ks) { Bfa[d][ks] = (bf16x8){0, 0, 0, 0, 0, 0, 0, 0}; Bfx[d][ks] = Bfa[d][ks]; }
    unsigned xw[19];
#define LRU_LOAD_XW(unit_) do { const int nb_ = (unit_) / NCHUNK, pu_ = (unit_) % NCHUNK, ck_ = (pu_ % 3 == 2) ? 256 + pu_ / 3 : 2 * (pu_ / 3) + pu_ % 3, tok0_ = LCH * ck_; const int s0_ = tok0_ < TPR ? (tok0_ & ~4095) : TPR, send_ = tok0_ < TPR ? s0_ + 4096 : T; \
        const int ch_ = 128 * nb_ + 2 * (tid & 63), tg_ = tid >> 6; \
        _Pragma("unroll") for (int i = 0; i < 19; ++i) { const int row_ = tok0_ + 16 * tg_ + i - 2; unsigned w_ = 0u; if (row_ >= s0_ && row_ < send_) w_ = *(const unsigned*)(Z + (size_t)row_ * NIN + ZXL + ch_); xw[i] = w_; } } while (0)
    if (u_n > 0) LRU_LOAD_XW(u_lo);
    for (int ui = 0; ui < u_n; ++ui) {
        const int unit = u_lo + ui * u_step; const int nb = unit / NCHUNK, pu = unit % NCHUNK; const int ck = (pu % 3 == 2) ? 256 + pu / 3 : 2 * (pu / 3) + pu % 3;
        const int tok0 = LCH * ck; const int s0 = tok0 < TPR ? (tok0 & ~4095) : TPR; const int send = tok0 < TPR ? s0 + 4096 : T;
        __syncthreads();
        { const int cp = tid & 63, ch = 128 * nb + 2 * cp, tg = tid >> 6;
          float w0[4], w1[4];
#pragma unroll
          for (int j = 0; j < 4; ++j) { w0[j] = convw[j * LW + ch]; w1[j] = convw[j * LW + ch + 1]; }
          const float b0 = convb[ch], b1 = convb[ch + 1];
          float x0[19], x1[19];
#pragma unroll
          for (int i = 0; i < 19; ++i) { x0[i] = bf_lo(xw[i]); x1[i] = bf_hi(xw[i]); }
#pragma unroll
          for (int i = 0; i < 16; ++i) { const float a0 = ((x0[i] * w0[0] + x0[i + 1] * w0[1]) + (x0[i + 2] * w0[2] + x0[i + 3] * w0[3])) + b0, a1 = ((x1[i] * w1[0] + x1[i + 1] * w1[1]) + (x1[i + 2] * w1[2] + x1[i + 3] * w1[3])) + b1;
              *(LAS unsigned*)(xcb + (16 * tg + i) * 136 + 2 * cp) = pk2(a0, a1); } }
        if (nb != nb_cur) { nb_cur = nb; const int ch = 128 * nb + dl;
#pragma unroll
            for (int d = 0; d < 2; ++d) { sp8[d] = 8.0f * 1.4426950408889634f * log1pf(expf(-lam[d * LW + ch])); bav[d] = ba[d * LW + ch]; bxv[d] = bx[d * LW + ch];
                const bf16* wa = LWT + ((size_t)((0 * 2 + d) * 10 + nb) * 128 + dl) * 128; const bf16* wx = LWT + ((size_t)((1 * 2 + d) * 10 + nb) * 128 + dl) * 128;
#pragma unroll
                for (int ks = 0; ks < 4; ++ks) { Bfa[d][ks] = *(const bf16x8*)(wa + 32 * ks + 8 * g); Bfx[d][ks] = *(const bf16x8*)(wx + 32 * ks + 8 * g); } } }
        float C[2] = {0.f, 0.f};
        if (MODE == 1) {
            const int cfirst = s0 / LCH, clast = send / LCH - 1; const int ch = 128 * nb + dl;
#pragma unroll
            for (int d = 0; d < 2; ++d) { const int n = d ? (clast - ck) : (ck - cfirst); const int q = (n + 3) >> 2, i0 = g * q, i1 = (i0 + q) < n ? (i0 + q) : n; float FA = 1.f, FH = 0.f;
                for (int i = i0; i < i1; i += 8) { f32x2 v[8];
#pragma unroll
                    for (int e = 0; e < 8; ++e) { const int ii = (i + e) < i1 ? (i + e) : (i1 - 1); const int kc = d ? clast - ii : cfirst + ii; v[e] = *(const f32x2*)(tot + (((size_t)kc * 2 + d) * LW + ch) * 2); }
#pragma unroll
                    for (int e = 0; e < 8; ++e) if ((i + e) < i1) { FH = v[e].x * FH + v[e].y; FA = v[e].x * FA; } }
                float Cc = 0.f;
#pragma unroll
                for (int gg = 0; gg < 4; ++gg) { const float A_g = shl(FA, c + 16 * gg), H_g = shl(FH, c + 16 * gg); Cc = A_g * Cc + H_g; }
                C[d] = Cc; }
        }
        __syncthreads();
        if (ui + 1 < u_n) LRU_LOAD_XW(u_lo + (ui + 1) * u_step);
        v4u gwp[4];
        if (MODE == 1) {
#pragma unroll
            for (int i = 0; i < 4; ++i) { const int itx = tid + 512 * i, tt = itx >> 4, cg = itx & 15; gwp[i] = *(const v4u*)(Z + (size_t)(tok0 + tt) * NIN + ZGL + 128 * nb + 8 * cg); } }
#pragma unroll
        for (int d = 0; d < 2; ++d) {
            float Cd = C[d], Atot = 1.f;
            f32x4 aaN, axN;
#define LRU_GATES(mt_, aa_, ax_) do { bf16x8 Af_[4]; _Pragma("unroll") for (int ks = 0; ks < 4; ++ks) Af_[ks] = *(const LAS bf16x8*)(xcb + (16 * (mt_) + c) * 136 + 32 * ks + 8 * g); \
                aa_ = (f32x4){0.f, 0.f, 0.f, 0.f}; ax_ = (f32x4){0.f, 0.f, 0.f, 0.f}; \
                _Pragma("unroll") for (int ks = 0; ks < 4; ++ks) { aa_ = __builtin_amdgcn_mfma_f32_16x16x32_bf16(Af_[ks], Bfa[d][ks], aa_, 0, 0, 0); ax_ = __builtin_amdgcn_mfma_f32_16x16x32_bf16(Af_[ks], Bfx[d][ks], ax_, 0, 0, 0); } } while (0)
            LRU_GATES(d ? (LCH / 16 - 1) : 0, aaN, axN);
#pragma unroll 2
            for (int it = 0; it < LCH / 16; ++it) { const int mt = d ? (LCH / 16 - 1 - it) : it;
                const f32x4 aa = aaN, ax = axN;
                if (it + 1 < LCH / 16) { const int mtn = d ? (LCH / 16 - 2 - it) : it + 1; LRU_GATES(mtn, aaN, axN); }
                float av[4], uv[4];
#pragma unroll
                for (int jp = 0; jp < 2; ++jp) {
                    constexpr float NL2E = -1.4426950408889634f;
                    const f32x2 za = (f32x2){aa[2 * jp], aa[2 * jp + 1]} * NL2E + NL2E * bav[d], zx = (f32x2){ax[2 * jp], ax[2 * jp + 1]} * NL2E + NL2E * bxv[d];
                    const f32x2 da = (f32x2){__builtin_amdgcn_exp2f(za.x), __builtin_amdgcn_exp2f(za.y)} + 1.0f, dx = (f32x2){__builtin_amdgcn_exp2f(zx.x), __builtin_amdgcn_exp2f(zx.y)} + 1.0f;
                    const f32x2 r = {__builtin_amdgcn_rcpf(da.x), __builtin_amdgcn_rcpf(da.y)}, ig = {__builtin_amdgcn_rcpf(dx.x), __builtin_amdgcn_rcpf(dx.y)};
                    const f32x2 la2 = r * (-sp8[d]);
                    const f32x2 a2 = {__builtin_amdgcn_exp2f(la2.x), __builtin_amdgcn_exp2f(la2.y)};
                    const f32x2 om = (f32x2){1.0f, 1.0f} - a2 * a2;
                    const int tl = 16 * mt + 4 * g + 2 * jp;
                    const f32x2 xv = {__uint_as_float((unsigned)xcb[tl * 136 + dl] << 16), __uint_as_float((unsigned)xcb[(tl + 1) * 136 + dl] << 16)};
                    const f32x2 u2 = (f32x2){__builtin_amdgcn_sqrtf(om.x), __builtin_amdgcn_sqrtf(om.y)} * (ig * xv);
                    av[2 * jp] = a2.x; av[2 * jp + 1] = a2.y; uv[2 * jp] = u2.x; uv[2 * jp + 1] = u2.y; }
                float Pp = 1.f, Hh = 0.f, pj[4], hj[4];
#pragma unroll
                for (int jj = 0; jj < 4; ++jj) { const int j = d ? 3 - jj : jj; Hh = av[j] * Hh + uv[j]; Pp *= av[j]; pj[j] = Pp; hj[j] = Hh; }
                float tA = Pp, tH = Hh, eA = 1.f, eH = 0.f;
#pragma unroll
                for (int dim = 0; dim < 2; ++dim) { float aA = tA, bA = tA, aH = tH, bH = tH;
                    if (dim == 0) { pg8::swap16(aA, bA); pg8::swap16(aH, bH); } else { pg8::swap32(aA, bA); pg8::swap32(aH, bH); }
                    const float loA = d ? bA : aA, loH = d ? bH : aH, hiA = d ? aA : bA, hiH = d ? aH : bH;
                    const bool later = (((g >> dim) & 1) != 0) != (d != 0);
                    const float LA = later ? loA : 1.f, LH = later ? loH : 0.f;
                    eH = eA * LH + eH; eA = eA * LA;
                    tH = hiA * loH + hiH; tA = loA * hiA; }
                const float Xin = eA * Cd + eH;
                if (MODE == 0) Atot *= tA;
                Cd = tA * Cd + tH;
                if (MODE == 1) {
#pragma unroll
                    for (int j = 0; j < 4; ++j) { LAS float* hp = hb + (16 * mt + 4 * g + j) * 132 + dl; const float hv = pj[j] * Xin + hj[j]; if (d == 0) *hp = hv; else *hp = *hp + hv; } }
            }
            if (MODE == 0) { if (g == 0) *(f32x2*)(tot + (((size_t)ck * 2 + d) * LW + 128 * nb + dl) * 2) = (f32x2){Atot, Cd}; }
        }
        if (MODE == 1) {
            __syncthreads();
#pragma unroll
            for (int i = 0; i < 4; ++i) { const int itx = tid + 512 * i, tt = itx >> 4, cg = itx & 15;
                const f32x4 f0 = *(const LAS f32x4*)(hb + tt * 132 + 8 * cg), f1 = *(const LAS f32x4*)(hb + tt * 132 + 8 * cg + 4);
                bf16* gp = Z + (size_t)(tok0 + tt) * NIN + ZGL + 128 * nb + 8 * cg; const v4u gw = gwp[i];
                float rv[8];
                rv[0] = f0[0] * gelu_tanh(bf_lo(gw.x)); rv[1] = f0[1] * gelu_tanh(bf_hi(gw.x)); rv[2] = f0[2] * gelu_tanh(bf_lo(gw.y)); rv[3] = f0[3] * gelu_tanh(bf_hi(gw.y));
                rv[4] = f1[0] * gelu_tanh(bf_lo(gw.z)); rv[5] = f1[1] * gelu_tanh(bf_hi(gw.z)); rv[6] = f1[2] * gelu_tanh(bf_lo(gw.w)); rv[7] = f1[3] * gelu_tanh(bf_hi(gw.w));
                float sq = 0.f;
#pragma unroll
                for (int e = 0; e < 8; ++e) sq += rv[e] * rv[e];
                sq += shx(sq, 1, lane); sq += shx(sq, 2, lane); sq += shx(sq, 4, lane); sq += shx(sq, 8, lane);
                v4u o; o.x = pk2(rv[0], rv[1]); o.y = pk2(rv[2], rv[3]); o.z = pk2(rv[4], rv[5]); o.w = pk2(rv[6], rv[7]); *(v4u*)gp = o;
                if (cg == 0) unsafeAtomicAdd(ssq + tok0 + tt, pg8::qgrid<6>(sq)); }
        }
    }
#undef LRU_LOAD_XW
#undef LRU_GATES
    __syncthreads();
}

__device__ __forceinline__ void rmsnorm_phase(bf16* Z, const float* ssq_att, const float* ssq_rec, int gw, int NGW, int lane) {
    for (int r = gw; r < T; r += NGW) {
        const float ra = rsqrtf(ssq_att[r] * (1.0f / AW) + 1e-5f), rr = rsqrtf(ssq_rec[r] * (1.0f / LW) + 1e-5f);
#pragma unroll
        for (int i = 0; i < 4; ++i) { const int col = 8 * (lane + 64 * i); const float sc = col < AW ? ra : rr; bf16* p = Z + (size_t)r * NIN + col; const v4u w = *(const v4u*)p;
            v4u o; o.x = pk2(bf_lo(w.x) * sc, bf_hi(w.x) * sc); o.y = pk2(bf_lo(w.y) * sc, bf_hi(w.y) * sc); o.z = pk2(bf_lo(w.z) * sc, bf_hi(w.z) * sc); o.w = pk2(bf_lo(w.w) * sc, bf_hi(w.w) * sc); *(v4u*)p = o; }
    }
}
__device__ __forceinline__ void final_ln_phase(float* out, const unsigned char* res, const float* st, const float* g, const float* b, int gw, int NGW, int lane, const float* tpv) {
    for (int r0 = gw; r0 < T; r0 += 2 * NGW) {
      v4u wv[2][4]; f32x2 sv2[2];
#pragma unroll
      for (int h = 0; h < 2; ++h) { const int r = r0 + h * NGW; if (r < T) { sv2[h] = *(const f32x2*)(st + 2 * (size_t)r);
#pragma unroll
          for (int i = 0; i < 4; ++i) wv[h][i] = __builtin_nontemporal_load((const v4u*)(res + ((size_t)r * D + 8 * (lane + 64 * i)) * 2)); } }
#pragma unroll
      for (int h = 0; h < 2; ++h) { const int r = r0 + h * NGW; if (r >= T) break;
        const f32x2 s = sv2[h]; const float mu = s.x * (1.0f / 2048.0f); const float rstd = rsqrtf(fmaxf(s.y * (1.0f / 2048.0f) - mu * mu, 0.f) + 1e-5f);
#pragma unroll
        for (int i = 0; i < 4; ++i) { const int col = 8 * (lane + 64 * i); const v4u w = wv[h][i]; float* p = out + (size_t)r * D + col;
            const f32x4 t0 = {pg8::f16_lo(w.x), pg8::f16_hi(w.x), pg8::f16_lo(w.y), pg8::f16_hi(w.y)}, t1 = {pg8::f16_lo(w.z), pg8::f16_hi(w.z), pg8::f16_lo(w.w), pg8::f16_hi(w.w)};
            f32x4 y0 = (t0 - mu) * rstd * *(const f32x4*)(g + col) + *(const f32x4*)(b + col), y1 = (t1 - mu) * rstd * *(const f32x4*)(g + col + 4) + *(const f32x4*)(b + col + 4);
#if defined(TPROBE)
            y0 = y0 * (1.0f + tpv[0]); y1 = y1 * (1.0f + tpv[0]);
#endif
            __builtin_nontemporal_store(y0, (f32x4*)p); __builtin_nontemporal_store(y1, (f32x4*)(p + 4)); }
      }
    }
}

#ifndef STAGGER_DOWN
#define STAGGER_DOWN 0
#endif
#ifndef STAGGER_OUT
#define STAGGER_OUT 0
#endif
__device__ __forceinline__ void stagger_start(int blk, unsigned ticks_per_group) {
    const unsigned long long t0 = __builtin_amdgcn_s_memrealtime(); const unsigned long long wait = (unsigned long long)(blk & 3) * ticks_per_group;
    while (__builtin_amdgcn_s_memrealtime() - t0 < wait) __builtin_amdgcn_s_sleep(16);
}
#ifndef FUSE_FIN
#define FUSE_FIN 0
#endif
#ifndef MK_N_LAUNCHES
#define MK_N_LAUNCHES 1
#endif
#if defined(XDUP) && (XDUP < 3 || XDUP == 6 || XDUP == 7 || XDUP == 8 || XDUP == 10 || XDUP == 11 || XDUP == 12 || (XDUP >= 13 && XDUP <= 19))
constexpr int N_PHASES_C = 1 + 9 + 1 + 9 + 1 + (XDUP == 19 ? 6 : 0);
#else
constexpr int N_PHASES_C = 1 + 8 + 1 + 8 + (FUSE_FIN ? 0 : 1);
#endif
__global__ void __launch_bounds__(NWAVES * 64, 2) enc_fwd(Args args) {
    __builtin_amdgcn_s_setreg(1473, 1);
    extern __shared__ __attribute__((aligned(16))) unsigned char lds_raw[];
    LAS unsigned char* lds = (LAS unsigned char*)lds_raw;
    volatile LAS unsigned* MISC = (volatile LAS unsigned*)(lds + MISC_OFF);
    const int tid = threadIdx.x, lane = tid & 63, wave = __builtin_amdgcn_readfirstlane(tid >> 6);
    const int G = gridDim.x, blk = blockIdx.x;
    (void)lane; (void)wave;
    GAS unsigned char* ws = (GAS unsigned char*)args.ws;
    for (int u = tid; u < (LDS_BYTES - LDSCTL_OFF) / 4; u += NWAVES * 64) ((LAS unsigned*)(lds + LDSCTL_OFF))[u] = 0u;
    __syncthreads();
    unsigned bar_x; { const XcdBarrier b0 = xcd_barrier_post((unsigned*)(args.ws + WS_CTL) + CW_BAR, MISC + 8); bar_x = b0.x; }
#define GRID_BAR() do { unsigned xx_ = bar_x; asm volatile("" : "+s"(xx_)); XcdBarrier b_; b_.bar = (unsigned*)(ws + WS_CTL) + CW_BAR; b_.x = xx_; b_.st = MISC + 8; xcd_barrier(b_); } while (0)
    int ph = 0;
    const int lo = args.ph_lo, hi = args.ph_hi; (void)lo; (void)hi;
#if defined(TPROBE)
    unsigned long long tp_acc0 = 0, tp_acc1 = 0, tp_all = 0, tp_t0 = 0, tp_c0 = 0; int tp_cls = 2;
#if TPROBE == 1
#define TP_BEGIN(k) tp_cls = ((k) == 1 || (k) == 2 || (k) == 3 || (k) == 8) ? 0 : (((k) == 4 || (k) == 6) ? 1 : 2); tp_t0 = __builtin_amdgcn_s_memrealtime();
#define TP_MID()
#elif TPROBE == 3
#define TP_BEGIN(k) tp_cls = ((k) == 1 || (k) == 2) ? 0 : (((k) == 3 || (k) == 8) ? 1 : 2); tp_t0 = __builtin_amdgcn_s_memrealtime();
#define TP_MID()
#elif TPROBE == 5
#define TP_BEGIN(k) tp_cls = ((k) == 1) ? 0 : 2; tp_t0 = __builtin_amdgcn_s_memrealtime(); tp_c0 = __builtin_amdgcn_s_memtime();
#define TP_MID()
#elif TPROBE == 4
#define TP_BEGIN(k) tp_cls = ((k) == 1) ? 0 : (((k) == 0 || (k) == 9) ? 1 : 2); tp_t0 = __builtin_amdgcn_s_memrealtime();
#define TP_MID()
#else
#define TP_BEGIN(k) tp_cls = ((k) == 4) ? 0 : (((k) == 6) ? 1 : 2); tp_t0 = __builtin_amdgcn_s_memrealtime();
#define TP_MID() { __syncthreads(); const unsigned long long n_ = __builtin_amdgcn_s_memrealtime(); tp_all += n_ - tp_t0; tp_acc0 += n_ - tp_t0; tp_t0 = n_; tp_cls = 2; }
#endif
#if TPROBE == 5
#define TP_END() { const unsigned long long d_ = __builtin_amdgcn_s_memrealtime() - tp_t0, dc_ = __builtin_amdgcn_s_memtime() - tp_c0; if (tp_cls == 0) { tp_acc0 += d_; tp_acc1 += dc_; } \
        if (blk == 0 && tid == 0) { float* tpw = (float*)(args.ws + WS_VEC + 32768); const float ghz = 0.1f * (float)tp_acc1 / (float)(tp_acc0 ? tp_acc0 : 1); tpw[0] = 0.01f * floorf(ghz * 10.0f + 0.5f); tpw[1] = 0.0f; } }
#else
#define TP_END() { const unsigned long long d_ = __builtin_amdgcn_s_memrealtime() - tp_t0; tp_all += d_; if (tp_cls == 0) tp_acc0 += d_; if (tp_cls == 1) tp_acc1 += d_; \
        if (blk == 0 && tid == 0) { float* tpw = (float*)(args.ws + WS_VEC + 32768); tpw[0] = 0.02f + 0.08f * (floorf(40.0f * (float)tp_acc0 / (float)tp_all + 0.5f) / 40.0f); tpw[1] = 2.0f + 8.0f * (floorf(40.0f * (float)tp_acc1 / (float)tp_all + 0.5f) / 40.0f);     } }
#endif
#else
#define TP_BEGIN(k)
#define TP_END()
#define TP_MID()
#endif
#if MK_N_LAUNCHES == 1
#define PH_IN_RANGE true
#define PH_BAR_AFTER (ph + 1 < N_PHASES_C)
#else
#define PH_IN_RANGE (ph >= lo && ph < hi)
#define PH_BAR_AFTER (ph + 1 < hi)
#endif
#define PHASE_BEGIN(k) if (PH_IN_RANGE) { TP_BEGIN(k) if (PHON(k)) { int tidx = wave * 64 + pg8::lane_now(), blkx = blk, Gx = G; CArgs P = (CArgs)__builtin_amdgcn_kernarg_segment_ptr(); asm volatile("" : "+s"(ws), "+s"(outg), "+v"(tidx), "+s"(blkx), "+s"(Gx), "+s"(P)); const int NGW = Gx * NWAVES, NGT = Gx * NWAVES * 64; (void)NGW; (void)NGT; const int lanex = tidx & 63, wavex = __builtin_amdgcn_readfirstlane(tidx >> 6), gwx = blkx * NWAVES + wavex, gtidx = blkx * (NWAVES * 64) + tidx; (void)lanex; (void)gwx; (void)gtidx;
#define PHASE_END   } if (PH_BAR_AFTER) { TP_END() GRID_BAR(); } } ++ph;

    GAS float* outg = (GAS float*)args.out;
#define out ((float*)outg)

#if defined(XDUP) && XDUP == 19
    PHASE_BEGIN(0) PHASE_END PHASE_BEGIN(0) PHASE_END PHASE_BEGIN(0) PHASE_END PHASE_BEGIN(0) PHASE_END PHASE_BEGIN(0) PHASE_END PHASE_BEGIN(0) PHASE_END PHASE_BEGIN(0) PHASE_END PHASE_BEGIN(0) PHASE_END
#endif
#if defined(XDUP) && XDUP == 18
    PHASE_BEGIN(0) prologue(P, lds, gtidx, NGT, gwx, NGW, wavex, lanex, false); PHASE_END
#endif
    PHASE_BEGIN(0) prologue(P, lds, gtidx, NGT, gwx, NGW, wavex, lanex); PHASE_END

    { constexpr int l = 0;
    {
#define TB ((bf16*)(ws + WS_TB))
#define HB ((bf16*)(ws + WS_BIG))
#define Z ((bf16*)(ws + WS_BIG))
#define csb ((float*)(ws + WS_CSB) + (size_t)l * 6 * 16384)
#define ones ((const float*)(ws + WS_VEC))
#define zeros (ones + 2048)
#define st_prev (l ? (const float*)(ws + WS_ST + 2 * STAT_BYTES) : (const float*)(ws + WS_ST0))
#define g_prev (l ? P->in[20] : ones)
#define b_prev (l ? P->in[21] : zeros)
#define st1 ((float*)(ws + WS_ST + (size_t)(3 * l + 0) * STAT_BYTES))
#define st2 ((float*)(ws + WS_ST + (size_t)(3 * l + 1) * STAT_BYTES))
#define st3 ((float*)(ws + WS_ST + (size_t)(3 * l + 2) * STAT_BYTES))
#ifndef F8TO6
#define F8TO6 0
#endif
#if FFN6_D
#define GU_EPI pg8::EpiGU6
#ifndef F6_FIX
#define F6_FIX 1.0f
#endif
#define DOWN_SC (0.5f / (pg8::F6_WD * pg8::F6_HSC) * F6_FIX)
#else
#define GU_EPI pg8::EpiGU
#define DOWN_SC (0.5f / (pg8::F8_WSC * pg8::F8_HSC) * (F8TO6 ? 8.0f : 1.0f))
#endif
#ifndef WGM_GU
#define WGM_GU PG8_WGM
#endif
#ifndef WGM_D
#define WGM_D PG8_WGM
#endif
#ifndef WGM_IN
#define WGM_IN PG8_WGM
#endif
#ifndef WGM_OUT
#define WGM_OUT PG8_WGM
#endif
#define ssq_att ((float*)(ws + WS_SSQ + (size_t)(2 * l) * SSQ_BYTES))
#define ssq_rec ((float*)(ws + WS_SSQ + (size_t)(2 * l + 1) * SSQ_BYTES))
        PHASE_BEGIN(1) { pg8::Gemm gm{(const bf16*)(ws + WS_TB8), (const bf16*)(ws + WS_WGU1), T, 2 * FF, D / 2, D / 2}; pg8::StaticOrder S; S.init(T, 2 * FF, Gx, blkx);
            pg8::EpiGU E{(unsigned char*)HB, st_prev, csb, csb + 16384};
            pg8::gemm_phase<pg8::EpiGU, pg8::StaticOrder, PG8_ALIGN, PG8_SP2, true>(lds + RING_OFF, gm, S, E, tidx); } PHASE_END
#if defined(XDUP) && XDUP == 11
        PHASE_BEGIN(1) { pg8::Gemm gm{(const bf16*)(ws + WS_TB8), (const bf16*)(ws + WS_WGU1), T, 2 * FF, D / 2, D / 2}; pg8::FixedOrder S; S.init(T, 2 * FF, Gx, blkx);
            pg8::EpiNull E{(float*)(ws + WS_VEC + 65536)};
            pg8::gemm_phase<pg8::EpiNull, pg8::FixedOrder, PG8_ALIGN, PG8_SP2, true, false, 2>(lds + RING_OFF, gm, S, E, tidx); } PHASE_END
#endif
#if defined(XDUP) && XDUP >= 13 && XDUP <= 16
        PHASE_BEGIN(1) { pg8::Gemm gm{(const bf16*)(ws + WS_TB8), (const bf16*)(ws + WS_WGU1), T, 2 * FF, D / 2, D / 2}; pg8::StaticOrder S; S.init(T, 2 * FF, Gx, blkx);
            pg8::EpiNull E{(float*)(ws + WS_VEC + 65536)};
            pg8::gemm_phase<pg8::EpiNull, pg8::StaticOrder, PG8_ALIGN, PG8_SP2, true, false, 1, false, false, XDUP - 13>(lds + RING_OFF, gm, S, E, tidx); } PHASE_END
#endif
#if defined(XDUP) && XDUP == 12
        PHASE_BEGIN(1) { pg8::Gemm gm{(const bf16*)(ws + WS_TB8), (const bf16*)(ws + WS_WGU1), T, 2 * FF, D / 2, D / 2}; pg8::StaticOrder S; S.init(T, 2 * FF, Gx, blkx);
            pg8::EpiNull E{(float*)(ws + WS_VEC + 65536)};
            pg8::gemm_phase<pg8::EpiNull, pg8::StaticOrder, PG8_ALIGN, PG8_SP2, false, false, 1, true>(lds + RING_OFF, gm, S, E, tidx); } PHASE_END
#endif
#if defined(XDUP) && XDUP == 9
        for (int xb = 0; xb < 10; ++xb) { GRID_BAR(); }
#endif
#if defined(XDUP) && XDUP == 10
        PHASE_BEGIN(1) { pg8::Gemm gm{(const bf16*)(ws + WS_TB8), (const bf16*)(ws + WS_WGU1), T, 2 * FF, D / 2, D / 2}; pg8::FixedOrder S; S.init(T, 2 * FF, Gx, blkx);
            pg8::EpiNull E{(float*)(ws + WS_VEC + 65536)};
            pg8::gemm_phase<pg8::EpiNull, pg8::FixedOrder, PG8_ALIGN, PG8_SP2, true>(lds + RING_OFF, gm, S, E, tidx); } PHASE_END
#endif
#if defined(XDUP) && XDUP == 1
        PHASE_BEGIN(1) { pg8::Gemm gm{(const bf16*)(ws + WS_TB8), (const bf16*)(ws + WS_WGU1), T, 2 * FF, D / 2, D / 2}; pg8::StaticOrder S; S.init(T, 2 * FF, Gx, blkx);
            pg8::EpiNull E{(float*)(ws + WS_VEC + 65536)};
            pg8::gemm_phase<pg8::EpiNull, pg8::StaticOrder, PG8_ALIGN, PG8_SP2, true>(lds + RING_OFF, gm, S, E, tidx); } PHASE_END
#elif defined(XDUP) && XDUP == 2
        PHASE_BEGIN(1) { pg8::Gemm gm{(const bf16*)(ws + WS_TB8), (const bf16*)(ws + WS_WGU1), T, 2 * FF, D / 2, D / 2}; pg8::StaticOrder S; S.init(T, 2 * FF, Gx, blkx, WGM_GU);
            GU_EPI E{(unsigned char*)HB, st_prev, csb, csb + 16384};
            pg8::gemm_phase<GU_EPI, pg8::StaticOrder, PG8_ALIGN, PG8_SP2, !FFN6_GU, false, 1, FFN6_GU>(lds + RING_OFF, gm, S, E, tidx); } PHASE_END
#endif
        PHASE_BEGIN(2) { if (STAGGER_DOWN) stagger_start(blkx, STAGGER_DOWN); pg8::Gemm gm{HB, (const bf16*)(ws + WS_WD1), T, D, FF / 2, FF / 2}; pg8::StaticOrder S; S.init(T, D, Gx, blkx, WGM_D);
            pg8::EpiRes<false> E{P, ws, l == 0, (unsigned)(l ? WS_ST + 2 * STAT_BYTES : WS_ST0), (unsigned)(WS_ST + (size_t)(3 * l + 0) * STAT_BYTES), l ? 20 : -1, 21, 0, DOWN_SC, 0u};
            pg8::gemm_phase<pg8::EpiRes<false>, pg8::StaticOrder, PG8_ALIGN, PG8_SP2, !FFN6_D, false, 1, FFN6_D, F8TO6>(lds + RING_OFF, gm, S, E, tidx); } PHASE_END
        PHASE_BEGIN(3) { pg8::Gemm gm{TB, (const bf16*)(ws + WS_WIN), T, NIN, D, D}; pg8::StaticOrder S; S.init(T, NIN, Gx, blkx, WGM_IN);
            pg8::EpiIn E{Z, st1, csb + 2 * 16384, csb + 3 * 16384, (const float*)(ws + WS_ROPE)};
            pg8::gemm_phase<pg8::EpiIn, pg8::StaticOrder, PG8_ALIGN, PG8_SP2, false, true>(lds + RING_OFF, gm, S, E, tidx); } PHASE_END
#if defined(XDUP) && XDUP == 7
        PHASE_BEGIN(3) { pg8::Gemm gm{TB, (const bf16*)(ws + WS_WIN), T, NIN, D, D}; pg8::StaticOrder S; S.init(T, NIN, Gx, blkx);
            pg8::EpiIn E{Z, st1, csb + 2 * 16384, csb + 3 * 16384, (const float*)(ws + WS_ROPE)};
            pg8::gemm_phase<pg8::EpiIn, pg8::StaticOrder, PG8_ALIGN, PG8_SP2, false, true>(lds + RING_OFF, gm, S, E, tidx); } PHASE_END
#endif
        PHASE_BEGIN(4)
#if defined(ATTN_VALU)
            attn_valu_phase(lds, Z, ssq_att, blkx, Gx, wavex, lanex);
#else
#if defined(XDUP) && XDUP == 4
            attn_mfma_phase(lds, Z, ssq_att, blkx, Gx, tidx, wavex, lanex, (bf16*)(ws + WS_TB));
#endif
            attn_mfma_phase(lds, Z, ssq_att, blkx, Gx, tidx, wavex, lanex);
#endif
            TP_MID()
            if (PHON(5)) lru_phase<0>(lds, blkx, Gx, tidx, lanex, wavex, Z, (const bf16*)(ws + WS_LRUW), P->in[10] + (size_t)l * 4 * LW, P->in[11] + (size_t)l * LW, P->in[13] + (size_t)l * 2 * LW, P->in[15] + (size_t)l * 2 * LW, P->in[16] + (size_t)l * 2 * LW, (float*)(ws + WS_TOT), ssq_rec);
#if defined(XDUP) && XDUP == 3
            lru_phase<0>(lds, blkx, Gx, tidx, lanex, wavex, Z, (const bf16*)(ws + WS_LRUW), P->in[10] + (size_t)l * 4 * LW, P->in[11] + (size_t)l * LW, P->in[13] + (size_t)l * 2 * LW, P->in[15] + (size_t)l * 2 * LW, P->in[16] + (size_t)l * 2 * LW, (float*)(ws + WS_TOT), ssq_rec);
#endif
            PHASE_END
        PHASE_BEGIN(6) lru_phase<1>(lds, blkx, Gx, tidx, lanex, wavex, Z, (const bf16*)(ws + WS_LRUW), P->in[10] + (size_t)l * 4 * LW, P->in[11] + (size_t)l * LW, P->in[13] + (size_t)l * 2 * LW, P->in[15] + (size_t)l * 2 * LW, P->in[16] + (size_t)l * 2 * LW, (float*)(ws + WS_TOT), ssq_rec); PHASE_END
        PHASE_BEGIN(8) { if (STAGGER_OUT) stagger_start(blkx, STAGGER_OUT); pg8::Gemm gm{Z, (const bf16*)(ws + WS_WOUT), T, D, D, NIN}; pg8::StaticOrder S; S.init(T, D, Gx, blkx, WGM_OUT);
            pg8::EpiRes<true, false, 12> E{P, ws, 0, (unsigned)(WS_ST + (size_t)(3 * l + 0) * STAT_BYTES), (unsigned)(WS_ST + (size_t)(3 * l + 1) * STAT_BYTES), 2, 3, l * D, 1.0f, (unsigned)(WS_SSQ + (size_t)(2 * l) * SSQ_BYTES)};
            pg8::gemm_phase<pg8::EpiRes<true, false, 12>, pg8::StaticOrder, PG8_ALIGN, PG8_SP2>(lds + RING_OFF, gm, S, E, tidx); } PHASE_END
        PHASE_BEGIN(1) { pg8::Gemm gm{(const bf16*)(ws + WS_TB8), (const bf16*)(ws + WS_WGU2), T, 2 * FF, D / 2, D / 2}; pg8::StaticOrder S; S.init(T, 2 * FF, Gx, blkx, WGM_GU);
            GU_EPI E{(unsigned char*)HB, st2, csb + 4 * 16384, csb + 5 * 16384};
            pg8::gemm_phase<GU_EPI, pg8::StaticOrder, PG8_ALIGN, PG8_SP2, !FFN6_GU, false, 1, FFN6_GU>(lds + RING_OFF, gm, S, E, tidx); } PHASE_END
#if defined(XDUP) && XDUP == 8
        PHASE_BEGIN(2) { pg8::Gemm gm{HB, (const bf16*)(ws + WS_WD2), T, D, FF / 2, FF / 2}; pg8::StaticOrder S; S.init(T, D, Gx, blkx);
            pg8::EpiRes<true, true> E{P, ws, 0, (unsigned)(WS_ST + (size_t)(3 * l + 1) * STAT_BYTES), (unsigned)(WS_ST + (size_t)(3 * l + 2) * STAT_BYTES), 7, 8, l * D, 0.5f / (pg8::F8_WSC * pg8::F8_HSC), 0u};
            pg8::gemm_phase<pg8::EpiRes<true, true>, pg8::StaticOrder, PG8_ALIGN, PG8_SP2, true>(lds + RING_OFF, gm, S, E, tidx); } PHASE_END
#endif
#if defined(XDUP) && XDUP == 6
        PHASE_BEGIN(2) { pg8::Gemm gm{HB, (const bf16*)(ws + WS_WD2), T, D, FF / 2, FF / 2}; pg8::StaticOrder S; S.init(T, D, Gx, blkx);
            pg8::EpiNull E{(float*)(ws + WS_VEC + 65536)};
            pg8::gemm_phase<pg8::EpiNull, pg8::StaticOrder, PG8_ALIGN, PG8_SP2, true>(lds + RING_OFF, gm, S, E, tidx); } PHASE_END
#endif
        PHASE_BEGIN(2) { if (STAGGER_DOWN) stagger_start(blkx, STAGGER_DOWN); pg8::Gemm gm{HB, (const bf16*)(ws + WS_WD2), T, D, FF / 2, FF / 2}; pg8::StaticOrder S; S.init(T, D, Gx, blkx, WGM_D);
            using EpiD2 = pg8::EpiRes<(l == 1) ? false : true, false, 0, (FUSE_FIN && l == 1)>;
            EpiD2 E{P, ws, 0, (unsigned)(WS_ST + (size_t)(3 * l + 1) * STAT_BYTES), (unsigned)(WS_ST + (size_t)(3 * l + 2) * STAT_BYTES), 7, 8, l * D, DOWN_SC, 0u};
            pg8::gemm_phase<EpiD2, pg8::StaticOrder, PG8_ALIGN, PG8_SP2, !FFN6_D, false, 1, FFN6_D, F8TO6>(lds + RING_OFF, gm, S, E, tidx); } PHASE_END
        if (l == 0) { PHASE_BEGIN(9) convert_layer(P, 1, lds, gwx, NGW, wavex, lanex);
#if defined(XDUP) && XDUP == 5
            convert_layer(P, 1, lds, gwx, NGW, wavex, lanex, (float*)(ws + WS_TOT));
#endif
            PHASE_END }
    }
    }
    { constexpr int l = 1;
    {
#define TB ((bf16*)(ws + WS_TB))
#define HB ((bf16*)(ws + WS_BIG))
#define Z ((bf16*)(ws + WS_BIG))
#define csb ((float*)(ws + WS_CSB) + (size_t)l * 6 * 16384)
#define ones ((const float*)(ws + WS_VEC))
#define zeros (ones + 2048)
#define st_prev (l ? (const float*)(ws + WS_ST + 2 * STAT_BYTES) : (const float*)(ws + WS_ST0))
#define g_prev (l ? P->in[20] : ones)
#define b_prev (l ? P->in[21] : zeros)
#define st1 ((float*)(ws + WS_ST + (size_t)(3 * l + 0) * STAT_BYTES))
#define st2 ((float*)(ws + WS_ST + (size_t)(3 * l + 1) * STAT_BYTES))
#define st3 ((float*)(ws + WS_ST + (size_t)(3 * l + 2) * STAT_BYTES))
#ifndef F8TO6
#define F8TO6 0
#endif
#if FFN6_D
#define GU_EPI pg8::EpiGU6
#ifndef F6_FIX
#define F6_FIX 1.0f
#endif
#define DOWN_SC (0.5f / (pg8::F6_WD * pg8::F6_HSC) * F6_FIX)
#else
#define GU_EPI pg8::EpiGU
#define DOWN_SC (0.5f / (pg8::F8_WSC * pg8::F8_HSC) * (F8TO6 ? 8.0f : 1.0f))
#endif
#ifndef WGM_GU
#define WGM_GU PG8_WGM
#endif
#ifndef WGM_D
#define WGM_D PG8_WGM
#endif
#ifndef WGM_IN
#define WGM_IN PG8_WGM
#endif
#ifndef WGM_OUT
#define WGM_OUT PG8_WGM
#endif
#define ssq_att ((float*)(ws + WS_SSQ + (size_t)(2 * l) * SSQ_BYTES))
#define ssq_rec ((float*)(ws + WS_SSQ + (size_t)(2 * l + 1) * SSQ_BYTES))
        PHASE_BEGIN(1) { pg8::Gemm gm{(const bf16*)(ws + WS_TB8), (const bf16*)(ws + WS_WGU1), T, 2 * FF, D / 2, D / 2}; pg8::StaticOrder S; S.init(T, 2 * FF, Gx, blkx);
            pg8::EpiGU E{(unsigned char*)HB, st_prev, csb, csb + 16384};
            pg8::gemm_phase<pg8::EpiGU, pg8::StaticOrder, PG8_ALIGN, PG8_SP2, true>(lds + RING_OFF, gm, S, E, tidx); } PHASE_END
#if defined(XDUP) && XDUP == 11
        PHASE_BEGIN(1) { pg8::Gemm gm{(const bf16*)(ws + WS_TB8), (const bf16*)(ws + WS_WGU1), T, 2 * FF, D / 2, D / 2}; pg8::FixedOrder S; S.init(T, 2 * FF, Gx, blkx);
            pg8::EpiNull E{(float*)(ws + WS_VEC + 65536)};
            pg8::gemm_phase<pg8::EpiNull, pg8::FixedOrder, PG8_ALIGN, PG8_SP2, true, false, 2>(lds + RING_OFF, gm, S, E, tidx); } PHASE_END
#endif
#if defined(XDUP) && XDUP >= 13 && XDUP <= 16
        PHASE_BEGIN(1) { pg8::Gemm gm{(const bf16*)(ws + WS_TB8), (const bf16*)(ws + WS_WGU1), T, 2 * FF, D / 2, D / 2}; pg8::StaticOrder S; S.init(T, 2 * FF, Gx, blkx);
            pg8::EpiNull E{(float*)(ws + WS_VEC + 65536)};
            pg8::gemm_phase<pg8::EpiNull, pg8::StaticOrder, PG8_ALIGN, PG8_SP2, true, false, 1, false, false, XDUP - 13>(lds + RING_OFF, gm, S, E, tidx); } PHASE_END
#endif
#if defined(XDUP) && XDUP == 12
        PHASE_BEGIN(1) { pg8::Gemm gm{(const bf16*)(ws + WS_TB8), (const bf16*)(ws + WS_WGU1), T, 2 * FF, D / 2, D / 2}; pg8::StaticOrder S; S.init(T, 2 * FF, Gx, blkx);
            pg8::EpiNull E{(float*)(ws + WS_VEC + 65536)};
            pg8::gemm_phase<pg8::EpiNull, pg8::StaticOrder, PG8_ALIGN, PG8_SP2, false, false, 1, true>(lds + RING_OFF, gm, S, E, tidx); } PHASE_END
#endif
#if defined(XDUP) && XDUP == 9
        for (int xb = 0; xb < 10; ++xb) { GRID_BAR(); }
#endif
#if defined(XDUP) && XDUP == 10
        PHASE_BEGIN(1) { pg8::Gemm gm{(const bf16*)(ws + WS_TB8), (const bf16*)(ws + WS_WGU1), T, 2 * FF, D / 2, D / 2}; pg8::FixedOrder S; S.init(T, 2 * FF, Gx, blkx);
            pg8::EpiNull E{(float*)(ws + WS_VEC + 65536)};
            pg8::gemm_phase<pg8::EpiNull, pg8::FixedOrder, PG8_ALIGN, PG8_SP2, true>(lds + RING_OFF, gm, S, E, tidx); } PHASE_END
#endif
#if defined(XDUP) && XDUP == 1
        PHASE_BEGIN(1) { pg8::Gemm gm{(const bf16*)(ws + WS_TB8), (const bf16*)(ws + WS_WGU1), T, 2 * FF, D / 2, D / 2}; pg8::StaticOrder S; S.init(T, 2 * FF, Gx, blkx);
            pg8::EpiNull E{(float*)(ws + WS_VEC + 65536)};
            pg8::gemm_phase<pg8::EpiNull, pg8::StaticOrder, PG8_ALIGN, PG8_SP2, true>(lds + RING_OFF, gm, S, E, tidx); } PHASE_END
#elif defined(XDUP) && XDUP == 2
        PHASE_BEGIN(1) { pg8::Gemm gm{(const bf16*)(ws + WS_TB8), (const bf16*)(ws + WS_WGU1), T, 2 * FF, D / 2, D / 2}; pg8::StaticOrder S; S.init(T, 2 * FF, Gx, blkx, WGM_GU);
            GU_EPI E{(unsigned char*)HB, st_prev, csb, csb + 16384};
            pg8::gemm_phase<GU_EPI, pg8::StaticOrder, PG8_ALIGN, PG8_SP2, !FFN6_GU, false, 1, FFN6_GU>(lds + RING_OFF, gm, S, E, tidx); } PHASE_END
#endif
        PHASE_BEGIN(2) { if (STAGGER_DOWN) stagger_start(blkx, STAGGER_DOWN); pg8::Gemm gm{HB, (const bf16*)(ws + WS_WD1), T, D, FF / 2, FF / 2}; pg8::StaticOrder S; S.init(T, D, Gx, blkx, WGM_D);
            pg8::EpiRes<false> E{P, ws, l == 0, (unsigned)(l ? WS_ST + 2 * STAT_BYTES : WS_ST0), (unsigned)(WS_ST + (size_t)(3 * l + 0) * STAT_BYTES), l ? 20 : -1, 21, 0, DOWN_SC, 0u};
            pg8::gemm_phase<pg8::EpiRes<false>, pg8::StaticOrder, PG8_ALIGN, PG8_SP2, !FFN6_D, false, 1, FFN6_D, F8TO6>(lds + RING_OFF, gm, S, E, tidx); } PHASE_END
        PHASE_BEGIN(3) { pg8::Gemm gm{TB, (const bf16*)(ws + WS_WIN), T, NIN, D, D}; pg8::StaticOrder S; S.init(T, NIN, Gx, blkx, WGM_IN);
            pg8::EpiIn E{Z, st1, csb + 2 * 16384, csb + 3 * 16384, (const float*)(ws + WS_ROPE)};
            pg8::gemm_phase<pg8::EpiIn, pg8::StaticOrder, PG8_ALIGN, PG8_SP2, false, true>(lds + RING_OFF, gm, S, E, tidx); } PHASE_END
#if defined(XDUP) && XDUP == 7
        PHASE_BEGIN(3) { pg8::Gemm gm{TB, (const bf16*)(ws + WS_WIN), T, NIN, D, D}; pg8::StaticOrder S; S.init(T, NIN, Gx, blkx);
            pg8::EpiIn E{Z, st1, csb + 2 * 16384, csb + 3 * 16384, (const float*)(ws + WS_ROPE)};
            pg8::gemm_phase<pg8::EpiIn, pg8::StaticOrder, PG8_ALIGN, PG8_SP2, false, true>(lds + RING_OFF, gm, S, E, tidx); } PHASE_END
#endif
        PHASE_BEGIN(4)
#if defined(ATTN_VALU)
            attn_valu_phase(lds, Z, ssq_att, blkx, Gx, wavex, lanex);
#else
#if defined(XDUP) && XDUP == 4
            attn_mfma_phase(lds, Z, ssq_att, blkx, Gx, tidx, wavex, lanex, (bf16*)(ws + WS_TB));
#endif
            attn_mfma_phase(lds, Z, ssq_att, blkx, Gx, tidx, wavex, lanex);
#endif
            TP_MID()
            if (PHON(5)) lru_phase<0>(lds, blkx, Gx, tidx, lanex, wavex, Z, (const bf16*)(ws + WS_LRUW), P->in[10] + (size_t)l * 4 * LW, P->in[11] + (size_t)l * LW, P->in[13] + (size_t)l * 2 * LW, P->in[15] + (size_t)l * 2 * LW, P->in[16] + (size_t)l * 2 * LW, (float*)(ws + WS_TOT), ssq_rec);
#if defined(XDUP) && XDUP == 3
            lru_phase<0>(lds, blkx, Gx, tidx, lanex, wavex, Z, (const bf16*)(ws + WS_LRUW), P->in[10] + (size_t)l * 4 * LW, P->in[11] + (size_t)l * LW, P->in[13] + (size_t)l * 2 * LW, P->in[15] + (size_t)l * 2 * LW, P->in[16] + (size_t)l * 2 * LW, (float*)(ws + WS_TOT), ssq_rec);
#endif
            PHASE_END
        PHASE_BEGIN(6) lru_phase<1>(lds, blkx, Gx, tidx, lanex, wavex, Z, (const bf16*)(ws + WS_LRUW), P->in[10] + (size_t)l * 4 * LW, P->in[11] + (size_t)l * LW, P->in[13] + (size_t)l * 2 * LW, P->in[15] + (size_t)l * 2 * LW, P->in[16] + (size_t)l * 2 * LW, (float*)(ws + WS_TOT), ssq_rec); PHASE_END
        PHASE_BEGIN(8) { if (STAGGER_OUT) stagger_start(blkx, STAGGER_OUT); pg8::Gemm gm{Z, (const bf16*)(ws + WS_WOUT), T, D, D, NIN}; pg8::StaticOrder S; S.init(T, D, Gx, blkx, WGM_OUT);
            pg8::EpiRes<true, false, 12> E{P, ws, 0, (unsigned)(WS_ST + (size_t)(3 * l + 0) * STAT_BYTES), (unsigned)(WS_ST + (size_t)(3 * l + 1) * STAT_BYTES), 2, 3, l * D, 1.0f, (unsigned)(WS_SSQ + (size_t)(2 * l) * SSQ_BYTES)};
            pg8::gemm_phase<pg8::EpiRes<true, false, 12>, pg8::StaticOrder, PG8_ALIGN, PG8_SP2>(lds + RING_OFF, gm, S, E, tidx); } PHASE_END
        PHASE_BEGIN(1) { pg8::Gemm gm{(const bf16*)(ws + WS_TB8), (const bf16*)(ws + WS_WGU2), T, 2 * FF, D / 2, D / 2}; pg8::StaticOrder S; S.init(T, 2 * FF, Gx, blkx, WGM_GU);
            GU_EPI E{(unsigned char*)HB, st2, csb + 4 * 16384, csb + 5 * 16384};
            pg8::gemm_phase<GU_EPI, pg8::StaticOrder, PG8_ALIGN, PG8_SP2, !FFN6_GU, false, 1, FFN6_GU>(lds + RING_OFF, gm, S, E, tidx); } PHASE_END
#if defined(XDUP) && XDUP == 8
        PHASE_BEGIN(2) { pg8::Gemm gm{HB, (const bf16*)(ws + WS_WD2), T, D, FF / 2, FF / 2}; pg8::StaticOrder S; S.init(T, D, Gx, blkx);
            pg8::EpiRes<true, true> E{P, ws, 0, (unsigned)(WS_ST + (size_t)(3 * l + 1) * STAT_BYTES), (unsigned)(WS_ST + (size_t)(3 * l + 2) * STAT_BYTES), 7, 8, l * D, 0.5f / (pg8::F8_WSC * pg8::F8_HSC), 0u};
            pg8::gemm_phase<pg8::EpiRes<true, true>, pg8::StaticOrder, PG8_ALIGN, PG8_SP2, true>(lds + RING_OFF, gm, S, E, tidx); } PHASE_END
#endif
#if defined(XDUP) && XDUP == 6
        PHASE_BEGIN(2) { pg8::Gemm gm{HB, (const bf16*)(ws + WS_WD2), T, D, FF / 2, FF / 2}; pg8::StaticOrder S; S.init(T, D, Gx, blkx);
            pg8::EpiNull E{(float*)(ws + WS_VEC + 65536)};
            pg8::gemm_phase<pg8::EpiNull, pg8::StaticOrder, PG8_ALIGN, PG8_SP2, true>(lds + RING_OFF, gm, S, E, tidx); } PHASE_END
#endif
        PHASE_BEGIN(2) { if (STAGGER_DOWN) stagger_start(blkx, STAGGER_DOWN); pg8::Gemm gm{HB, (const bf16*)(ws + WS_WD2), T, D, FF / 2, FF / 2}; pg8::StaticOrder S; S.init(T, D, Gx, blkx, WGM_D);
            using EpiD2 = pg8::EpiRes<(l == 1) ? false : true, false, 0, (FUSE_FIN && l == 1)>;
            EpiD2 E{P, ws, 0, (unsigned)(WS_ST + (size_t)(3 * l + 1) * STAT_BYTES), (unsigned)(WS_ST + (size_t)(3 * l + 2) * STAT_BYTES), 7, 8, l * D, DOWN_SC, 0u};
            pg8::gemm_phase<EpiD2, pg8::StaticOrder, PG8_ALIGN, PG8_SP2, !FFN6_D, false, 1, FFN6_D, F8TO6>(lds + RING_OFF, gm, S, E, tidx); } PHASE_END
        if (l == 0) { PHASE_BEGIN(9) convert_layer(P, 1, lds, gwx, NGW, wavex, lanex);
#if defined(XDUP) && XDUP == 5
            convert_layer(P, 1, lds, gwx, NGW, wavex, lanex, (float*)(ws + WS_TOT));
#endif
            PHASE_END }
    }
    }

#if !FUSE_FIN
#if defined(XDUP) && XDUP == 17
    PHASE_BEGIN(10) final_ln_phase(out, (const unsigned char*)(ws + WS_TB), (const float*)(ws + WS_ST + 5 * STAT_BYTES), P->in[20] + D, P->in[21] + D, gwx, NGW, lanex, (const float*)(ws + WS_VEC + 32768)); PHASE_END
#endif
    PHASE_BEGIN(10) final_ln_phase(out, (const unsigned char*)(ws + WS_TB), (const float*)(ws + WS_ST + 5 * STAT_BYTES), P->in[20] + D, P->in[21] + D, gwx, NGW, lanex, (const float*)(ws + WS_VEC + 32768)); PHASE_END
#endif
#undef PHASE_BEGIN
#undef PH_IN_RANGE
#undef PH_BAR_AFTER
#undef GRID_BAR
#undef PHASE_END
#undef TB
#undef HB
#undef Z
#undef csb
#undef ones
#undef zeros
#undef st_prev
#undef g_prev
#undef b_prev
#undef st1
#undef st2
#undef st3
#undef ssq_att
#undef ssq_rec
#undef out
}
constexpr int N_PHASES = N_PHASES_C;

#ifndef MK_N_LAUNCHES
#define MK_N_LAUNCHES 1
#endif
extern "C" void kernel_launch(void* const* d_in, const int* in_sizes, int n_in, void* d_out, int out_size, void* d_ws, size_t ws_size, hipStream_t stream) {
    static int grid = 0;
    if (grid == 0) {
        if (n_in != 25 || out_size != T * D || ws_size < WS_END) { fprintf(stderr, "kernel_launch: unexpected shapes (n_in %d, out %d, ws %zu)\n", n_in, out_size, ws_size); grid = -1; return; }
        int dev = 0, cus = 0, per_cu = 0;
        if (hipGetDevice(&dev) != hipSuccess || hipDeviceGetAttribute(&cus, hipDeviceAttributeMultiprocessorCount, dev) != hipSuccess) { grid = -1; return; }
        if (hipFuncSetAttribute((const void*)enc_fwd, hipFuncAttributeMaxDynamicSharedMemorySize, LDS_BYTES) != hipSuccess) { grid = -1; return; }
        if (hipOccupancyMaxActiveBlocksPerMultiprocessor(&per_cu, (const void*)enc_fwd, NWAVES * 64, LDS_BYTES) != hipSuccess || per_cu < 1) fprintf(stderr, "kernel_launch: occupancy query reports %d\n", per_cu);
        (void)hipGetLastError();
        grid = cus;
    }
    if (grid < 0) return;
    if (hipMemsetAsync((char*)d_ws + WS_CTL, 0, CTL_ZERO_BYTES, stream) != hipSuccess) return;
    Args a{};
    for (int i = 0; i < 25; ++i) a.in[i] = (const float*)d_in[i];
    a.out = (float*)d_out; a.ws = (unsigned char*)d_ws;
#if MK_N_LAUNCHES == 1
    a.ph_lo = 0; a.ph_hi = N_PHASES;
    hipLaunchKernelGGL(enc_fwd, dim3(grid), dim3(NWAVES * 64), LDS_BYTES, stream, a);
#else
    for (int p = 0; p < N_PHASES; ++p) { a.ph_lo = p; a.ph_hi = p + 1; hipLaunchKernelGGL(enc_fwd, dim3(grid), dim3(NWAVES * 64), LDS_BYTES, stream, a); }
#endif
}
```
